# Optimizing an MI355X kernel written in HIP

```python
import math
import jax, jax.numpy as jnp
from jax import lax
import numpy as np

D_MODEL = 1024
BATCH = 16
SEQ = 2048
DEPTH = 2

N_META = 16
Q_BLOCK = 128
ROPE_THETA = 10000.0
EPS = 1e-6

MLA_NOPE_DIM = 128
MLA_ROPE_DIM = 64
MLA_V_DIM = 128
MLA_QK_DIM = MLA_NOPE_DIM + MLA_ROPE_DIM
MLA_HEADS = (D_MODEL // 2) // MLA_V_DIM
MLA_Q_RANK = D_MODEL // 4
MLA_KV_RANK = D_MODEL // 8

DIFF_HEAD_DIM = 64
DIFF_V_DIM = 2 * DIFF_HEAD_DIM
DIFF_HEADS = (D_MODEL // 2) // DIFF_V_DIM

MLA_OUT = MLA_HEADS * MLA_V_DIM
DIFF_OUT = DIFF_HEADS * DIFF_V_DIM
MIX_WIDTH = MLA_OUT + DIFF_OUT

IN_SIZES = (MLA_Q_RANK, MLA_KV_RANK, MLA_ROPE_DIM,
            DIFF_HEADS * 2 * DIFF_HEAD_DIM, DIFF_HEADS * 2 * DIFF_HEAD_DIM, DIFF_OUT)
IN_WIDTH = sum(IN_SIZES)

D_FF = -(-8 * D_MODEL // (3 * 256)) * 256

kernel_name = 'hymba_mla_diffattn_swiglu'


def rms_norm(x, g):
    xf = x.astype(jnp.float32)
    y = xf * lax.rsqrt(jnp.mean(xf * xf, axis=-1, keepdims=True) + EPS)
    return (y * g.astype(jnp.float32)).astype(x.dtype)


def rope_tables(n, dim):
    pos = jnp.arange(n, dtype=jnp.float32)
    inv = 1.0 / (ROPE_THETA ** (jnp.arange(0, dim, 2, dtype=jnp.float32) / dim))
    ang = pos[:, None] * inv[None, :]
    emb = jnp.concatenate([ang, ang], axis=-1)
    return jnp.cos(emb), jnp.sin(emb)


def apply_rope(x, cos, sin):
    n, dim = cos.shape
    shape = (1, n) + (1,) * (x.ndim - 3) + (dim,)
    c = cos.reshape(shape).astype(x.dtype)
    s = sin.reshape(shape).astype(x.dtype)
    half = dim // 2
    rot = jnp.concatenate([-x[..., half:], x[..., :half]], axis=-1)
    return x * c + rot * s


def query_blocks(n_total):
    bounds = [(0, N_META)]
    for s in range(N_META, n_total, Q_BLOCK):
        bounds.append((s, min(s + Q_BLOCK, n_total)))
    return bounds


def causal_probs(scores, q_start):
    tq, tk = scores.shape[-2], scores.shape[-1]
    q_idx = q_start + jnp.arange(tq)
    k_idx = jnp.arange(tk)
    mask = k_idx[None, :] <= q_idx[:, None]
    scores = jnp.where(mask, scores, jnp.finfo(jnp.float32).min)
    return jax.nn.softmax(scores, axis=-1)


def mla_attention(q, k, v):
    scale = MLA_QK_DIM ** -0.5
    outs = []
    for s, e in query_blocks(q.shape[1]):
        sc = jnp.einsum('bqhd,bkhd->bhqk', q[:, s:e], k[:, :e],
                        preferred_element_type=jnp.float32) * scale
        p = causal_probs(sc, s)
        outs.append(jnp.einsum('bhqk,bkhd->bqhd', p.astype(v.dtype), v[:, :e]))
    return jnp.concatenate(outs, axis=1)


def diff_attention(q, k, v, lam):
    scale = DIFF_HEAD_DIM ** -0.5
    outs = []
    for s, e in query_blocks(q.shape[1]):
        sc = jnp.einsum('bqhcd,bkhcd->bchqk', q[:, s:e], k[:, :e],
                        preferred_element_type=jnp.float32) * scale
        p = causal_probs(sc, s)
        attn = p[:, 0] - lam * p[:, 1]
        outs.append(jnp.einsum('bhqk,bkhd->bqhd', attn.astype(v.dtype), v[:, :e]))
    return jnp.concatenate(outs, axis=1)


def setup_inputs(seed: int = 0) -> dict:
    key = jax.random.key(seed)
    ks = jax.random.split(key, 24)
    f32 = jnp.float32

    def w(k, shape, fan_in):
        return jax.random.normal(k, shape, f32) * (fan_in ** -0.5)

    def gain(k, shape):
        return 1.0 + 0.02 * jax.random.normal(k, shape, f32)

    return {
        'x': jax.random.normal(ks[0], (BATCH, SEQ, D_MODEL), f32),
        'meta_tokens': jax.random.normal(ks[1], (N_META, D_MODEL), f32),
        'attn_norm': gain(ks[2], (DEPTH, D_MODEL)),
        'w_in': w(ks[3], (DEPTH, D_MODEL, IN_WIDTH), D_MODEL),
        'mla_q_a_norm': gain(ks[4], (DEPTH, MLA_Q_RANK)),
        'w_q_up': w(ks[5], (DEPTH, MLA_Q_RANK, MLA_HEADS * MLA_QK_DIM), MLA_Q_RANK),
        'mla_kv_a_norm': gain(ks[6], (DEPTH, MLA_KV_RANK)),
        'w_kv_up': w(ks[7], (DEPTH, MLA_KV_RANK, MLA_HEADS * (MLA_NOPE_DIM + MLA_V_DIM)), MLA_KV_RANK),
        'mla_q_norm': gain(ks[8], (DEPTH, MLA_QK_DIM)),
        'mla_k_norm': gain(ks[9], (DEPTH, MLA_QK_DIM)),
        'diff_q_norm': gain(ks[10], (DEPTH, DIFF_HEAD_DIM)),
        'diff_k_norm': gain(ks[11], (DEPTH, DIFF_HEAD_DIM)),
        'lambda_q1': 0.1 * jax.random.normal(ks[12], (DEPTH, DIFF_HEAD_DIM), f32),
        'lambda_k1': 0.1 * jax.random.normal(ks[13], (DEPTH, DIFF_HEAD_DIM), f32),
        'lambda_q2': 0.1 * jax.random.normal(ks[14], (DEPTH, DIFF_HEAD_DIM), f32),
        'lambda_k2': 0.1 * jax.random.normal(ks[15], (DEPTH, DIFF_HEAD_DIM), f32),
        'diff_subln': gain(ks[16], (DEPTH, DIFF_V_DIM)),
        'w_o': w(ks[17], (DEPTH, MIX_WIDTH, D_MODEL), MIX_WIDTH),
        'ffn_norm': gain(ks[18], (DEPTH, D_MODEL)),
        'w_gate_up': w(ks[19], (DEPTH, D_MODEL, 2 * D_FF), D_MODEL),
        'w_down': w(ks[20], (DEPTH, D_FF, D_MODEL), D_FF),
    }


def reference(x, meta_tokens, attn_norm, w_in, mla_q_a_norm, w_q_up, mla_kv_a_norm,
              w_kv_up, mla_q_norm, mla_k_norm, diff_q_norm, diff_k_norm,
              lambda_q1, lambda_k1, lambda_q2, lambda_k2, diff_subln, w_o,
              ffn_norm, w_gate_up, w_down):
    b = x.shape[0]
    meta = jnp.broadcast_to(meta_tokens[None].astype(x.dtype), (b, N_META, x.shape[2]))
    h_res = jnp.concatenate([meta, x], axis=1)
    n = h_res.shape[1]
    cos_a, sin_a = rope_tables(n, MLA_ROPE_DIM)
    cos_b, sin_b = rope_tables(n, DIFF_HEAD_DIM)
    split_pts = [sum(IN_SIZES[:i + 1]) for i in range(len(IN_SIZES) - 1)]

    for l in range(DEPTH):
        hn = rms_norm(h_res, attn_norm[l])
        proj = hn @ w_in[l]
        cq, ckv, kr, dq, dk, dv = jnp.split(proj, split_pts, axis=-1)

        q = (rms_norm(cq, mla_q_a_norm[l]) @ w_q_up[l]).reshape(b, n, MLA_HEADS, MLA_QK_DIM)
        kv = (rms_norm(ckv, mla_kv_a_norm[l]) @ w_kv_up[l]).reshape(
            b, n, MLA_HEADS, MLA_NOPE_DIM + MLA_V_DIM)
        k_nope, v_a = kv[..., :MLA_NOPE_DIM], kv[..., MLA_NOPE_DIM:]
        k_rope = jnp.broadcast_to(kr[:, :, None, :], (b, n, MLA_HEADS, MLA_ROPE_DIM))
        k = jnp.concatenate([k_nope, k_rope], axis=-1)
        q = rms_norm(q, mla_q_norm[l])
        k = rms_norm(k, mla_k_norm[l])
        q = jnp.concatenate([q[..., :MLA_NOPE_DIM],
                             apply_rope(q[..., MLA_NOPE_DIM:], cos_a, sin_a)], axis=-1)
        k = jnp.concatenate([k[..., :MLA_NOPE_DIM],
                             apply_rope(k[..., MLA_NOPE_DIM:], cos_a, sin_a)], axis=-1)
        o_a = mla_attention(q, k, v_a).reshape(b, n, MLA_OUT)

        qd = rms_norm(dq.reshape(b, n, DIFF_HEADS, 2, DIFF_HEAD_DIM), diff_q_norm[l])
        kd = rms_norm(dk.reshape(b, n, DIFF_HEADS, 2, DIFF_HEAD_DIM), diff_k_norm[l])
        qd = apply_rope(qd, cos_b, sin_b)
        kd = apply_rope(kd, cos_b, sin_b)
        vd = dv.reshape(b, n, DIFF_HEADS, DIFF_V_DIM)
        lam_init = 0.8 - 0.6 * math.exp(-0.3 * l)
        lam = (jnp.exp(jnp.sum(lambda_q1[l].astype(jnp.float32) * lambda_k1[l].astype(jnp.float32)))
               - jnp.exp(jnp.sum(lambda_q2[l].astype(jnp.float32) * lambda_k2[l].astype(jnp.float32)))
               + lam_init)
        o_b = diff_attention(qd, kd, vd, lam)
        o_b = (rms_norm(o_b, diff_subln[l]) * (1.0 - lam_init)).reshape(b, n, DIFF_OUT)

        h_res = h_res + jnp.concatenate([o_a, o_b], axis=-1) @ w_o[l]

        hn = rms_norm(h_res, ffn_norm[l])
        gu = hn @ w_gate_up[l]
        g, u = gu[..., :D_FF], gu[..., D_FF:]
        h_res = h_res + (jax.nn.silu(g) * u) @ w_down[l]

    return h_res[:, N_META:]
```

```cpp
#include <hip/hip_runtime.h>
#include <hip/hip_cooperative_groups.h>
#include <cstdio>
#include <cstdint>
namespace cg = cooperative_groups;

#ifndef MK_ONE_LAUNCH
#define MK_ONE_LAUNCH 0
#endif

constexpr int DM = 1024, BATCH = 16, SEQ = 2048, NMETA = 16, DEPTH = 2;
constexpr int NREAL = BATCH * SEQ;
constexpr int NROWS = NREAL + NMETA;
constexpr int MP = 33024;
constexpr int LSEQ = SEQ + NMETA;
constexpr int INW = 1984, INWP = 2048, DFF = 2816;
constexpr float EPS = 1e-6f;
constexpr float LOG2E = 1.4426950408889634f;
constexpr float CA = 0.07216878364870322f * LOG2E;
constexpr float CD = 0.125f * LOG2E;
constexpr int PC_CQ = 0, PC_CKV = 256, PC_KR = 384, PC_DQ = 448, PC_DK = 960, PC_DV = 1472;

constexpr size_t MiB = 1u << 20;
constexpr size_t WS_CTL = 0;
constexpr size_t WS_RH = 1 * MiB;
constexpr size_t WS_RQ = WS_RH + 256 * 1024;
constexpr size_t WS_RKV = WS_RQ + 256 * 1024;
constexpr size_t WS_HM = WS_RKV + 256 * 1024;
constexpr size_t WS_LAM = WS_HM + 64 * 1024;
constexpr size_t WS_COS = 2 * MiB;
constexpr size_t WS_SIN = WS_COS + 512 * 1024;
constexpr size_t WS_W = 4 * MiB;
constexpr size_t W_IN = 0, W_Q = W_IN + (size_t)INWP * DM * 2, W_KV = W_Q + (size_t)1024 * 256 * 2, W_O = W_KV + (size_t)1024 * 256 * 2,
                 W_GU = W_O + (size_t)DM * DM * 2, W_D = W_GU + (size_t)2 * DFF * DM * 2, W_LAYER = W_D + (size_t)DM * DFF * 2;
static_assert(WS_W + 2 * W_LAYER <= 52 * MiB, "weights");
constexpr size_t WS_PROJ = 52 * MiB;
constexpr size_t WS_KVRAW = WS_PROJ + (size_t)MP * INWP * 2;
constexpr size_t WS_QA = WS_KVRAW + (size_t)MP * 1024 * 2;
constexpr size_t WS_KA = WS_QA + (size_t)MP * 768 * 2;
constexpr size_t WS_QD = WS_KA + (size_t)MP * 768 * 2;
constexpr size_t WS_KD = WS_QD + (size_t)MP * 512 * 2;
constexpr size_t WS_AO = WS_KD + (size_t)MP * 512 * 2;
constexpr size_t WS_TMP = WS_AO + (size_t)MP * 1024 * 2;
constexpr size_t WS_END = WS_TMP + (size_t)256 * 64 * 512 * 4;
constexpr size_t WS_ACT = WS_PROJ;
static_assert(WS_ACT + (size_t)MP * DFF * 2 <= WS_QA, "ACT overlay");

#define LAS __attribute__((address_space(3)))
typedef unsigned short bf16_t;
typedef short bf16x8 __attribute__((ext_vector_type(8)));
typedef short s16x4 __attribute__((ext_vector_type(4)));
typedef float f32x4 __attribute__((ext_vector_type(4)));
typedef float f32x16 __attribute__((ext_vector_type(16)));
typedef unsigned u32x4 __attribute__((ext_vector_type(4)));
typedef unsigned u32x2 __attribute__((ext_vector_type(2)));
#define GAS __attribute__((address_space(1)))
typedef GAS bf16_t gbf16_t; typedef GAS float gfloat; typedef GAS unsigned char guchar; typedef GAS char gchar; typedef GAS unsigned gunsigned;
typedef GAS u32x4 gu32x4; typedef GAS u32x2 gu32x2; typedef GAS f32x4 gf32x4; typedef GAS bf16x8 gbf16x8;

__device__ __forceinline__ unsigned f2bf(float f) { unsigned u = __builtin_bit_cast(unsigned, f); return (u + 0x7fffu + ((u >> 16) & 1u)) >> 16; }
__device__ __forceinline__ unsigned pk2(float lo, float hi) { return f2bf(lo) | (f2bf(hi) << 16); }
__device__ __forceinline__ float bf2f(unsigned b) { return __builtin_bit_cast(float, b << 16); }
__device__ __forceinline__ unsigned cvt_pk_bf16(float lo, float hi) { unsigned r; asm volatile("v_cvt_pk_bf16_f32 %0, %1, %2" : "=v"(r) : "v"(lo), "v"(hi)); return r; }
__device__ __forceinline__ float wave_sum(float v) {
#pragma unroll
    for (int o = 1; o < 64; o <<= 1) v += __shfl_xor(v, o);
    return v;
}
#define LDS_WAIT() asm volatile("s_waitcnt lgkmcnt(0)" ::: "memory")

namespace pg8 {
constexpr int BM = 256, BK = 64, HALF = 128, HTB = HALF * BK * 2, STAGE_BYTES = 8 * HTB, NXCD = 8, WGM = 8;
__host__ __device__ __forceinline__ int lds_byte(int r, int c) { const int st = (r >> 4) * 2 + (c >> 5), rr = r & 15, cc = c & 31, ob = rr * 64 + cc * 2; return st * 1024 + (ob ^ (((ob >> 9) & 1) << 5)); }
__host__ __device__ __forceinline__ void stage_rc(int b, int& R, int& C) { const int st = b / 1024, sb = b % 1024, swz = sb ^ (((sb >> 9) & 1) << 5); R = (st >> 1) * 16 + swz / 64; C = (st & 1) * 32 + (swz % 64) / 2; }
__host__ __device__ __forceinline__ int perm32(int rho) { const int n = rho >> 4, i = rho & 15; return 8 * (i >> 2) + 4 * n + (i & 3); }

struct Unit { int pm, pn; };
struct Gemm { const gbf16_t* A; const gbf16_t* Bt; int M, N, K, lda; };

struct StaticOrder {
    int nM, nN, nwg, G, c;
    __device__ void init(int M, int N, int G_, int c_) { nM = M / BM; nN = N / BM; nwg = nM * nN; G = G_; c = c_; }
    __device__ bool next(int i, Unit& u) const {
        const long L = (long)i * G + c; if (L >= nwg) return false;
        int wgid = (int)L; { const int q = nwg / NXCD, r = nwg % NXCD, xcd = wgid % NXCD, off = wgid / NXCD; wgid = (xcd < r ? xcd * (q + 1) : r * (q + 1) + (xcd - r) * q) + off; }
        const int nig = WGM * nN, gid = wgid / nig, fm = gid * WGM, gsz = (nM - fm) < WGM ? (nM - fm) : WGM;
        u.pm = fm + ((wgid % nig) % gsz); u.pn = (wgid % nig) / gsz; return true;
    }
};

struct EpiScaleBf16 {
    static constexpr bool PERM = true;
    gbf16_t* O; int ldc; const gfloat* rs;
    __device__ __forceinline__ void operator()(const f32x4 (&acc)[2][2][4][2], const Unit& u, int wr, int wc, int fr, int fq) const {
        const int row0 = u.pm * BM + wr * 64 + fr, col0 = u.pn * BM + wc * 32 + 8 * fq;
#pragma unroll
        for (int ai = 0; ai < 2; ++ai)
#pragma unroll
            for (int m = 0; m < 4; ++m) { const int row = row0 + ai * HALF + m * 16; const float sc = rs[row]; gbf16_t* rowp = O + (size_t)row * ldc + col0;
#pragma unroll
                for (int bj = 0; bj < 2; ++bj) { const f32x4 v0 = acc[ai][bj][m][0] * sc, v1 = acc[ai][bj][m][1] * sc;
                    u32x4 w; w.x = cvt_pk_bf16(v0[0], v0[1]); w.y = cvt_pk_bf16(v0[2], v0[3]); w.z = cvt_pk_bf16(v1[0], v1[1]); w.w = cvt_pk_bf16(v1[2], v1[3]);
                    *(gu32x4*)(rowp + bj * HALF) = w; } }
    }
};
__device__ __forceinline__ float silu_mul(float g, float u) { const float e = __builtin_amdgcn_exp2f(-g * LOG2E); return g * __builtin_amdgcn_rcpf(1.0f + e) * u; }
struct EpiSwiglu {
    static constexpr bool PERM = true;
    gbf16_t* O; int ldc; const gfloat* rs;
    __device__ __forceinline__ void operator()(const f32x4 (&acc)[2][2][4][2], const Unit& u, int wr, int wc, int fr, int fq) const {
        const int row0 = u.pm * BM + wr * 64 + fr, col0 = u.pn * HALF + wc * 32 + 8 * fq;
#pragma unroll
        for (int ai = 0; ai < 2; ++ai)
#pragma unroll
            for (int m = 0; m < 4; ++m) { const int row = row0 + ai * HALF + m * 16; const float sc = rs[row];
                const f32x4 g0 = acc[ai][0][m][0] * sc, g1 = acc[ai][0][m][1] * sc, u0 = acc[ai][1][m][0] * sc, u1 = acc[ai][1][m][1] * sc;
                u32x4 w; w.x = cvt_pk_bf16(silu_mul(g0[0], u0[0]), silu_mul(g0[1], u0[1])); w.y = cvt_pk_bf16(silu_mul(g0[2], u0[2]), silu_mul(g0[3], u0[3]));
                w.z = cvt_pk_bf16(silu_mul(g1[0], u1[0]), silu_mul(g1[1], u1[1])); w.w = cvt_pk_bf16(silu_mul(g1[2], u1[2]), silu_mul(g1[3], u1[3]));
                *(gu32x4*)(O + (size_t)row * ldc + col0) = w; }
    }
};
struct EpiResidual {
    static constexpr bool PERM = false;
    const gfloat* src_real; const gfloat* src_meta; gfloat* dst_real; gfloat* dst_meta;
    __device__ __forceinline__ void operator()(const f32x4 (&acc)[2][2][4][2], const Unit& u, int wr, int wc, int fr, int fq) const {
        const int row0 = u.pm * BM + wr * 64 + fr, col0 = u.pn * BM + wc * 32 + 4 * fq;
#pragma unroll
        for (int ai = 0; ai < 2; ++ai)
#pragma unroll
            for (int m = 0; m < 4; ++m) { const int row = row0 + ai * HALF + m * 16;
                if (row < NROWS) {
                    const gfloat* s = row < NREAL ? src_real + (size_t)row * DM : src_meta + (size_t)(row - NREAL) * DM;
                    gfloat* d = row < NREAL ? dst_real + (size_t)row * DM : dst_meta + (size_t)(row - NREAL) * DM;
#pragma unroll
                    for (int bj = 0; bj < 2; ++bj)
#pragma unroll
                        for (int n = 0; n < 2; ++n) { const int c = col0 + bj * HALF + n * 16; *(gf32x4*)(d + c) = *(const gf32x4*)(s + c) + acc[ai][bj][m][n]; }
                } }
    }
};

template <class Epi, class Sched>
__device__ __forceinline__ void gemm_phase(LAS unsigned char* lds, const Gemm g, const Sched& S, const Epi& E) {
    int tid_ = threadIdx.x; asm volatile("" : "+v"(tid_));
    const int tid = tid_, wid = __builtin_amdgcn_readfirstlane(tid >> 6), lane = tid & 63, wr = wid >> 2, wc = wid & 3, fr = lane & 15, fq = lane >> 4;
    const int K = g.K, nt = K / BK, lda = g.lda;
    unsigned voffA[2], voffB[2];
#pragma unroll
    for (int i = 0; i < 2; ++i) { int R, C; stage_rc(tid * 16 + i * 8192, R, C); const int Rb = Epi::PERM ? ((R & ~31) + perm32(R & 31)) : R;
        voffA[i] = (unsigned)(R * lda + C) * 2u; voffB[i] = (unsigned)(Rb * K + C) * 2u; }
    const size_t kstep = (size_t)(BK * 2);
    const size_t hstepA = (size_t)HALF * lda * 2, hstepB = (size_t)HALF * K * 2;
    const size_t tstepA = 2 * hstepA, tstepB = 2 * hstepB;
    const unsigned ldsw = (unsigned)wid * 1024u;
    const int aoff = lds_byte(wr * 64 + fr, fq * 8), boff = lds_byte(wc * 32 + fr, fq * 8);
#define PG8_SA(b, h) (((b) * 2 + (h)) * HTB)
#define PG8_SB(b, h) ((4 + (b) * 2 + (h)) * HTB)
#define PG8_STAGE(bufoff, gbase, voff) do { _Pragma("unroll") for (int _i = 0; _i < 2; ++_i) \
        __builtin_amdgcn_global_load_lds((const gunsigned*)((const gchar*)(gbase) + (voff)[_i]), (LAS unsigned*)(lds + (bufoff) + ldsw + _i * 8192), 16, 0, 0); } while (0)
#define PG8_LDA(dst, b, h) do { _Pragma("unroll") for (int m = 0; m < 4; ++m) _Pragma("unroll") for (int k = 0; k < 2; ++k) dst[m][k] = *(const LAS bf16x8*)(lds + PG8_SA(b, h) + aoff + m * 2048 + k * 1024); } while (0)
#define PG8_LDB(dst, b, h) do { _Pragma("unroll") for (int n = 0; n < 2; ++n) _Pragma("unroll") for (int k = 0; k < 2; ++k) dst[n][k] = *(const LAS bf16x8*)(lds + PG8_SB(b, h) + boff + n * 2048 + k * 1024); } while (0)
#define PG8_MMA(ai, bj, At, Bt) do { __builtin_amdgcn_s_setprio(1); _Pragma("unroll") for (int m = 0; m < 4; ++m) _Pragma("unroll") for (int n = 0; n < 2; ++n) _Pragma("unroll") for (int k = 0; k < 2; ++k) \
        acc[ai][bj][m][n] = __builtin_amdgcn_mfma_f32_16x16x32_bf16(Bt[n][k], At[m][k], acc[ai][bj][m][n], 0, 0, 0); __builtin_amdgcn_s_setprio(0); } while (0)
#define PG8_WAIT_V(n) asm volatile("s_waitcnt vmcnt(" #n ")" ::: "memory")
#define PG8_WAIT_L(n) asm volatile("s_waitcnt lgkmcnt(" #n ")" ::: "memory")
#define PG8_BAR __builtin_amdgcn_s_barrier()
#define PG8_SCHED __builtin_amdgcn_sched_barrier(0)
    Unit cur, nxt; int ui = 0;
    if (!S.next(0, cur)) return;
    f32x4 acc[2][2][4][2];
#pragma unroll
    for (int a = 0; a < 2; ++a)
#pragma unroll
        for (int b = 0; b < 2; ++b)
#pragma unroll
            for (int m = 0; m < 4; ++m)
#pragma unroll
                for (int n = 0; n < 2; ++n) acc[a][b][m][n] = (f32x4){0.f, 0.f, 0.f, 0.f};
    bf16x8 At[4][2], B0[2][2], B1[2][2];
    const gchar* cA = (const gchar*)g.A + (size_t)cur.pm * tstepA; const gchar* cB = (const gchar*)g.Bt + (size_t)cur.pn * tstepB;
    PG8_STAGE(PG8_SB(0, 0), cB, voffB); PG8_STAGE(PG8_SB(0, 1), cB + hstepB, voffB); PG8_STAGE(PG8_SA(0, 0), cA, voffA); PG8_STAGE(PG8_SA(0, 1), cA + hstepA, voffA);
    if (wr == 1) PG8_BAR;
    PG8_WAIT_V(2); PG8_BAR;
    PG8_STAGE(PG8_SB(1, 0), cB + kstep, voffB); PG8_STAGE(PG8_SA(1, 0), cA + kstep, voffA); PG8_STAGE(PG8_SB(1, 1), cB + hstepB + kstep, voffB);
    PG8_WAIT_V(6); PG8_BAR;
    for (;;) {
        const bool has_next = S.next(ui + 1, nxt);
        const gchar* nA = has_next ? (const gchar*)g.A + (size_t)nxt.pm * tstepA : cA; const gchar* nB = has_next ? (const gchar*)g.Bt + (size_t)nxt.pn * tstepB : cB;
        for (int t = 0; t < nt; t += 2) {
            const bool last = (t == nt - 2);
            const gchar* a1 = cA + (size_t)(t + 1) * kstep;
            const gchar* a2 = last ? nA : cA + (size_t)(t + 2) * kstep; const gchar* b2 = last ? nB : cB + (size_t)(t + 2) * kstep;
            const gchar* a3 = a2 + kstep; const gchar* b3 = b2 + kstep;
            PG8_LDB(B0, 0, 0); PG8_LDB(B1, 0, 1); PG8_SCHED; PG8_LDA(At, 0, 0); PG8_STAGE(PG8_SA(1, 1), a1 + hstepA, voffA);
            PG8_WAIT_V(8); PG8_WAIT_L(0); PG8_BAR; PG8_MMA(0, 0, At, B0); PG8_MMA(0, 1, At, B1); PG8_BAR; PG8_SCHED;
            PG8_LDA(At, 0, 1); PG8_STAGE(PG8_SB(0, 0), b2, voffB); PG8_STAGE(PG8_SB(0, 1), b2 + hstepB, voffB); PG8_STAGE(PG8_SA(0, 0), a2, voffA);
            PG8_WAIT_V(8); PG8_WAIT_L(0); PG8_BAR; PG8_MMA(1, 0, At, B0); PG8_MMA(1, 1, At, B1); PG8_BAR; PG8_SCHED;
            PG8_LDB(B0, 1, 0); PG8_LDB(B1, 1, 1); PG8_SCHED; PG8_LDA(At, 1, 0); PG8_STAGE(PG8_SA(0, 1), a2 + hstepA, voffA);
            PG8_WAIT_V(8); PG8_WAIT_L(0); PG8_BAR; PG8_MMA(0, 0, At, B0); PG8_MMA(0, 1, At, B1); PG8_BAR; PG8_SCHED;
            PG8_LDA(At, 1, 1); PG8_STAGE(PG8_SB(1, 0), b3, voffB); PG8_STAGE(PG8_SB(1, 1), b3 + hstepB, voffB); PG8_STAGE(PG8_SA(1, 0), a3, voffA);
            PG8_WAIT_V(8); PG8_WAIT_L(0); PG8_BAR; PG8_MMA(1, 0, At, B0); PG8_MMA(1, 1, At, B1); PG8_BAR; PG8_SCHED;
        }
        if (wr == 0) PG8_BAR;
        E(acc, cur, wr, wc, fr, fq);
        if (!has_next) break;
#pragma unroll
        for (int a = 0; a < 2; ++a)
#pragma unroll
            for (int b = 0; b < 2; ++b)
#pragma unroll
                for (int m = 0; m < 4; ++m)
#pragma unroll
                    for (int n = 0; n < 2; ++n) acc[a][b][m][n] = (f32x4){0.f, 0.f, 0.f, 0.f};
        cur = nxt; cA = nA; cB = nB; ++ui;
        if (wr == 1) PG8_BAR;
    }
    PG8_WAIT_V(0);
    PG8_BAR;
#undef PG8_SA
#undef PG8_SB
#undef PG8_STAGE
#undef PG8_LDA
#undef PG8_LDB
#undef PG8_MMA
#undef PG8_WAIT_V
#undef PG8_WAIT_L
#undef PG8_BAR
#undef PG8_SCHED
}
}

namespace att {
#define SBAR() __builtin_amdgcn_sched_barrier(0)
constexpr int OFF_K = 0, OFF_V = 24576, OFF_WS = 24576 + 16384, ATT_LDS = OFF_WS + 8 * 64 * 4;
__device__ __forceinline__ int crow(int r, int hi) { return (r & 3) + 8 * (r >> 2) + 4 * hi; }
__device__ __forceinline__ int v_st(int k, int c) { const int kk = (k & ~0xC) | ((k & 4) << 1) | ((k & 8) >> 1); return ((kk >> 3) * 4 + (c >> 5)) * 512 + ((kk & 7) * 32 + (c & 31)) * 2; }
__device__ __forceinline__ int v_rd_base(int lane) { return ((lane & 3) << 3) | (((lane >> 2) & 3) << 6) | (((lane >> 4) & 1) << 5) | (((lane >> 5) & 1) << 8); }
constexpr int v_rd_off(int d0, int ks, int half) { return d0 * 512 + ks * 4096 + half * 2048; }
template <int OFF> __device__ __forceinline__ s16x4 tr_read(int vb) {
    s16x4 r; asm volatile("ds_read_b64_tr_b16 %0, %1 offset:%2" : "=&v"(r) : "v"(vb), "i"(OFF) : "memory"); return r;
}
template <int D0> __device__ __forceinline__ void pv_one(f32x16& od, int vb, bf16x8 pa0, bf16x8 pa1, bf16x8 pa2, bf16x8 pa3) {
    const s16x4 l0 = tr_read<v_rd_off(D0, 0, 0)>(vb), h0 = tr_read<v_rd_off(D0, 0, 1)>(vb), l1 = tr_read<v_rd_off(D0, 1, 0)>(vb), h1 = tr_read<v_rd_off(D0, 1, 1)>(vb);
    const s16x4 l2 = tr_read<v_rd_off(D0, 2, 0)>(vb), h2 = tr_read<v_rd_off(D0, 2, 1)>(vb), l3 = tr_read<v_rd_off(D0, 3, 0)>(vb), h3 = tr_read<v_rd_off(D0, 3, 1)>(vb);
    asm volatile("s_waitcnt lgkmcnt(0)" ::: "memory"); SBAR();
#define PK(L, H) (bf16x8){L[0], L[1], L[2], L[3], H[0], H[1], H[2], H[3]}
    od = __builtin_amdgcn_mfma_f32_32x32x16_bf16(pa0, PK(l0, h0), od, 0, 0, 0);
    od = __builtin_amdgcn_mfma_f32_32x32x16_bf16(pa1, PK(l1, h1), od, 0, 0, 0);
    od = __builtin_amdgcn_mfma_f32_32x32x16_bf16(pa2, PK(l2, h2), od, 0, 0, 0);
    od = __builtin_amdgcn_mfma_f32_32x32x16_bf16(pa3, PK(l3, h3), od, 0, 0, 0);
#undef PK
}
__device__ __forceinline__ int key_row(int b, int p) { p = p < LSEQ ? p : LSEQ - 1; return p < NMETA ? NREAL + p : b * SEQ + p - NMETA; }

template <int DQK>
__device__ __forceinline__ void attn_map(const gbf16_t* __restrict__ Qp, int ldq, const gbf16_t* __restrict__ Kp, int ldk, const gbf16_t* __restrict__ Vp, int ldv,
                                         int b, int qpos0, int NT, f32x16 (&o)[4], float& l_out, LAS char* lds) {
    constexpr int RB = DQK * 2, CPR = DQK / 8, NKC = (64 * CPR) / 512, ND = DQK / 16;
    int tid_ = threadIdx.x; asm volatile("" : "+v"(tid_));
    const int tid = tid_, wid = __builtin_amdgcn_readfirstlane(tid >> 6), lane = tid & 63, r32 = lane & 31, hi = lane >> 5;
    LAS char* K_lds = lds + OFF_K; LAS char* V_lds = lds + OFF_V; LAS float* al_l = (LAS float*)(lds + OFF_WS) + wid * 64;
    bf16x8 qr[ND];
    { const gbf16_t* Qw = Qp + (size_t)(wid * 32 + r32) * ldq + hi * 8;
#pragma unroll
      for (int d0 = 0; d0 < ND; ++d0) qr[d0] = *(const gbf16x8*)(Qw + d0 * 16); }
    float m_reg = -1e30f, l_reg = 0.f;
#pragma unroll
    for (int d = 0; d < 4; ++d) o[d] = f32x16{};
    const int vb = (int)(unsigned)(uintptr_t)V_lds + v_rd_base(lane);
    const int qpos = qpos0 + wid * 32 + r32, wq_min = qpos0 + wid * 32, wq_max = wq_min + 31;
    int kb4[4];
#pragma unroll
    for (int i = 0; i < 4; ++i) kb4[i] = r32 * RB + (((i * 2 + hi) ^ (r32 & 7)) << 4);
    bf16x8 kst[NKC], vst[2];
#define ATT_SLOAD(j) do { \
        _Pragma("unroll") for (int i_ = 0; i_ < NKC; ++i_) { const int c_ = tid + i_ * 512, row_ = c_ / CPR, cc_ = c_ % CPR; \
            kst[i_] = *(const gbf16x8*)(Kp + (size_t)key_row(b, 64 * (j) + row_) * ldk + cc_ * 8); } \
        _Pragma("unroll") for (int i_ = 0; i_ < 2; ++i_) { const int row_ = (tid >> 4) + 32 * i_, col_ = (tid & 15) * 8; \
            vst[i_] = *(const gbf16x8*)(Vp + (size_t)key_row(b, 64 * (j) + row_) * ldv + col_); } } while (0)
#define ATT_SWRITE() do { \
        _Pragma("unroll") for (int i_ = 0; i_ < NKC; ++i_) { const int c_ = tid + i_ * 512, row_ = c_ / CPR, cc_ = c_ % CPR; \
            *(LAS bf16x8*)(K_lds + row_ * RB + ((cc_ * 16) ^ ((row_ & 7) << 4))) = kst[i_]; } \
        _Pragma("unroll") for (int i_ = 0; i_ < 2; ++i_) { const int row_ = (tid >> 4) + 32 * i_, col_ = (tid & 15) * 8; \
            *(LAS bf16x8*)(V_lds + v_st(row_, col_)) = vst[i_]; } } while (0)
    ATT_SLOAD(0);
    for (int j = 0; j < NT; ++j) {
        __syncthreads();
        ATT_SWRITE();
        __syncthreads();
        if (j + 1 < NT) ATT_SLOAD(j + 1);
        if (64 * j <= wq_max) {
            f32x16 p0 = f32x16{}, p1 = f32x16{};
#pragma unroll
            for (int d0 = 0; d0 < ND; ++d0) { const LAS char* kp_ = K_lds + kb4[d0 & 3] + (d0 >> 2) * 128;
                const bf16x8 b0 = *(const LAS bf16x8*)(kp_);
                const bf16x8 b1 = *(const LAS bf16x8*)(kp_ + 32 * RB);
                p0 = __builtin_amdgcn_mfma_f32_32x32x16_bf16(b0, qr[d0], p0, 0, 0, 0);
                p1 = __builtin_amdgcn_mfma_f32_32x32x16_bf16(b1, qr[d0], p1, 0, 0, 0);
                if ((d0 & 3) == 3) SBAR(); }
            if (64 * j + 63 > wq_min) {
#pragma unroll
                for (int r = 0; r < 16; ++r) { const int kp = 64 * j + crow(r, hi); if (kp > qpos) p0[r] = -1e30f; if (kp + 32 > qpos) p1[r] = -1e30f; }
            }
            float pmax = p0[0];
#pragma unroll
            for (int r = 1; r < 16; ++r) pmax = fmaxf(pmax, p0[r]);
#pragma unroll
            for (int r = 0; r < 16; ++r) pmax = fmaxf(pmax, p1[r]);
            { auto rr = __builtin_amdgcn_permlane32_swap(__float_as_uint(pmax), __float_as_uint(pmax), false, false);
              pmax = fmaxf(__uint_as_float(rr[0]), __uint_as_float(rr[1])); }
            const float mn = fmaxf(m_reg, pmax), alpha = __builtin_amdgcn_exp2f(m_reg - mn); m_reg = mn;
#pragma unroll
            for (int r = 0; r < 16; ++r) { p0[r] = __builtin_amdgcn_exp2f(p0[r] - mn); p1[r] = __builtin_amdgcn_exp2f(p1[r] - mn); }
            float ps = 0.f;
#pragma unroll
            for (int r = 0; r < 16; ++r) ps += p0[r] + p1[r];
            { auto rr = __builtin_amdgcn_permlane32_swap(__float_as_uint(ps), __float_as_uint(ps), false, false);
              ps = __uint_as_float(rr[0]) + __uint_as_float(rr[1]); }
            l_reg = l_reg * alpha + ps;
            bf16x8 pa0, pa1, pa2, pa3;
#define PK4(P, BASE, OUT) do { unsigned a0 = cvt_pk_bf16(P[BASE + 0], P[BASE + 1]), a1 = cvt_pk_bf16(P[BASE + 2], P[BASE + 3]);   \
    unsigned b0_ = cvt_pk_bf16(P[BASE + 4], P[BASE + 5]), b1_ = cvt_pk_bf16(P[BASE + 6], P[BASE + 7]);                              \
    auto r0 = __builtin_amdgcn_permlane32_swap(a0, b0_, false, false); auto r1 = __builtin_amdgcn_permlane32_swap(a1, b1_, false, false); \
    u32x4 w = {r0[0], r1[0], r0[1], r1[1]}; OUT = __builtin_bit_cast(bf16x8, w); } while (0)
            PK4(p0, 0, pa0); PK4(p0, 8, pa1); PK4(p1, 0, pa2); PK4(p1, 8, pa3);
#undef PK4
            if (__any(alpha < 1.f)) {
                if (hi == 0) al_l[r32] = alpha;
                LDS_WAIT();
#pragma unroll
                for (int r = 0; r < 16; ++r) { const float a = al_l[crow(r, hi)];
#pragma unroll
                    for (int d = 0; d < 4; ++d) o[d][r] *= a; }
            }
            pv_one<0>(o[0], vb, pa0, pa1, pa2, pa3); pv_one<1>(o[1], vb, pa0, pa1, pa2, pa3); pv_one<2>(o[2], vb, pa0, pa1, pa2, pa3); pv_one<3>(o[3], vb, pa0, pa1, pa2, pa3);
        }
    }
#undef ATT_SLOAD
#undef ATT_SWRITE
    l_out = l_reg;
}
__device__ __forceinline__ void row_recip(float l, float (&rli)[16], LAS char* lds, int wid, int r32, int hi) {
    LAS float* li_l = (LAS float*)(lds + OFF_WS) + wid * 64 + 32;
    if (hi == 0) li_l[r32] = l;
    LDS_WAIT();
#pragma unroll
    for (int r = 0; r < 16; ++r) rli[r] = __builtin_amdgcn_rcpf(li_l[crow(r, hi)]);
    LDS_WAIT();
}
#undef SBAR
}

struct Params { const float* in[21]; float* out; unsigned char* ws; int s_lo, s_hi; };
struct DParams { const gfloat* in[21]; gfloat* out; guchar* ws; int s_lo, s_hi; };
enum { I_X = 0, I_META, I_ATTN_NORM, I_W_IN, I_QA_NORM, I_W_Q_UP, I_KVA_NORM, I_W_KV_UP, I_Q_NORM, I_K_NORM, I_DQ_NORM, I_DK_NORM, I_LQ1, I_LK1, I_LQ2, I_LK2, I_SUBLN, I_W_O, I_FFN_NORM,
       I_W_GU, I_W_D };
constexpr int LDS_BYTES = 147456;
constexpr int NTHREADS = 512, NWAVES = 8;

struct Frame {
    LAS unsigned char* lds; DParams p; int tid, lane, wave, vcu, G, gw, ngw;
};

__device__ __forceinline__ void transpose_item(const gfloat* W, int ldw, int Ksrc, const gfloat* gain, gbf16_t* WT, int Kd, int k0, int sc0, int dr0, LAS float* scr, int lane) {
    const bool zero = (sc0 < 0) || (k0 >= Ksrc);
    const int c = lane & 7;
    if (zero) {
#pragma unroll
        for (int j = 0; j < 4; ++j) { const int n = (lane >> 3) + 8 * j; *(gu32x4*)(WT + (size_t)(dr0 + n) * Kd + k0 + 8 * c) = (u32x4){0u, 0u, 0u, 0u}; }
        return;
    }
#pragma unroll 8
    for (int i = 0; i < 32; ++i) { const int kk = 2 * i + (lane >> 5); const float gsc = gain ? gain[k0 + kk] : 1.0f; scr[kk * 33 + (lane & 31)] = W[(size_t)(k0 + kk) * ldw + sc0 + (lane & 31)] * gsc; }
    LDS_WAIT(); asm volatile("" ::: "memory");
#pragma unroll
    for (int j = 0; j < 4; ++j) { const int n = (lane >> 3) + 8 * j; const LAS float* s = scr + (8 * c) * 33 + n;
        u32x4 o; o.x = pk2(s[0 * 33], s[1 * 33]); o.y = pk2(s[2 * 33], s[3 * 33]); o.z = pk2(s[4 * 33], s[5 * 33]); o.w = pk2(s[6 * 33], s[7 * 33]);
        *(gu32x4*)(WT + (size_t)(dr0 + n) * Kd + k0 + 8 * c) = o; }
    LDS_WAIT(); asm volatile("" ::: "memory");
}
__device__ __forceinline__ void stage_prep(Frame& F) {
    LAS float* scr = (LAS float*)(F.lds + F.wave * 16384);
    const DParams& P = F.p;
    constexpr int IT_IN = 16 * 64, IT_Q = 4 * 32, IT_KV = 4 * 32, IT_O = 16 * 32, IT_GU = 16 * 176, IT_D = 44 * 32, IT_L = IT_IN + IT_Q + IT_KV + IT_O + IT_GU + IT_D;
    for (int it = F.gw; it < 2 * IT_L; it += F.ngw) {
        const int l = it / IT_L; int r = it % IT_L;
        gbf16_t* wb = (gbf16_t*)(P.ws + WS_W + (size_t)l * W_LAYER);
        if (r < IT_IN) { const int kb = r / 64, g = r % 64;
            transpose_item(P.in[I_W_IN] + (size_t)l * DM * INW, INW, DM, P.in[I_ATTN_NORM] + l * DM, (gbf16_t*)((gchar*)wb + W_IN), DM, kb * 64, (32 * g < INW) ? 32 * g : -1, 32 * g, scr, F.lane); continue; }
        r -= IT_IN;
        if (r < IT_Q) { const int kb = r / 32, g = r % 32, h = g >> 3, d0 = (g & 7) * 32;
            transpose_item(P.in[I_W_Q_UP] + (size_t)l * 256 * 768, 768, 256, P.in[I_QA_NORM] + l * 256, (gbf16_t*)((gchar*)wb + W_Q), 256, kb * 64, d0 < 192 ? h * 192 + d0 : -1, 32 * g, scr, F.lane); continue; }
        r -= IT_Q;
        if (r < IT_KV) { const int kb = r / 32, g = r % 32;
            transpose_item(P.in[I_W_KV_UP] + (size_t)l * 128 * 1024, 1024, 128, P.in[I_KVA_NORM] + l * 128, (gbf16_t*)((gchar*)wb + W_KV), 256, kb * 64, 32 * g, 32 * g, scr, F.lane); continue; }
        r -= IT_KV;
        if (r < IT_O) { const int kb = r / 32, g = r % 32;
            transpose_item(P.in[I_W_O] + (size_t)l * DM * DM, DM, DM, nullptr, (gbf16_t*)((gchar*)wb + W_O), DM, kb * 64, 32 * g, 32 * g, scr, F.lane); continue; }
        r -= IT_O;
        if (r < IT_GU) { const int kb = r / 176, g = r % 176, pn = g >> 3, half = (g & 7) >> 2, i0 = (g & 3) * 32;
            transpose_item(P.in[I_W_GU] + (size_t)l * DM * 2 * DFF, 2 * DFF, DM, P.in[I_FFN_NORM] + l * DM, (gbf16_t*)((gchar*)wb + W_GU), DM, kb * 64, half * DFF + pn * 128 + i0, 32 * g, scr, F.lane); continue; }
        r -= IT_GU;
        { const int kb = r / 32, g = r % 32;
          transpose_item(P.in[I_W_D] + (size_t)l * DFF * DM, DM, DFF, nullptr, (gbf16_t*)((gchar*)wb + W_D), DFF, kb * 64, 32 * g, 32 * g, scr, F.lane); }
    }
    gfloat* COS = (gfloat*)(P.ws + WS_COS); gfloat* SIN = (gfloat*)(P.ws + WS_SIN);
    for (int i = blockIdx.x * NTHREADS + F.tid; i < LSEQ * 32; i += F.G * NTHREADS) {
        const int pos = i >> 5, m = i & 31;
        const float inv = 1.0f / powf(10000.0f, (float)(2 * m) / 64.0f), ang = (float)pos * inv;
        COS[i] = cosf(ang); SIN[i] = sinf(ang);
    }
    if (blockIdx.x == 0 && F.tid < DEPTH) {
        const int l = F.tid; float a = 0.f, b = 0.f;
        for (int i = 0; i < 64; ++i) { a += P.in[I_LQ1][l * 64 + i] * P.in[I_LK1][l * 64 + i]; b += P.in[I_LQ2][l * 64 + i] * P.in[I_LK2][l * 64 + i]; }
        const float lam_init = 0.8f - 0.6f * expf(-0.3f * (float)l);
        ((gfloat*)(P.ws + WS_LAM))[l] = expf(a) - expf(b) + lam_init;
    }
}

__device__ __forceinline__ void stage_cast(Frame& F, const gfloat* h_real, const gfloat* h_meta) {
    gbf16_t* XN = (gbf16_t*)(F.p.ws + WS_AO); gfloat* RH = (gfloat*)(F.p.ws + WS_RH);
    for (int row = F.gw; row < NROWS; row += F.ngw) {
        const gfloat* hr = row < NREAL ? h_real + (size_t)row * DM : h_meta + (size_t)(row - NREAL) * DM;
        f32x4 v[4]; float s = 0.f;
#pragma unroll
        for (int j = 0; j < 4; ++j) { v[j] = *((const gf32x4*)hr + F.lane + 64 * j); s += (v[j].x * v[j].x + v[j].y * v[j].y) + (v[j].z * v[j].z + v[j].w * v[j].w); }
        s = wave_sum(s);
        if (F.lane == 0) RH[row] = 1.0f / sqrtf(s * (1.0f / DM) + EPS);
        gu32x2* o8 = (gu32x2*)(XN + (size_t)row * DM) + F.lane;
#pragma unroll
        for (int j = 0; j < 4; ++j) o8[64 * j] = (u32x2){pk2(v[j].x, v[j].y), pk2(v[j].z, v[j].w)};
    }
}

__device__ __forceinline__ void stage_postproj(Frame& F, int l) {
    const DParams& P = F.p;
    const gbf16_t* PROJ = (const gbf16_t*)(P.ws + WS_PROJ); gbf16_t* QD = (gbf16_t*)(P.ws + WS_QD); gbf16_t* KD = (gbf16_t*)(P.ws + WS_KD);
    gfloat* RQ = (gfloat*)(P.ws + WS_RQ); gfloat* RKV = (gfloat*)(P.ws + WS_RKV);
    const gfloat* COS = (const gfloat*)(P.ws + WS_COS); const gfloat* SIN = (const gfloat*)(P.ws + WS_SIN);
    const float gq = P.in[I_DQ_NORM][l * 64 + F.lane], gk = P.in[I_DK_NORM][l * 64 + F.lane];
    for (int row = F.gw; row < NROWS; row += F.ngw) {
        const int pos = row < NREAL ? NMETA + (row & (SEQ - 1)) : row - NREAL;
        const gbf16_t* pr = PROJ + (size_t)row * INWP;
        { const u32x2 v = *(const gu32x2*)(pr + PC_CQ + F.lane * 4); const float a = bf2f(v.x & 0xffffu), b = bf2f(v.x >> 16), c = bf2f(v.y & 0xffffu), d = bf2f(v.y >> 16);
          const float s = wave_sum((a * a + b * b) + (c * c + d * d)); if (F.lane == 0) RQ[row] = 1.0f / sqrtf(s * (1.0f / 256.0f) + EPS); }
        { const unsigned v = *(const gunsigned*)(pr + PC_CKV + F.lane * 2); const float a = bf2f(v & 0xffffu), b = bf2f(v >> 16);
          const float s = wave_sum(a * a + b * b); if (F.lane == 0) RKV[row] = 1.0f / sqrtf(s * (1.0f / 128.0f) + EPS); }
        const float cs = COS[pos * 32 + (F.lane & 31)], sn = SIN[pos * 32 + (F.lane & 31)];
#pragma unroll 4
        for (int seg = 0; seg < 16; ++seg) {
            const float x = bf2f(pr[PC_DQ + seg * 64 + F.lane]);
            const float r = 1.0f / sqrtf(wave_sum(x * x) * (1.0f / 64.0f) + EPS);
            const float y = x * r * (seg < 8 ? gq : gk), pt = __shfl_xor(y, 32);
            const float o = F.lane < 32 ? y * cs - pt * sn : y * cs + pt * sn;
            if (seg < 8) QD[(size_t)row * 512 + seg * 64 + F.lane] = (bf16_t)f2bf(o * CD);
            else KD[(size_t)row * 512 + (seg - 8) * 64 + F.lane] = (bf16_t)f2bf(o);
        }
    }
}

__device__ __forceinline__ void stage_mla_qk(Frame& F, int l) {
    const DParams& P = F.p;
    const gbf16_t* PROJ = (const gbf16_t*)(P.ws + WS_PROJ); const gbf16_t* QRAW = (const gbf16_t*)(P.ws + WS_AO); const gbf16_t* KVRAW = (const gbf16_t*)(P.ws + WS_KVRAW);
    gbf16_t* QA = (gbf16_t*)(P.ws + WS_QA); gbf16_t* KA = (gbf16_t*)(P.ws + WS_KA);
    const gfloat* COS = (const gfloat*)(P.ws + WS_COS); const gfloat* SIN = (const gfloat*)(P.ws + WS_SIN);
    const gfloat* gqp = P.in[I_Q_NORM] + l * 192; const gfloat* gkp = P.in[I_K_NORM] + l * 192;
    const float gq0 = gqp[F.lane], gq1 = gqp[64 + F.lane], gq2 = gqp[128 + F.lane], gk0 = gkp[F.lane], gk1 = gkp[64 + F.lane], gk2 = gkp[128 + F.lane];
    for (int row = F.gw; row < NROWS; row += F.ngw) {
        const int pos = row < NREAL ? NMETA + (row & (SEQ - 1)) : row - NREAL;
        const float cs = COS[pos * 32 + (F.lane & 31)], sn = SIN[pos * 32 + (F.lane & 31)];
        const float kr = bf2f(PROJ[(size_t)row * INWP + PC_KR + F.lane]);
#pragma unroll
        for (int h = 0; h < 4; ++h) {
            { const gbf16_t* qp = QRAW + (size_t)row * 1024 + h * 256;
              const float x0 = bf2f(qp[F.lane]), x1 = bf2f(qp[64 + F.lane]), x2 = bf2f(qp[128 + F.lane]);
              const float r = 1.0f / sqrtf(wave_sum(x0 * x0 + x1 * x1 + x2 * x2) * (1.0f / 192.0f) + EPS);
              const float y0 = x0 * r * gq0, y1 = x1 * r * gq1, y2 = x2 * r * gq2, pt = __shfl_xor(y2, 32);
              const float y2r = F.lane < 32 ? y2 * cs - pt * sn : y2 * cs + pt * sn;
              gbf16_t* qo = QA + (size_t)row * 768 + h * 192;
              qo[F.lane] = (bf16_t)f2bf(y0 * CA); qo[64 + F.lane] = (bf16_t)f2bf(y1 * CA); qo[128 + F.lane] = (bf16_t)f2bf(y2r * CA); }
            { const gbf16_t* kp = KVRAW + (size_t)row * 1024 + h * 256;
              const float x0 = bf2f(kp[F.lane]), x1 = bf2f(kp[64 + F.lane]), x2 = kr;
              const float r = 1.0f / sqrtf(wave_sum(x0 * x0 + x1 * x1 + x2 * x2) * (1.0f / 192.0f) + EPS);
              const float y0 = x0 * r * gk0, y1 = x1 * r * gk1, y2 = x2 * r * gk2, pt = __shfl_xor(y2, 32);
              const float y2r = F.lane < 32 ? y2 * cs - pt * sn : y2 * cs + pt * sn;
              gbf16_t* ko = KA + (size_t)row * 768 + h * 192;
              ko[F.lane] = (bf16_t)f2bf(y0); ko[64 + F.lane] = (bf16_t)f2bf(y1); ko[128 + F.lane] = (bf16_t)f2bf(y2r); }
        }
    }
}

__device__ __forceinline__ void attn_unit_mla(Frame& F, int b, int h, int qrow0, int qpos0, int NT, int nvalid) {
    const DParams& P = F.p;
    const gbf16_t* QA = (const gbf16_t*)(P.ws + WS_QA); const gbf16_t* KA = (const gbf16_t*)(P.ws + WS_KA); const gbf16_t* KVRAW = (const gbf16_t*)(P.ws + WS_KVRAW);
    gbf16_t* AO = (gbf16_t*)(P.ws + WS_AO);
    const int r32 = F.lane & 31, hi = F.lane >> 5;
    f32x16 o[4]; float l;
    att::attn_map<192>(QA + (size_t)qrow0 * 768 + h * 192, 768, KA + h * 192, 768, KVRAW + h * 256 + 128, 1024, b, qpos0, NT, o, l, (LAS char*)F.lds);
    float rli[16]; att::row_recip(l, rli, (LAS char*)F.lds, F.wave, r32, hi);
#pragma unroll
    for (int r = 0; r < 16; ++r) { const int lr = F.wave * 32 + att::crow(r, hi);
        if (lr < nvalid) { gbf16_t* op = AO + (size_t)(qrow0 + lr) * DM + h * 128 + r32;
#pragma unroll
            for (int d0 = 0; d0 < 4; ++d0) op[d0 * 32] = (bf16_t)f2bf(o[d0][r] * rli[r]); } }
}
__device__ __forceinline__ void attn_unit_diff(Frame& F, int l_idx, int b, int h, int qrow0, int qpos0, int NT, int nvalid) {
    const DParams& P = F.p;
    const gbf16_t* QD = (const gbf16_t*)(P.ws + WS_QD); const gbf16_t* KD = (const gbf16_t*)(P.ws + WS_KD); const gbf16_t* PROJ = (const gbf16_t*)(P.ws + WS_PROJ);
    gbf16_t* AO = (gbf16_t*)(P.ws + WS_AO);
    gf32x4* tmp = (gf32x4*)((gfloat*)(P.ws + WS_TMP) + ((size_t)blockIdx.x * 512 + F.tid) * 64);
    const int r32 = F.lane & 31, hi = F.lane >> 5;
    const float lam = ((const gfloat*)(P.ws + WS_LAM))[l_idx];
    const float lam_init = 0.8f - 0.6f * expf(-0.3f * (float)l_idx);
    f32x16 o[4]; float lsum; float rli[16];
#pragma unroll 1
    for (int c = 0; c < 2; ++c) {
        att::attn_map<64>(QD + (size_t)qrow0 * 512 + h * 128 + c * 64, 512, KD + h * 128 + c * 64, 512, PROJ + PC_DV + h * 128, INWP, b, qpos0, NT, o, lsum, (LAS char*)F.lds);
        att::row_recip(lsum, rli, (LAS char*)F.lds, F.wave, r32, hi);
        if (c == 0) {
#pragma unroll
            for (int d = 0; d < 4; ++d)
#pragma unroll
                for (int q = 0; q < 4; ++q) tmp[d * 4 + q] = (f32x4){o[d][4 * q] * rli[4 * q], o[d][4 * q + 1] * rli[4 * q + 1], o[d][4 * q + 2] * rli[4 * q + 2], o[d][4 * q + 3] * rli[4 * q + 3]};
        }
    }
    float ss[16];
#pragma unroll
    for (int r = 0; r < 16; ++r) ss[r] = 0.f;
#pragma unroll
    for (int d = 0; d < 4; ++d) {
#pragma unroll
        for (int q = 0; q < 4; ++q) { const f32x4 t = tmp[d * 4 + q];
#pragma unroll
            for (int e = 0; e < 4; ++e) { const int r = 4 * q + e; const float v = t[e] - lam * rli[r] * o[d][r]; o[d][r] = v; ss[r] += v * v; } }
        asm volatile("" ::: "memory"); }
#pragma unroll
    for (int off = 1; off < 32; off <<= 1)
#pragma unroll
        for (int r = 0; r < 16; ++r) ss[r] += __shfl_xor(ss[r], off);
    const gfloat* gs = P.in[I_SUBLN] + l_idx * 128; const float post = 1.0f - lam_init;
    float gcol[4];
#pragma unroll
    for (int d = 0; d < 4; ++d) gcol[d] = gs[d * 32 + r32] * post;
#pragma unroll
    for (int r = 0; r < 16; ++r) { const int lr = F.wave * 32 + att::crow(r, hi); const float rn = 1.0f / sqrtf(ss[r] * (1.0f / 128.0f) + EPS);
        if (lr < nvalid) { gbf16_t* op = AO + (size_t)(qrow0 + lr) * DM + 512 + h * 128 + r32;
#pragma unroll
            for (int d0 = 0; d0 < 4; ++d0) op[d0 * 32] = (bf16_t)f2bf(o[d0][r] * rn * gcol[d0]); } }
}
__device__ __forceinline__ void stage_attention(Frame& F, int l) {
    const int v = F.vcu, bh = v >> 2, s = v & 3, b = bh >> 2, h = bh & 3;
#pragma unroll 1
    for (int u = 0; u < 5; ++u) {
        int type, b_, h_, qrow0, qpos0, NT, nvalid;
        if (u < 4) { const int qb = (u & 1) ? 7 - s : s; type = u >> 1; b_ = b; h_ = h; qrow0 = b * SEQ + qb * 256; qpos0 = NMETA + qb * 256; NT = 4 * qb + 5; nvalid = 256; }
        else { if (v >= 8) break; type = v >> 2; b_ = 0; h_ = v & 3; qrow0 = NREAL; qpos0 = 0; NT = 1; nvalid = NMETA; }
        if (type == 0) attn_unit_mla(F, b_, h_, qrow0, qpos0, NT, nvalid);
        else attn_unit_diff(F, l, b_, h_, qrow0, qpos0, NT, nvalid);
    }
    __syncthreads();
}

constexpr int SPL = 11, NSTAGES = 1 + SPL * DEPTH;
__device__ __forceinline__ bool stage_needs_sync(int st) { return !(st >= 1 && (st - 1) % SPL == 4); }
__device__ __forceinline__ void run_stage(const Params& p, LAS unsigned char* ldsp, int st) {
    Frame F;
    F.lds = ldsp;
    { int t = threadIdx.x; asm volatile("" : "+v"(t)); F.tid = t; }
    { unsigned char* w = p.ws; asm volatile("" : "+s"(w)); F.p.ws = (guchar*)w; }
#pragma unroll
    for (int i = 0; i < 21; ++i) F.p.in[i] = (const gfloat*)p.in[i];
    F.p.out = (gfloat*)p.out; F.p.s_lo = p.s_lo; F.p.s_hi = p.s_hi;
    F.lane = F.tid & 63; F.wave = __builtin_amdgcn_readfirstlane(F.tid >> 6);
    F.G = gridDim.x; { const int bx = blockIdx.x; F.vcu = (F.G % 8 == 0) ? (bx % 8) * (F.G / 8) + bx / 8 : bx; }
    F.gw = blockIdx.x * NWAVES + F.wave; F.ngw = F.G * NWAVES;
    const DParams& P = F.p;
    guchar* ws = P.ws;
    if (st == 0) { stage_prep(F); return; }
    const int l = (st - 1) / SPL, s = (st - 1) % SPL;
    const gchar* wb = (const gchar*)(ws + WS_W + (size_t)l * W_LAYER);
    gfloat* HM = (gfloat*)(ws + WS_HM);
    int kind = -1; pg8::Gemm g{nullptr, nullptr, MP, 0, 0, 0};
    gbf16_t* eo = nullptr; int eld = 0; const gfloat* ers = nullptr;
    const gfloat* sr = nullptr; const gfloat* sm = nullptr;
    switch (s) {
    case 0: stage_cast(F, l == 0 ? P.in[I_X] : P.out, l == 0 ? P.in[I_META] : HM); break;
    case 1: kind = 0; g.A = (const gbf16_t*)(ws + WS_AO); g.Bt = (const gbf16_t*)(wb + W_IN); g.N = INWP; g.K = DM; g.lda = DM; eo = (gbf16_t*)(ws + WS_PROJ); eld = INWP; ers = (const gfloat*)(ws + WS_RH); break;
    case 2: stage_postproj(F, l); break;
    case 3: kind = 0; g.A = (const gbf16_t*)(ws + WS_PROJ) + PC_CQ; g.Bt = (const gbf16_t*)(wb + W_Q); g.N = 1024; g.K = 256; g.lda = INWP; eo = (gbf16_t*)(ws + WS_AO); eld = 1024; ers = (const gfloat*)(ws + WS_RQ); break;
    case 4: kind = 0; g.A = (const gbf16_t*)(ws + WS_PROJ) + PC_CKV; g.Bt = (const gbf16_t*)(wb + W_KV); g.N = 1024; g.K = 256; g.lda = INWP; eo = (gbf16_t*)(ws + WS_KVRAW); eld = 1024; ers = (const gfloat*)(ws + WS_RKV); break;
    case 5: stage_mla_qk(F, l); break;
    case 6: stage_attention(F, l); break;
    case 7: kind = 2; g.A = (const gbf16_t*)(ws + WS_AO); g.Bt = (const gbf16_t*)(wb + W_O); g.N = DM; g.K = DM; g.lda = DM; sr = l == 0 ? P.in[I_X] : P.out; sm = l == 0 ? P.in[I_META] : HM; break;
    case 8: stage_cast(F, P.out, HM); break;
    case 9: kind = 1; g.A = (const gbf16_t*)(ws + WS_AO); g.Bt = (const gbf16_t*)(wb + W_GU); g.N = 2 * DFF; g.K = DM; g.lda = DM; eo = (gbf16_t*)(ws + WS_ACT); eld = DFF; ers = (const gfloat*)(ws + WS_RH); break;
    case 10: kind = 2; g.A = (const gbf16_t*)(ws + WS_ACT); g.Bt = (const gbf16_t*)(wb + W_D); g.N = DM; g.K = DFF; g.lda = DFF; sr = P.out; sm = HM; break;
    }
    if (kind >= 0) {
        pg8::StaticOrder S; S.init(MP, g.N, F.G, (int)blockIdx.x);
        if (kind == 0) { pg8::EpiScaleBf16 E{eo, eld, ers}; pg8::gemm_phase(F.lds, g, S, E); }
        else if (kind == 1) { pg8::EpiSwiglu E{eo, eld, ers}; pg8::gemm_phase(F.lds, g, S, E); }
        else { pg8::EpiResidual E{sr, sm, P.out, HM}; pg8::gemm_phase(F.lds, g, S, E); }
    }
}

__global__ void __launch_bounds__(NTHREADS, 2) stage_kernel(Params p) {
    extern __shared__ __attribute__((aligned(16))) unsigned char lds[];
#pragma unroll 1
    for (int st = p.s_lo; st < p.s_hi; ++st) run_stage(p, (LAS unsigned char*)lds, st);
}
__global__ void __launch_bounds__(NTHREADS, 2) mega_kernel(Params p) {
    extern __shared__ __attribute__((aligned(16))) unsigned char lds[];
    cg::grid_group grid = cg::this_grid();
#pragma unroll 1
    for (int st = p.s_lo; st < p.s_hi; ++st) { if (st > p.s_lo && stage_needs_sync(st)) grid.sync(); run_stage(p, (LAS unsigned char*)lds, st); }
}

extern "C" void kernel_launch(void* const* d_in, const int* in_sizes, int n_in, void* d_out, int out_size, void* d_ws, size_t ws_size, hipStream_t stream) {
    static int state = 0;
    if (state == 0) {
        if (n_in != 21 || in_sizes[0] != NREAL * DM || out_size != NREAL * DM || ws_size < WS_END) {
            fprintf(stderr, "kernel_launch: unexpected shapes: n_in %d in0 %d out %d ws %zu (need %zu)\n", n_in, n_in > 0 ? in_sizes[0] : -1, out_size, ws_size, (size_t)WS_END); state = -1; return; }
        int dev = 0, cus = 0;
        hipGetDevice(&dev); hipDeviceGetAttribute(&cus, hipDeviceAttributeMultiprocessorCount, dev);
        if (hipFuncSetAttribute((const void*)stage_kernel, hipFuncAttributeMaxDynamicSharedMemorySize, LDS_BYTES) != hipSuccess ||
            hipFuncSetAttribute((const void*)mega_kernel, hipFuncAttributeMaxDynamicSharedMemorySize, LDS_BYTES) != hipSuccess) { fprintf(stderr, "kernel_launch: hipFuncSetAttribute failed\n"); state = -1; return; }
        int per_cu = 0;
        hipOccupancyMaxActiveBlocksPerMultiprocessor(&per_cu, (const void*)mega_kernel, NTHREADS, LDS_BYTES);
        (void)hipGetLastError();
        if (cus != 256 || per_cu < 1) { fprintf(stderr, "kernel_launch: needs a 256-CU device with one resident workgroup per CU (cus %d, per_cu %d)\n", cus, per_cu); state = -1; return; }
        state = 1;
    }
    if (state < 0) return;
    Params p{};
    for (int i = 0; i < 21; ++i) p.in[i] = (const float*)d_in[i];
    p.out = (float*)d_out; p.ws = (unsigned char*)d_ws;
#if MK_ONE_LAUNCH
    p.s_lo = 0; p.s_hi = NSTAGES;
    void* args[] = {&p};
    hipError_t e = hipLaunchCooperativeKernel((const void*)mega_kernel, dim3(256), dim3(NTHREADS), args, LDS_BYTES, stream);
    if (e != hipSuccess) fprintf(stderr, "kernel_launch: cooperative launch failed: %s\n", hipGetErrorString(e));
#else
    for (int st = 0; st < NSTAGES; ++st) {
        p.s_lo = st; p.s_hi = st + 1;
        hipLaunchKernelGGL(stage_kernel, dim3(256), dim3(NTHREADS), LDS_BYTES, stream, p);
    }
    const hipError_t le = hipPeekAtLastError();
    if (le != hipSuccess) fprintf(stderr, "kernel_launch: launch failed: %s\n", hipGetErrorName(le));
#endif
}
```

```cpp
#include <hip/hip_runtime.h>
#include <hip/hip_cooperative_groups.h>
#include <cstdio>
#include <cstdint>
namespace cg = cooperative_groups;

#ifndef MK_ONE_LAUNCH
#define MK_ONE_LAUNCH 1
#endif

constexpr int DM = 1024, BATCH = 16, SEQ = 2048, NMETA = 16, DEPTH = 2;
constexpr int NREAL = BATCH * SEQ;
constexpr int NROWS = NREAL + NMETA;
constexpr int MP = 33024;
constexpr int LSEQ = SEQ + NMETA;
constexpr int INW = 1984, INWP = 2048, DFF = 2816;
constexpr float EPS = 1e-6f;
constexpr float LOG2E = 1.4426950408889634f;
constexpr float CA = 0.07216878364870322f * LOG2E;
constexpr float CD = 0.125f * LOG2E;
constexpr int PC_CQ = 0, PC_CKV = 256, PC_KR = 384, PC_DQ = 448, PC_DK = 960, PC_DV = 1472;

constexpr size_t MiB = 1u << 20;
constexpr size_t WS_CTL = 0;
constexpr size_t WS_RH = 1 * MiB;
constexpr size_t WS_RQ = WS_RH + 256 * 1024;
constexpr size_t WS_RKV = WS_RQ + 256 * 1024;
constexpr size_t WS_HM = WS_RKV + 256 * 1024;
constexpr size_t WS_LAM = WS_HM + 64 * 1024;
constexpr size_t WS_COS = 2 * MiB;
constexpr size_t WS_SIN = WS_COS + 512 * 1024;
constexpr size_t WS_W = 4 * MiB;
constexpr size_t W_IN = 0, W_Q = W_IN + (size_t)INWP * DM * 2, W_KV = W_Q + (size_t)1024 * 256 * 2, W_O = W_KV + (size_t)1024 * 256 * 2,
                 W_GU = W_O + (size_t)DM * DM * 2, W_D = W_GU + (size_t)2 * DFF * DM * 2, W_LAYER = W_D + (size_t)DM * DFF * 2;
static_assert(WS_W + 2 * W_LAYER <= 52 * MiB, "weights");
constexpr size_t WS_PROJ = 52 * MiB;
constexpr size_t WS_KVRAW = WS_PROJ + (size_t)MP * INWP * 2;
constexpr size_t WS_QA = WS_KVRAW + (size_t)MP * 1024 * 2;
constexpr size_t WS_KA = WS_QA + (size_t)MP * 768 * 2;
constexpr size_t WS_QD = WS_KA + (size_t)MP * 768 * 2;
constexpr size_t WS_KD = WS_QD + (size_t)MP * 512 * 2;
constexpr size_t WS_AO = WS_KD + (size_t)MP * 512 * 2;
constexpr size_t WS_TMP = WS_AO + (size_t)MP * 1024 * 2;
constexpr size_t WS_END = WS_TMP + (size_t)256 * 64 * 512 * 4;
constexpr size_t WS_ACT = WS_PROJ;
static_assert(WS_ACT + (size_t)MP * DFF * 2 <= WS_QA, "ACT overlay");

#define LAS __attribute__((address_space(3)))
typedef unsigned short bf16_t;
typedef short bf16x8 __attribute__((ext_vector_type(8)));
typedef short s16x4 __attribute__((ext_vector_type(4)));
typedef float f32x4 __attribute__((ext_vector_type(4)));
typedef float f32x16 __attribute__((ext_vector_type(16)));
typedef unsigned u32x4 __attribute__((ext_vector_type(4)));
typedef unsigned u32x2 __attribute__((ext_vector_type(2)));
#define GAS __attribute__((address_space(1)))
typedef GAS bf16_t gbf16_t; typedef GAS float gfloat; typedef GAS unsigned char guchar; typedef GAS char gchar; typedef GAS unsigned gunsigned;
typedef GAS u32x4 gu32x4; typedef GAS u32x2 gu32x2; typedef GAS f32x4 gf32x4; typedef GAS bf16x8 gbf16x8;

__device__ __forceinline__ unsigned f2bf(float f) { unsigned u = __builtin_bit_cast(unsigned, f); return (u + 0x7fffu + ((u >> 16) & 1u)) >> 16; }
__device__ __forceinline__ unsigned pk2(float lo, float hi) { return f2bf(lo) | (f2bf(hi) << 16); }
__device__ __forceinline__ float bf2f(unsigned b) { return __builtin_bit_cast(float, b << 16); }
__device__ __forceinline__ unsigned cvt_pk_bf16(float lo, float hi) { unsigned r; asm volatile("v_cvt_pk_bf16_f32 %0, %1, %2" : "=v"(r) : "v"(lo), "v"(hi)); return r; }
__device__ __forceinline__ float wave_sum(float v) {
#pragma unroll
    for (int o = 1; o < 64; o <<= 1) v += __shfl_xor(v, o);
    return v;
}
#define LDS_WAIT() asm volatile("s_waitcnt lgkmcnt(0)" ::: "memory")

namespace pg8 {
constexpr int BM = 256, BK = 64, HALF = 128, HTB = HALF * BK * 2, STAGE_BYTES = 8 * HTB, NXCD = 8, WGM = 8;
__host__ __device__ __forceinline__ int lds_byte(int r, int c) { const int st = (r >> 4) * 2 + (c >> 5), rr = r & 15, cc = c & 31, ob = rr * 64 + cc * 2; return st * 1024 + (ob ^ (((ob >> 9) & 1) << 5)); }
__host__ __device__ __forceinline__ void stage_rc(int b, int& R, int& C) { const int st = b / 1024, sb = b % 1024, swz = sb ^ (((sb >> 9) & 1) << 5); R = (st >> 1) * 16 + swz / 64; C = (st & 1) * 32 + (swz % 64) / 2; }
__host__ __device__ __forceinline__ int perm32(int rho) { const int n = rho >> 4, i = rho & 15; return 8 * (i >> 2) + 4 * n + (i & 3); }

struct Unit { int pm, pn; };
struct Gemm { const gbf16_t* A; const gbf16_t* Bt; int M, N, K, lda; };

struct StaticOrder {
    int nM, nN, nwg, G, c;
    __device__ void init(int M, int N, int G_, int c_) { nM = M / BM; nN = N / BM; nwg = nM * nN; G = G_; c = c_; }
    __device__ bool next(int i, Unit& u) const {
        const long L = (long)i * G + c; if (L >= nwg) return false;
        int wgid = (int)L; { const int q = nwg / NXCD, r = nwg % NXCD, xcd = wgid % NXCD, off = wgid / NXCD; wgid = (xcd < r ? xcd * (q + 1) : r * (q + 1) + (xcd - r) * q) + off; }
        const int nig = WGM * nN, gid = wgid / nig, fm = gid * WGM, gsz = (nM - fm) < WGM ? (nM - fm) : WGM;
        u.pm = fm + ((wgid % nig) % gsz); u.pn = (wgid % nig) / gsz; return true;
    }
};

struct EpiScaleBf16 {
    static constexpr bool PERM = true;
    gbf16_t* O; int ldc; const gfloat* rs;
    __device__ __forceinline__ void operator()(const f32x4 (&acc)[2][2][4][2], const Unit& u, int wr, int wc, int fr, int fq) const {
        const int row0 = u.pm * BM + wr * 64 + fr, col0 = u.pn * BM + wc * 32 + 8 * fq;
#pragma unroll
        for (int ai = 0; ai < 2; ++ai)
#pragma unroll
            for (int m = 0; m < 4; ++m) { const int row = row0 + ai * HALF + m * 16; const float sc = rs[row]; gbf16_t* rowp = O + (size_t)row * ldc + col0;
#pragma unroll
                for (int bj = 0; bj < 2; ++bj) { const f32x4 v0 = acc[ai][bj][m][0] * sc, v1 = acc[ai][bj][m][1] * sc;
                    u32x4 w; w.x = cvt_pk_bf16(v0[0], v0[1]); w.y = cvt_pk_bf16(v0[2], v0[3]); w.z = cvt_pk_bf16(v1[0], v1[1]); w.w = cvt_pk_bf16(v1[2], v1[3]);
                    *(gu32x4*)(rowp + bj * HALF) = w; } }
    }
};
__device__ __forceinline__ float silu_mul(float g, float u) { const float e = __builtin_amdgcn_exp2f(-g * LOG2E); return g * __builtin_amdgcn_rcpf(1.0f + e) * u; }
struct EpiSwiglu {
    static constexpr bool PERM = true;
    gbf16_t* O; int ldc; const gfloat* rs;
    __device__ __forceinline__ void operator()(const f32x4 (&acc)[2][2][4][2], const Unit& u, int wr, int wc, int fr, int fq) const {
        const int row0 = u.pm * BM + wr * 64 + fr, col0 = u.pn * HALF + wc * 32 + 8 * fq;
#pragma unroll
        for (int ai = 0; ai < 2; ++ai)
#pragma unroll
            for (int m = 0; m < 4; ++m) { const int row = row0 + ai * HALF + m * 16; const float sc = rs[row];
                const f32x4 g0 = acc[ai][0][m][0] * sc, g1 = acc[ai][0][m][1] * sc, u0 = acc[ai][1][m][0] * sc, u1 = acc[ai][1][m][1] * sc;
                u32x4 w; w.x = cvt_pk_bf16(silu_mul(g0[0], u0[0]), silu_mul(g0[1], u0[1])); w.y = cvt_pk_bf16(silu_mul(g0[2], u0[2]), silu_mul(g0[3], u0[3]));
                w.z = cvt_pk_bf16(silu_mul(g1[0], u1[0]), silu_mul(g1[1], u1[1])); w.w = cvt_pk_bf16(silu_mul(g1[2], u1[2]), silu_mul(g1[3], u1[3]));
                *(gu32x4*)(O + (size_t)row * ldc + col0) = w; }
    }
};
struct EpiResidual {
    static constexpr bool PERM = false;
    const gfloat* src_real; const gfloat* src_meta; gfloat* dst_real; gfloat* dst_meta;
    __device__ __forceinline__ void operator()(const f32x4 (&acc)[2][2][4][2], const Unit& u, int wr, int wc, int fr, int fq) const {
        const int row0 = u.pm * BM + wr * 64 + fr, col0 = u.pn * BM + wc * 32 + 4 * fq;
#pragma unroll
        for (int ai = 0; ai < 2; ++ai)
#pragma unroll
            for (int m = 0; m < 4; ++m) { const int row = row0 + ai * HALF + m * 16;
                if (row < NROWS) {
                    const gfloat* s = row < NREAL ? src_real + (size_t)row * DM : src_meta + (size_t)(row - NREAL) * DM;
                    gfloat* d = row < NREAL ? dst_real + (size_t)row * DM : dst_meta + (size_t)(row - NREAL) * DM;
#pragma unroll
                    for (int bj = 0; bj < 2; ++bj)
#pragma unroll
                        for (int n = 0; n < 2; ++n) { const int c = col0 + bj * HALF + n * 16; *(gf32x4*)(d + c) = *(const gf32x4*)(s + c) + acc[ai][bj][m][n]; }
                } }
    }
};

template <class Epi, class Sched>
__device__ __forceinline__ void gemm_phase(LAS unsigned char* lds, const Gemm g, const Sched& S, const Epi& E) {
    int tid_ = threadIdx.x; asm volatile("" : "+v"(tid_));
    const int tid = tid_, wid = __builtin_amdgcn_readfirstlane(tid >> 6), lane = tid & 63, wr = wid >> 2, wc = wid & 3, fr = lane & 15, fq = lane >> 4;
    const int K = g.K, nt = K / BK, lda = g.lda;
    unsigned voffA[2], voffB[2];
#pragma unroll
    for (int i = 0; i < 2; ++i) { int R, C; stage_rc(tid * 16 + i * 8192, R, C); const int Rb = Epi::PERM ? ((R & ~31) + perm32(R & 31)) : R;
        voffA[i] = (unsigned)(R * lda + C) * 2u; voffB[i] = (unsigned)(Rb * K + C) * 2u; }
    const size_t kstep = (size_t)(BK * 2);
    const size_t hstepA = (size_t)HALF * lda * 2, hstepB = (size_t)HALF * K * 2;
    const size_t tstepA = 2 * hstepA, tstepB = 2 * hstepB;
    const unsigned ldsw = (unsigned)wid * 1024u;
    const int aoff = lds_byte(wr * 64 + fr, fq * 8), boff = lds_byte(wc * 32 + fr, fq * 8);
#define PG8_SA(b, h) (((b) * 2 + (h)) * HTB)
#define PG8_SB(b, h) ((4 + (b) * 2 + (h)) * HTB)
#define PG8_STAGE(bufoff, gbase, voff) do { _Pragma("unroll") for (int _i = 0; _i < 2; ++_i) \
        __builtin_amdgcn_global_load_lds((const gunsigned*)((const gchar*)(gbase) + (voff)[_i]), (LAS unsigned*)(lds + (bufoff) + ldsw + _i * 8192), 16, 0, 0); } while (0)
#define PG8_LDA(dst, b, h) do { _Pragma("unroll") for (int m = 0; m < 4; ++m) _Pragma("unroll") for (int k = 0; k < 2; ++k) dst[m][k] = *(const LAS bf16x8*)(lds + PG8_SA(b, h) + aoff + m * 2048 + k * 1024); } while (0)
#define PG8_LDB(dst, b, h) do { _Pragma("unroll") for (int n = 0; n < 2; ++n) _Pragma("unroll") for (int k = 0; k < 2; ++k) dst[n][k] = *(const LAS bf16x8*)(lds + PG8_SB(b, h) + boff + n * 2048 + k * 1024); } while (0)
#define PG8_MMA(ai, bj, At, Bt) do { __builtin_amdgcn_s_setprio(1); _Pragma("unroll") for (int m = 0; m < 4; ++m) _Pragma("unroll") for (int n = 0; n < 2; ++n) _Pragma("unroll") for (int k = 0; k < 2; ++k) \
        acc[ai][bj][m][n] = __builtin_amdgcn_mfma_f32_16x16x32_bf16(Bt[n][k], At[m][k], acc[ai][bj][m][n], 0, 0, 0); __builtin_amdgcn_s_setprio(0); } while (0)
#define PG8_WAIT_V(n) asm volatile("s_waitcnt vmcnt(" #n ")" ::: "memory")
#define PG8_WAIT_L(n) asm volatile("s_waitcnt lgkmcnt(" #n ")" ::: "memory")
#define PG8_BAR __builtin_amdgcn_s_barrier()
#define PG8_SCHED __builtin_amdgcn_sched_barrier(0)
    Unit cur, nxt; int ui = 0;
    if (!S.next(0, cur)) return;
    f32x4 acc[2][2][4][2];
#pragma unroll
    for (int a = 0; a < 2; ++a)
#pragma unroll
        for (int b = 0; b < 2; ++b)
#pragma unroll
            for (int m = 0; m < 4; ++m)
#pragma unroll
                for (int n = 0; n < 2; ++n) acc[a][b][m][n] = (f32x4){0.f, 0.f, 0.f, 0.f};
    bf16x8 At[4][2], B0[2][2], B1[2][2];
    const gchar* cA = (const gchar*)g.A + (size_t)cur.pm * tstepA; const gchar* cB = (const gchar*)g.Bt + (size_t)cur.pn * tstepB;
    PG8_STAGE(PG8_SB(0, 0), cB, voffB); PG8_STAGE(PG8_SB(0, 1), cB + hstepB, voffB); PG8_STAGE(PG8_SA(0, 0), cA, voffA); PG8_STAGE(PG8_SA(0, 1), cA + hstepA, voffA);
    if (wr == 1) PG8_BAR;
    PG8_WAIT_V(2); PG8_BAR;
    PG8_STAGE(PG8_SB(1, 0), cB + kstep, voffB); PG8_STAGE(PG8_SA(1, 0), cA + kstep, voffA); PG8_STAGE(PG8_SB(1, 1), cB + hstepB + kstep, voffB);
    PG8_WAIT_V(6); PG8_BAR;
    for (;;) {
        const bool has_next = S.next(ui + 1, nxt);
        const gchar* nA = has_next ? (const gchar*)g.A + (size_t)nxt.pm * tstepA : cA; const gchar* nB = has_next ? (const gchar*)g.Bt + (size_t)nxt.pn * tstepB : cB;
        for (int t = 0; t < nt; t += 2) {
            const bool last = (t == nt - 2);
            const gchar* a1 = cA + (size_t)(t + 1) * kstep;
            const gchar* a2 = last ? nA : cA + (size_t)(t + 2) * kstep; const gchar* b2 = last ? nB : cB + (size_t)(t + 2) * kstep;
            const gchar* a3 = a2 + kstep; const gchar* b3 = b2 + kstep;
            PG8_LDB(B0, 0, 0); PG8_LDB(B1, 0, 1); PG8_SCHED; PG8_LDA(At, 0, 0); PG8_STAGE(PG8_SA(1, 1), a1 + hstepA, voffA);
            PG8_WAIT_V(8); PG8_WAIT_L(0); PG8_BAR; PG8_MMA(0, 0, At, B0); PG8_MMA(0, 1, At, B1); PG8_BAR; PG8_SCHED;
            PG8_LDA(At, 0, 1); PG8_STAGE(PG8_SB(0, 0), b2, voffB); PG8_STAGE(PG8_SB(0, 1), b2 + hstepB, voffB); PG8_STAGE(PG8_SA(0, 0), a2, voffA);
            PG8_WAIT_V(8); PG8_WAIT_L(0); PG8_BAR; PG8_MMA(1, 0, At, B0); PG8_MMA(1, 1, At, B1); PG8_BAR; PG8_SCHED;
            PG8_LDB(B0, 1, 0); PG8_LDB(B1, 1, 1); PG8_SCHED; PG8_LDA(At, 1, 0); PG8_STAGE(PG8_SA(0, 1), a2 + hstepA, voffA);
            PG8_WAIT_V(8); PG8_WAIT_L(0); PG8_BAR; PG8_MMA(0, 0, At, B0); PG8_MMA(0, 1, At, B1); PG8_BAR; PG8_SCHED;
            PG8_LDA(At, 1, 1); PG8_STAGE(PG8_SB(1, 0), b3, voffB); PG8_STAGE(PG8_SB(1, 1), b3 + hstepB, voffB); PG8_STAGE(PG8_SA(1, 0), a3, voffA);
            PG8_WAIT_V(8); PG8_WAIT_L(0); PG8_BAR; PG8_MMA(1, 0, At, B0); PG8_MMA(1, 1, At, B1); PG8_BAR; PG8_SCHED;
        }
        if (wr == 0) PG8_BAR;
        E(acc, cur, wr, wc, fr, fq);
        if (!has_next) break;
#pragma unroll
        for (int a = 0; a < 2; ++a)
#pragma unroll
            for (int b = 0; b < 2; ++b)
#pragma unroll
                for (int m = 0; m < 4; ++m)
#pragma unroll
                    for (int n = 0; n < 2; ++n) acc[a][b][m][n] = (f32x4){0.f, 0.f, 0.f, 0.f};
        cur = nxt; cA = nA; cB = nB; ++ui;
        if (wr == 1) PG8_BAR;
    }
    PG8_WAIT_V(0);
    PG8_BAR;
#undef PG8_SA
#undef PG8_SB
#undef PG8_STAGE
#undef PG8_LDA
#undef PG8_LDB
#undef PG8_MMA
#undef PG8_WAIT_V
#undef PG8_WAIT_L
#undef PG8_BAR
#undef PG8_SCHED
}
}

namespace att {
#define SBAR() __builtin_amdgcn_sched_barrier(0)
constexpr int OFF_K = 0, OFF_V = 24576, OFF_WS = 24576 + 16384, ATT_LDS = OFF_WS + 8 * 64 * 4;
__device__ __forceinline__ int crow(int r, int hi) { return (r & 3) + 8 * (r >> 2) + 4 * hi; }
__device__ __forceinline__ int v_st(int k, int c) { const int kk = (k & ~0xC) | ((k & 4) << 1) | ((k & 8) >> 1); return ((kk >> 3) * 4 + (c >> 5)) * 512 + ((kk & 7) * 32 + (c & 31)) * 2; }
__device__ __forceinline__ int v_rd_base(int lane) { return ((lane & 3) << 3) | (((lane >> 2) & 3) << 6) | (((lane >> 4) & 1) << 5) | (((lane >> 5) & 1) << 8); }
constexpr int v_rd_off(int d0, int ks, int half) { return d0 * 512 + ks * 4096 + half * 2048; }
template <int OFF> __device__ __forceinline__ s16x4 tr_read(int vb) {
    s16x4 r; asm volatile("ds_read_b64_tr_b16 %0, %1 offset:%2" : "=&v"(r) : "v"(vb), "i"(OFF) : "memory"); return r;
}
template <int D0> __device__ __forceinline__ void pv_one(f32x16& od, int vb, bf16x8 pa0, bf16x8 pa1, bf16x8 pa2, bf16x8 pa3) {
    const s16x4 l0 = tr_read<v_rd_off(D0, 0, 0)>(vb), h0 = tr_read<v_rd_off(D0, 0, 1)>(vb), l1 = tr_read<v_rd_off(D0, 1, 0)>(vb), h1 = tr_read<v_rd_off(D0, 1, 1)>(vb);
    const s16x4 l2 = tr_read<v_rd_off(D0, 2, 0)>(vb), h2 = tr_read<v_rd_off(D0, 2, 1)>(vb), l3 = tr_read<v_rd_off(D0, 3, 0)>(vb), h3 = tr_read<v_rd_off(D0, 3, 1)>(vb);
    asm volatile("s_waitcnt lgkmcnt(0)" ::: "memory"); SBAR();
#define PK(L, H) (bf16x8){L[0], L[1], L[2], L[3], H[0], H[1], H[2], H[3]}
    od = __builtin_amdgcn_mfma_f32_32x32x16_bf16(pa0, PK(l0, h0), od, 0, 0, 0);
    od = __builtin_amdgcn_mfma_f32_32x32x16_bf16(pa1, PK(l1, h1), od, 0, 0, 0);
    od = __builtin_amdgcn_mfma_f32_32x32x16_bf16(pa2, PK(l2, h2), od, 0, 0, 0);
    od = __builtin_amdgcn_mfma_f32_32x32x16_bf16(pa3, PK(l3, h3), od, 0, 0, 0);
#undef PK
}
__device__ __forceinline__ int key_row(int b, int p) { p = p < LSEQ ? p : LSEQ - 1; return p < NMETA ? NREAL + p : b * SEQ + p - NMETA; }

template <int DQK>
__device__ __forceinline__ void attn_map(const gbf16_t* __restrict__ Qp, int ldq, const gbf16_t* __restrict__ Kp, int ldk, const gbf16_t* __restrict__ Vp, int ldv,
                                         int b, int qpos0, int NT, f32x16 (&o)[4], float& l_out, LAS char* lds) {
    constexpr int RB = DQK * 2, CPR = DQK / 8, NKC = (64 * CPR) / 512, ND = DQK / 16;
    int tid_ = threadIdx.x; asm volatile("" : "+v"(tid_));
    const int tid = tid_, wid = __builtin_amdgcn_readfirstlane(tid >> 6), lane = tid & 63, r32 = lane & 31, hi = lane >> 5;
    LAS char* K_lds = lds + OFF_K; LAS char* V_lds = lds + OFF_V; LAS float* al_l = (LAS float*)(lds + OFF_WS) + wid * 64;
    bf16x8 qr[ND];
    { const gbf16_t* Qw = Qp + (size_t)(wid * 32 + r32) * ldq + hi * 8;
#pragma unroll
      for (int d0 = 0; d0 < ND; ++d0) qr[d0] = *(const gbf16x8*)(Qw + d0 * 16); }
    float m_reg = -1e30f, l_reg = 0.f;
#pragma unroll
    for (int d = 0; d < 4; ++d) o[d] = f32x16{};
    const int vb = (int)(unsigned)(uintptr_t)V_lds + v_rd_base(lane);
    const int qpos = qpos0 + wid * 32 + r32, wq_min = qpos0 + wid * 32, wq_max = wq_min + 31;
    int kb4[4];
#pragma unroll
    for (int i = 0; i < 4; ++i) kb4[i] = r32 * RB + (((i * 2 + hi) ^ (r32 & 7)) << 4);
    bf16x8 kst[NKC], vst[2];
#define ATT_SLOAD(j) do { \
        _Pragma("unroll") for (int i_ = 0; i_ < NKC; ++i_) { const int c_ = tid + i_ * 512, row_ = c_ / CPR, cc_ = c_ % CPR; \
            kst[i_] = *(const gbf16x8*)(Kp + (size_t)key_row(b, 64 * (j) + row_) * ldk + cc_ * 8); } \
        _Pragma("unroll") for (int i_ = 0; i_ < 2; ++i_) { const int row_ = (tid >> 4) + 32 * i_, col_ = (tid & 15) * 8; \
            vst[i_] = *(const gbf16x8*)(Vp + (size_t)key_row(b, 64 * (j) + row_) * ldv + col_); } } while (0)
#define ATT_SWRITE() do { \
        _Pragma("unroll") for (int i_ = 0; i_ < NKC; ++i_) { const int c_ = tid + i_ * 512, row_ = c_ / CPR, cc_ = c_ % CPR; \
            *(LAS bf16x8*)(K_lds + row_ * RB + ((cc_ * 16) ^ ((row_ & 7) << 4))) = kst[i_]; } \
        _Pragma("unroll") for (int i_ = 0; i_ < 2; ++i_) { const int row_ = (tid >> 4) + 32 * i_, col_ = (tid & 15) * 8; \
            *(LAS bf16x8*)(V_lds + v_st(row_, col_)) = vst[i_]; } } while (0)
    ATT_SLOAD(0);
    for (int j = 0; j < NT; ++j) {
        __syncthreads();
        ATT_SWRITE();
        __syncthreads();
        if (j + 1 < NT) ATT_SLOAD(j + 1);
        if (64 * j <= wq_max) {
            f32x16 p0 = f32x16{}, p1 = f32x16{};
#pragma unroll
            for (int d0 = 0; d0 < ND; ++d0) { const LAS char* kp_ = K_lds + kb4[d0 & 3] + (d0 >> 2) * 128;
                const bf16x8 b0 = *(const LAS bf16x8*)(kp_);
                const bf16x8 b1 = *(const LAS bf16x8*)(kp_ + 32 * RB);
                p0 = __builtin_amdgcn_mfma_f32_32x32x16_bf16(b0, qr[d0], p0, 0, 0, 0);
                p1 = __builtin_amdgcn_mfma_f32_32x32x16_bf16(b1, qr[d0], p1, 0, 0, 0);
                if ((d0 & 3) == 3) SBAR(); }
            if (64 * j + 63 > wq_min) {
#pragma unroll
                for (int r = 0; r < 16; ++r) { const int kp = 64 * j + crow(r, hi); if (kp > qpos) p0[r] = -1e30f; if (kp + 32 > qpos) p1[r] = -1e30f; }
            }
            float pmax = p0[0];
#pragma unroll
            for (int r = 1; r < 16; ++r) pmax = fmaxf(pmax, p0[r]);
#pragma unroll
            for (int r = 0; r < 16; ++r) pmax = fmaxf(pmax, p1[r]);
            { auto rr = __builtin_amdgcn_permlane32_swap(__float_as_uint(pmax), __float_as_uint(pmax), false, false);
              pmax = fmaxf(__uint_as_float(rr[0]), __uint_as_float(rr[1])); }
            const float mn = fmaxf(m_reg, pmax), alpha = __builtin_amdgcn_exp2f(m_reg - mn); m_reg = mn;
#pragma unroll
            for (int r = 0; r < 16; ++r) { p0[r] = __builtin_amdgcn_exp2f(p0[r] - mn); p1[r] = __builtin_amdgcn_exp2f(p1[r] - mn); }
            float ps = 0.f;
#pragma unroll
            for (int r = 0; r < 16; ++r) ps += p0[r] + p1[r];
            { auto rr = __builtin_amdgcn_permlane32_swap(__float_as_uint(ps), __float_as_uint(ps), false, false);
              ps = __uint_as_float(rr[0]) + __uint_as_float(rr[1]); }
            l_reg = l_reg * alpha + ps;
            bf16x8 pa0, pa1, pa2, pa3;
#define PK4(P, BASE, OUT) do { unsigned a0 = cvt_pk_bf16(P[BASE + 0], P[BASE + 1]), a1 = cvt_pk_bf16(P[BASE + 2], P[BASE + 3]);   \
    unsigned b0_ = cvt_pk_bf16(P[BASE + 4], P[BASE + 5]), b1_ = cvt_pk_bf16(P[BASE + 6], P[BASE + 7]);                              \
    auto r0 = __builtin_amdgcn_permlane32_swap(a0, b0_, false, false); auto r1 = __builtin_amdgcn_permlane32_swap(a1, b1_, false, false); \
    u32x4 w = {r0[0], r1[0], r0[1], r1[1]}; OUT = __builtin_bit_cast(bf16x8, w); } while (0)
            PK4(p0, 0, pa0); PK4(p0, 8, pa1); PK4(p1, 0, pa2); PK4(p1, 8, pa3);
#undef PK4
            if (__any(alpha < 1.f)) {
                if (hi == 0) al_l[r32] = alpha;
                LDS_WAIT();
#pragma unroll
                for (int r = 0; r < 16; ++r) { const float a = al_l[crow(r, hi)];
#pragma unroll
                    for (int d = 0; d < 4; ++d) o[d][r] *= a; }
            }
            pv_one<0>(o[0], vb, pa0, pa1, pa2, pa3); pv_one<1>(o[1], vb, pa0, pa1, pa2, pa3); pv_one<2>(o[2], vb, pa0, pa1, pa2, pa3); pv_one<3>(o[3], vb, pa0, pa1, pa2, pa3);
        }
    }
#undef ATT_SLOAD
#undef ATT_SWRITE
    l_out = l_reg;
}
__device__ __forceinline__ void row_recip(float l, float (&rli)[16], LAS char* lds, int wid, int r32, int hi) {
    LAS float* li_l = (LAS float*)(lds + OFF_WS) + wid * 64 + 32;
    if (hi == 0) li_l[r32] = l;
    LDS_WAIT();
#pragma unroll
    for (int r = 0; r < 16; ++r) rli[r] = __builtin_amdgcn_rcpf(li_l[crow(r, hi)]);
    LDS_WAIT();
}
#undef SBAR
}

struct Params { const float* in[21]; float* out; unsigned char* ws; int s_lo, s_hi; };
struct DParams { const gfloat* in[21]; gfloat* out; guchar* ws; int s_lo, s_hi; };
enum { I_X = 0, I_META, I_ATTN_NORM, I_W_IN, I_QA_NORM, I_W_Q_UP, I_KVA_NORM, I_W_KV_UP, I_Q_NORM, I_K_NORM, I_DQ_NORM, I_DK_NORM, I_LQ1, I_LK1, I_LQ2, I_LK2, I_SUBLN, I_W_O, I_FFN_NORM,
       I_W_GU, I_W_D };
constexpr int LDS_BYTES = 147456;
constexpr int NTHREADS = 512, NWAVES = 8;

struct Frame {
    LAS unsigned char* lds; DParams p; int tid, lane, wave, vcu, G, gw, ngw;
};

__device__ __forceinline__ void transpose_item(const gfloat* W, int ldw, int Ksrc, const gfloat* gain, gbf16_t* WT, int Kd, int k0, int sc0, int dr0, LAS float* scr, int lane) {
    const bool zero = (sc0 < 0) || (k0 >= Ksrc);
    const int c = lane & 7;
    if (zero) {
#pragma unroll
        for (int j = 0; j < 4; ++j) { const int n = (lane >> 3) + 8 * j; *(gu32x4*)(WT + (size_t)(dr0 + n) * Kd + k0 + 8 * c) = (u32x4){0u, 0u, 0u, 0u}; }
        return;
    }
#pragma unroll 8
    for (int i = 0; i < 32; ++i) { const int kk = 2 * i + (lane >> 5); const float gsc = gain ? gain[k0 + kk] : 1.0f; scr[kk * 33 + (lane & 31)] = W[(size_t)(k0 + kk) * ldw + sc0 + (lane & 31)] * gsc; }
    LDS_WAIT(); asm volatile("" ::: "memory");
#pragma unroll
    for (int j = 0; j < 4; ++j) { const int n = (lane >> 3) + 8 * j; const LAS float* s = scr + (8 * c) * 33 + n;
        u32x4 o; o.x = pk2(s[0 * 33], s[1 * 33]); o.y = pk2(s[2 * 33], s[3 * 33]); o.z = pk2(s[4 * 33], s[5 * 33]); o.w = pk2(s[6 * 33], s[7 * 33]);
        *(gu32x4*)(WT + (size_t)(dr0 + n) * Kd + k0 + 8 * c) = o; }
    LDS_WAIT(); asm volatile("" ::: "memory");
}
__device__ __forceinline__ void stage_prep(Frame& F) {
    LAS float* scr = (LAS float*)(F.lds + F.wave * 16384);
    const DParams& P = F.p;
    constexpr int IT_IN = 16 * 64, IT_Q = 4 * 32, IT_KV = 4 * 32, IT_O = 16 * 32, IT_GU = 16 * 176, IT_D = 44 * 32, IT_L = IT_IN + IT_Q + IT_KV + IT_O + IT_GU + IT_D;
    for (int it = F.gw; it < 2 * IT_L; it += F.ngw) {
        const int l = it / IT_L; int r = it % IT_L;
        gbf16_t* wb = (gbf16_t*)(P.ws + WS_W + (size_t)l * W_LAYER);
        if (r < IT_IN) { const int kb = r / 64, g = r % 64;
            transpose_item(P.in[I_W_IN] + (size_t)l * DM * INW, INW, DM, P.in[I_ATTN_NORM] + l * DM, (gbf16_t*)((gchar*)wb + W_IN), DM, kb * 64, (32 * g < INW) ? 32 * g : -1, 32 * g, scr, F.lane); continue; }
        r -= IT_IN;
        if (r < IT_Q) { const int kb = r / 32, g = r % 32, h = g >> 3, d0 = (g & 7) * 32;
            transpose_item(P.in[I_W_Q_UP] + (size_t)l * 256 * 768, 768, 256, P.in[I_QA_NORM] + l * 256, (gbf16_t*)((gchar*)wb + W_Q), 256, kb * 64, d0 < 192 ? h * 192 + d0 : -1, 32 * g, scr, F.lane); continue; }
        r -= IT_Q;
        if (r < IT_KV) { const int kb = r / 32, g = r % 32;
            transpose_item(P.in[I_W_KV_UP] + (size_t)l * 128 * 1024, 1024, 128, P.in[I_KVA_NORM] + l * 128, (gbf16_t*)((gchar*)wb + W_KV), 256, kb * 64, 32 * g, 32 * g, scr, F.lane); continue; }
        r -= IT_KV;
        if (r < IT_O) { const int kb = r / 32, g = r % 32;
            transpose_item(P.in[I_W_O] + (size_t)l * DM * DM, DM, DM, nullptr, (gbf16_t*)((gchar*)wb + W_O), DM, kb * 64, 32 * g, 32 * g, scr, F.lane); continue; }
        r -= IT_O;
        if (r < IT_GU) { const int kb = r / 176, g = r % 176, pn = g >> 3, half = (g & 7) >> 2, i0 = (g & 3) * 32;
            transpose_item(P.in[I_W_GU] + (size_t)l * DM * 2 * DFF, 2 * DFF, DM, P.in[I_FFN_NORM] + l * DM, (gbf16_t*)((gchar*)wb + W_GU), DM, kb * 64, half * DFF + pn * 128 + i0, 32 * g, scr, F.lane); continue; }
        r -= IT_GU;
        { const int kb = r / 32, g = r % 32;
          transpose_item(P.in[I_W_D] + (size_t)l * DFF * DM, DM, DFF, nullptr, (gbf16_t*)((gchar*)wb + W_D), DFF, kb * 64, 32 * g, 32 * g, scr, F.lane); }
    }
    gfloat* COS = (gfloat*)(P.ws + WS_COS); gfloat* SIN = (gfloat*)(P.ws + WS_SIN);
    for (int i = blockIdx.x * NTHREADS + F.tid; i < LSEQ * 32; i += F.G * NTHREADS) {
        const int pos = i >> 5, m = i & 31;
        const float inv = 1.0f / powf(10000.0f, (float)(2 * m) / 64.0f), ang = (float)pos * inv;
        COS[i] = cosf(ang); SIN[i] = sinf(ang);
    }
    if (blockIdx.x == 0 && F.tid < DEPTH) {
        const int l = F.tid; float a = 0.f, b = 0.f;
        for (int i = 0; i < 64; ++i) { a += P.in[I_LQ1][l * 64 + i] * P.in[I_LK1][l * 64 + i]; b += P.in[I_LQ2][l * 64 + i] * P.in[I_LK2][l * 64 + i]; }
        const float lam_init = 0.8f - 0.6f * expf(-0.3f * (float)l);
        ((gfloat*)(P.ws + WS_LAM))[l] = expf(a) - expf(b) + lam_init;
    }
}

__device__ __forceinline__ void stage_cast(Frame& F, const gfloat* h_real, const gfloat* h_meta) {
    gbf16_t* XN = (gbf16_t*)(F.p.ws + WS_AO); gfloat* RH = (gfloat*)(F.p.ws + WS_RH);
    for (int row = F.gw; row < NROWS; row += F.ngw) {
        const gfloat* hr = row < NREAL ? h_real + (size_t)row * DM : h_meta + (size_t)(row - NREAL) * DM;
        f32x4 v[4]; float s = 0.f;
#pragma unroll
        for (int j = 0; j < 4; ++j) { v[j] = *((const gf32x4*)hr + F.lane + 64 * j); s += (v[j].x * v[j].x + v[j].y * v[j].y) + (v[j].z * v[j].z + v[j].w * v[j].w); }
        s = wave_sum(s);
        if (F.lane == 0) RH[row] = 1.0f / sqrtf(s * (1.0f / DM) + EPS);
        gu32x2* o8 = (gu32x2*)(XN + (size_t)row * DM) + F.lane;
#pragma unroll
        for (int j = 0; j < 4; ++j) o8[64 * j] = (u32x2){pk2(v[j].x, v[j].y), pk2(v[j].z, v[j].w)};
    }
}

__device__ __forceinline__ void stage_postproj(Frame& F, int l) {
    const DParams& P = F.p;
    const gbf16_t* PROJ = (const gbf16_t*)(P.ws + WS_PROJ); gbf16_t* QD = (gbf16_t*)(P.ws + WS_QD); gbf16_t* KD = (gbf16_t*)(P.ws + WS_KD);
    gfloat* RQ = (gfloat*)(P.ws + WS_RQ); gfloat* RKV = (gfloat*)(P.ws + WS_RKV);
    const gfloat* COS = (const gfloat*)(P.ws + WS_COS); const gfloat* SIN = (const gfloat*)(P.ws + WS_SIN);
    const float gq = P.in[I_DQ_NORM][l * 64 + F.lane], gk = P.in[I_DK_NORM][l * 64 + F.lane];
    for (int row = F.gw; row < NROWS; row += F.ngw) {
        const int pos = row < NREAL ? NMETA + (row & (SEQ - 1)) : row - NREAL;
        const gbf16_t* pr = PROJ + (size_t)row * INWP;
        { const u32x2 v = *(const gu32x2*)(pr + PC_CQ + F.lane * 4); const float a = bf2f(v.x & 0xffffu), b = bf2f(v.x >> 16), c = bf2f(v.y & 0xffffu), d = bf2f(v.y >> 16);
          const float s = wave_sum((a * a + b * b) + (c * c + d * d)); if (F.lane == 0) RQ[row] = 1.0f / sqrtf(s * (1.0f / 256.0f) + EPS); }
        { const unsigned v = *(const gunsigned*)(pr + PC_CKV + F.lane * 2); const float a = bf2f(v & 0xffffu), b = bf2f(v >> 16);
          const float s = wave_sum(a * a + b * b); if (F.lane == 0) RKV[row] = 1.0f / sqrtf(s * (1.0f / 128.0f) + EPS); }
        const float cs = COS[pos * 32 + (F.lane & 31)], sn = SIN[pos * 32 + (F.lane & 31)];
#pragma unroll 4
        for (int seg = 0; seg < 16; ++seg) {
            const float x = bf2f(pr[PC_DQ + seg * 64 + F.lane]);
            const float r = 1.0f / sqrtf(wave_sum(x * x) * (1.0f / 64.0f) + EPS);
            const float y = x * r * (seg < 8 ? gq : gk), pt = __shfl_xor(y, 32);
            const float o = F.lane < 32 ? y * cs - pt * sn : y * cs + pt * sn;
            if (seg < 8) QD[(size_t)row * 512 + seg * 64 + F.lane] = (bf16_t)f2bf(o * CD);
            else KD[(size_t)row * 512 + (seg - 8) * 64 + F.lane] = (bf16_t)f2bf(o);
        }
    }
}

__device__ __forceinline__ void stage_mla_qk(Frame& F, int l) {
    const DParams& P = F.p;
    const gbf16_t* PROJ = (const gbf16_t*)(P.ws + WS_PROJ); const gbf16_t* QRAW = (const gbf16_t*)(P.ws + WS_AO); const gbf16_t* KVRAW = (const gbf16_t*)(P.ws + WS_KVRAW);
    gbf16_t* QA = (gbf16_t*)(P.ws + WS_QA); gbf16_t* KA = (gbf16_t*)(P.ws + WS_KA);
    const gfloat* COS = (const gfloat*)(P.ws + WS_COS); const gfloat* SIN = (const gfloat*)(P.ws + WS_SIN);
    const gfloat* gqp = P.in[I_Q_NORM] + l * 192; const gfloat* gkp = P.in[I_K_NORM] + l * 192;
    const float gq0 = gqp[F.lane], gq1 = gqp[64 + F.lane], gq2 = gqp[128 + F.lane], gk0 = gkp[F.lane], gk1 = gkp[64 + F.lane], gk2 = gkp[128 + F.lane];
    for (int row = F.gw; row < NROWS; row += F.ngw) {
        const int pos = row < NREAL ? NMETA + (row & (SEQ - 1)) : row - NREAL;
        const float cs = COS[pos * 32 + (F.lane & 31)], sn = SIN[pos * 32 + (F.lane & 31)];
        const float kr = bf2f(PROJ[(size_t)row * INWP + PC_KR + F.lane]);
#pragma unroll
        for (int h = 0; h < 4; ++h) {
            { const gbf16_t* qp = QRAW + (size_t)row * 1024 + h * 256;
              const float x0 = bf2f(qp[F.lane]), x1 = bf2f(qp[64 + F.lane]), x2 = bf2f(qp[128 + F.lane]);
              const float r = 1.0f / sqrtf(wave_sum(x0 * x0 + x1 * x1 + x2 * x2) * (1.0f / 192.0f) + EPS);
              const float y0 = x0 * r * gq0, y1 = x1 * r * gq1, y2 = x2 * r * gq2, pt = __shfl_xor(y2, 32);
              const float y2r = F.lane < 32 ? y2 * cs - pt * sn : y2 * cs + pt * sn;
              gbf16_t* qo = QA + (size_t)row * 768 + h * 192;
              qo[F.lane] = (bf16_t)f2bf(y0 * CA); qo[64 + F.lane] = (bf16_t)f2bf(y1 * CA); qo[128 + F.lane] = (bf16_t)f2bf(y2r * CA); }
            { const gbf16_t* kp = KVRAW + (size_t)row * 1024 + h * 256;
              const float x0 = bf2f(kp[F.lane]), x1 = bf2f(kp[64 + F.lane]), x2 = kr;
              const float r = 1.0f / sqrtf(wave_sum(x0 * x0 + x1 * x1 + x2 * x2) * (1.0f / 192.0f) + EPS);
              const float y0 = x0 * r * gk0, y1 = x1 * r * gk1, y2 = x2 * r * gk2, pt = __shfl_xor(y2, 32);
              const float y2r = F.lane < 32 ? y2 * cs - pt * sn : y2 * cs + pt * sn;
              gbf16_t* ko = KA + (size_t)row * 768 + h * 192;
              ko[F.lane] = (bf16_t)f2bf(y0); ko[64 + F.lane] = (bf16_t)f2bf(y1); ko[128 + F.lane] = (bf16_t)f2bf(y2r); }
        }
    }
}

__device__ __forceinline__ void attn_unit_mla(Frame& F, int b, int h, int qrow0, int qpos0, int NT, int nvalid) {
    const DParams& P = F.p;
    const gbf16_t* QA = (const gbf16_t*)(P.ws + WS_QA); const gbf16_t* KA = (const gbf16_t*)(P.ws + WS_KA); const gbf16_t* KVRAW = (const gbf16_t*)(P.ws + WS_KVRAW);
    gbf16_t* AO = (gbf16_t*)(P.ws + WS_AO);
    const int r32 = F.lane & 31, hi = F.lane >> 5;
    f32x16 o[4]; float l;
    att::attn_map<192>(QA + (size_t)qrow0 * 768 + h * 192, 768, KA + h * 192, 768, KVRAW + h * 256 + 128, 1024, b, qpos0, NT, o, l, (LAS char*)F.lds);
    float rli[16]; att::row_recip(l, rli, (LAS char*)F.lds, F.wave, r32, hi);
#pragma unroll
    for (int r = 0; r < 16; ++r) { const int lr = F.wave * 32 + att::crow(r, hi);
        if (lr < nvalid) { gbf16_t* op = AO + (size_t)(qrow0 + lr) * DM + h * 128 + r32;
#pragma unroll
            for (int d0 = 0; d0 < 4; ++d0) op[d0 * 32] = (bf16_t)f2bf(o[d0][r] * rli[r]); } }
}
__device__ __forceinline__ void attn_unit_diff(Frame& F, int l_idx, int b, int h, int qrow0, int qpos0, int NT, int nvalid) {
    const DParams& P = F.p;
    const gbf16_t* QD = (const gbf16_t*)(P.ws + WS_QD); const gbf16_t* KD = (const gbf16_t*)(P.ws + WS_KD); const gbf16_t* PROJ = (const gbf16_t*)(P.ws + WS_PROJ);
    gbf16_t* AO = (gbf16_t*)(P.ws + WS_AO);
    gf32x4* tmp = (gf32x4*)((gfloat*)(P.ws + WS_TMP) + ((size_t)blockIdx.x * 512 + F.tid) * 64);
    const int r32 = F.lane & 31, hi = F.lane >> 5;
    const float lam = ((const gfloat*)(P.ws + WS_LAM))[l_idx];
    const float lam_init = 0.8f - 0.6f * expf(-0.3f * (float)l_idx);
    f32x16 o[4]; float lsum; float rli[16];
#pragma unroll 1
    for (int c = 0; c < 2; ++c) {
        att::attn_map<64>(QD + (size_t)qrow0 * 512 + h * 128 + c * 64, 512, KD + h * 128 + c * 64, 512, PROJ + PC_DV + h * 128, INWP, b, qpos0, NT, o, lsum, (LAS char*)F.lds);
        att::row_recip(lsum, rli, (LAS char*)F.lds, F.wave, r32, hi);
        if (c == 0) {
#pragma unroll
            for (int d = 0; d < 4; ++d)
#pragma unroll
                for (int q = 0; q < 4; ++q) tmp[d * 4 + q] = (f32x4){o[d][4 * q] * rli[4 * q], o[d][4 * q + 1] * rli[4 * q + 1], o[d][4 * q + 2] * rli[4 * q + 2], o[d][4 * q + 3] * rli[4 * q + 3]};
        }
    }
    float ss[16];
#pragma unroll
    for (int r = 0; r < 16; ++r) ss[r] = 0.f;
#pragma unroll
    for (int d = 0; d < 4; ++d) {
#pragma unroll
        for (int q = 0; q < 4; ++q) { const f32x4 t = tmp[d * 4 + q];
#pragma unroll
            for (int e = 0; e < 4; ++e) { const int r = 4 * q + e; const float v = t[e] - lam * rli[r] * o[d][r]; o[d][r] = v; ss[r] += v * v; } }
        asm volatile("" ::: "memory"); }
#pragma unroll
    for (int off = 1; off < 32; off <<= 1)
#pragma unroll
        for (int r = 0; r < 16; ++r) ss[r] += __shfl_xor(ss[r], off);
    const gfloat* gs = P.in[I_SUBLN] + l_idx * 128; const float post = 1.0f - lam_init;
    float gcol[4];
#pragma unroll
    for (int d = 0; d < 4; ++d) gcol[d] = gs[d * 32 + r32] * post;
#pragma unroll
    for (int r = 0; r < 16; ++r) { const int lr = F.wave * 32 + att::crow(r, hi); const float rn = 1.0f / sqrtf(ss[r] * (1.0f / 128.0f) + EPS);
        if (lr < nvalid) { gbf16_t* op = AO + (size_t)(qrow0 + lr) * DM + 512 + h * 128 + r32;
#pragma unroll
            for (int d0 = 0; d0 < 4; ++d0) op[d0 * 32] = (bf16_t)f2bf(o[d0][r] * rn * gcol[d0]); } }
}
__device__ __forceinline__ void stage_attention(Frame& F, int l) {
    const int v = F.vcu, bh = v >> 2, s = v & 3, b = bh >> 2, h = bh & 3;
#pragma unroll 1
    for (int u = 0; u < 5; ++u) {
        int type, b_, h_, qrow0, qpos0, NT, nvalid;
        if (u < 4) { const int qb = (u & 1) ? 7 - s : s; type = u >> 1; b_ = b; h_ = h; qrow0 = b * SEQ + qb * 256; qpos0 = NMETA + qb * 256; NT = 4 * qb + 5; nvalid = 256; }
        else { if (v >= 8) break; type = v >> 2; b_ = 0; h_ = v & 3; qrow0 = NREAL; qpos0 = 0; NT = 1; nvalid = NMETA; }
        if (type == 0) attn_unit_mla(F, b_, h_, qrow0, qpos0, NT, nvalid);
        else attn_unit_diff(F, l, b_, h_, qrow0, qpos0, NT, nvalid);
    }
    __syncthreads();
}

constexpr int SPL = 11, NSTAGES = 1 + SPL * DEPTH;
__device__ __forceinline__ bool stage_needs_sync(int st) { return !(st >= 1 && (st - 1) % SPL == 4); }
__device__ __forceinline__ void run_stage(const Params& p, LAS unsigned char* ldsp, int st) {
    Frame F;
    F.lds = ldsp;
    { int t = threadIdx.x; asm volatile("" : "+v"(t)); F.tid = t; }
    { unsigned char* w = p.ws; asm volatile("" : "+s"(w)); F.p.ws = (guchar*)w; }
#pragma unroll
    for (int i = 0; i < 21; ++i) F.p.in[i] = (const gfloat*)p.in[i];
    F.p.out = (gfloat*)p.out; F.p.s_lo = p.s_lo; F.p.s_hi = p.s_hi;
    F.lane = F.tid & 63; F.wave = __builtin_amdgcn_readfirstlane(F.tid >> 6);
    F.G = gridDim.x; { const int bx = blockIdx.x; F.vcu = (F.G % 8 == 0) ? (bx % 8) * (F.G / 8) + bx / 8 : bx; }
    F.gw = blockIdx.x * NWAVES + F.wave; F.ngw = F.G * NWAVES;
    const DParams& P = F.p;
    guchar* ws = P.ws;
    if (st == 0) { stage_prep(F); return; }
    const int l = (st - 1) / SPL, s = (st - 1) % SPL;
    const gchar* wb = (const gchar*)(ws + WS_W + (size_t)l * W_LAYER);
    gfloat* HM = (gfloat*)(ws + WS_HM);
    int kind = -1; pg8::Gemm g{nullptr, nullptr, MP, 0, 0, 0};
    gbf16_t* eo = nullptr; int eld = 0; const gfloat* ers = nullptr;
    const gfloat* sr = nullptr; const gfloat* sm = nullptr;
    switch (s) {
    case 0: stage_cast(F, l == 0 ? P.in[I_X] : P.out, l == 0 ? P.in[I_META] : HM); break;
    case 1: kind = 0; g.A = (const gbf16_t*)(ws + WS_AO); g.Bt = (const gbf16_t*)(wb + W_IN); g.N = INWP; g.K = DM; g.lda = DM; eo = (gbf16_t*)(ws + WS_PROJ); eld = INWP; ers = (const gfloat*)(ws + WS_RH); break;
    case 2: stage_postproj(F, l); break;
    case 3: kind = 0; g.A = (const gbf16_t*)(ws + WS_PROJ) + PC_CQ; g.Bt = (const gbf16_t*)(wb + W_Q); g.N = 1024; g.K = 256; g.lda = INWP; eo = (gbf16_t*)(ws + WS_AO); eld = 1024; ers = (const gfloat*)(ws + WS_RQ); break;
    case 4: kind = 0; g.A = (const gbf16_t*)(ws + WS_PROJ) + PC_CKV; g.Bt = (const gbf16_t*)(wb + W_KV); g.N = 1024; g.K = 256; g.lda = INWP; eo = (gbf16_t*)(ws + WS_KVRAW); eld = 1024; ers = (const gfloat*)(ws + WS_RKV); break;
    case 5: stage_mla_qk(F, l); break;
    case 6: stage_attention(F, l); break;
    case 7: kind = 2; g.A = (const gbf16_t*)(ws + WS_AO); g.Bt = (const gbf16_t*)(wb + W_O); g.N = DM; g.K = DM; g.lda = DM; sr = l == 0 ? P.in[I_X] : P.out; sm = l == 0 ? P.in[I_META] : HM; break;
    case 8: stage_cast(F, P.out, HM); break;
    case 9: kind = 1; g.A = (const gbf16_t*)(ws + WS_AO); g.Bt = (const gbf16_t*)(wb + W_GU); g.N = 2 * DFF; g.K = DM; g.lda = DM; eo = (gbf16_t*)(ws + WS_ACT); eld = DFF; ers = (const gfloat*)(ws + WS_RH); break;
    case 10: kind = 2; g.A = (const gbf16_t*)(ws + WS_ACT); g.Bt = (const gbf16_t*)(wb + W_D); g.N = DM; g.K = DFF; g.lda = DFF; sr = P.out; sm = HM; break;
    }
    if (kind >= 0) {
        pg8::StaticOrder S; S.init(MP, g.N, F.G, (int)blockIdx.x);
        if (kind == 0) { pg8::EpiScaleBf16 E{eo, eld, ers}; pg8::gemm_phase(F.lds, g, S, E); }
        else if (kind == 1) { pg8::EpiSwiglu E{eo, eld, ers}; pg8::gemm_phase(F.lds, g, S, E); }
        else { pg8::EpiResidual E{sr, sm, P.out, HM}; pg8::gemm_phase(F.lds, g, S, E); }
    }
}

__global__ void __launch_bounds__(NTHREADS, 2) stage_kernel(Params p) {
    extern __shared__ __attribute__((aligned(16))) unsigned char lds[];
#pragma unroll 1
    for (int st = p.s_lo; st < p.s_hi; ++st) run_stage(p, (LAS unsigned char*)lds, st);
}
__global__ void __launch_bounds__(NTHREADS, 2) mega_kernel(Params p) {
    extern __shared__ __attribute__((aligned(16))) unsigned char lds[];
    cg::grid_group grid = cg::this_grid();
#pragma unroll 1
    for (int st = p.s_lo; st < p.s_hi; ++st) { if (st > p.s_lo && stage_needs_sync(st)) grid.sync(); run_stage(p, (LAS unsigned char*)lds, st); }
}

extern "C" void kernel_launch(void* const* d_in, const int* in_sizes, int n_in, void* d_out, int out_size, void* d_ws, size_t ws_size, hipStream_t stream) {
    static int state = 0;
    if (state == 0) {
        if (n_in != 21 || in_sizes[0] != NREAL * DM || out_size != NREAL * DM || ws_size < WS_END) {
            fprintf(stderr, "kernel_launch: unexpected shapes: n_in %d in0 %d out %d ws %zu (need %zu)\n", n_in, n_in > 0 ? in_sizes[0] : -1, out_size, ws_size, (size_t)WS_END); state = -1; return; }
        int dev = 0, cus = 0;
        hipGetDevice(&dev); hipDeviceGetAttribute(&cus, hipDeviceAttributeMultiprocessorCount, dev);
        if (hipFuncSetAttribute((const void*)stage_kernel, hipFuncAttributeMaxDynamicSharedMemorySize, LDS_BYTES) != hipSuccess ||
            hipFuncSetAttribute((const void*)mega_kernel, hipFuncAttributeMaxDynamicSharedMemorySize, LDS_BYTES) != hipSuccess) { fprintf(stderr, "kernel_launch: hipFuncSetAttribute failed\n"); state = -1; return; }
        int per_cu = 0;
        hipOccupancyMaxActiveBlocksPerMultiprocessor(&per_cu, (const void*)mega_kernel, NTHREADS, LDS_BYTES);
        (void)hipGetLastError();
        if (cus != 256 || per_cu < 1) { fprintf(stderr, "kernel_launch: needs a 256-CU device with one resident workgroup per CU (cus %d, per_cu %d)\n", cus, per_cu); state = -1; return; }
        state = 1;
    }
    if (state < 0) return;
    Params p{};
    for (int i = 0; i < 21; ++i) p.in[i] = (const float*)d_in[i];
    p.out = (float*)d_out; p.ws = (unsigned char*)d_ws;
#if MK_ONE_LAUNCH
    p.s_lo = 0; p.s_hi = NSTAGES;
    void* args[] = {&p};
    hipError_t e = hipLaunchCooperativeKernel((const void*)mega_kernel, dim3(256), dim3(NTHREADS), args, LDS_BYTES, stream);
    if (e != hipSuccess) fprintf(stderr, "kernel_launch: cooperative launch failed: %s\n", hipGetErrorString(e));
#else
    for (int st = 0; st < NSTAGES; ++st) {
        p.s_lo = st; p.s_hi = st + 1;
        hipLaunchKernelGGL(stage_kernel, dim3(256), dim3(NTHREADS), LDS_BYTES, stream, p);
    }
    const hipError_t le = hipPeekAtLastError();
    if (le != hipSuccess) fprintf(stderr, "kernel_launch: launch failed: %s\n", hipGetErrorName(le));
#endif
}
```

```cpp
#include <hip/hip_runtime.h>
#include <hip/hip_cooperative_groups.h>
#include <cstdio>
#include <cstdint>
namespace cg = cooperative_groups;

#ifndef MK_ONE_LAUNCH
#define MK_ONE_LAUNCH 1
#endif

constexpr int DM = 1024, BATCH = 16, SEQ = 2048, NMETA = 16, DEPTH = 2;
constexpr int NREAL = BATCH * SEQ;
constexpr int NROWS = NREAL + NMETA;
constexpr int MP = 33024;
constexpr int LSEQ = SEQ + NMETA;
constexpr int INW = 1984, INWP = 2048, DFF = 2816;
constexpr float EPS = 1e-6f;
constexpr float LOG2E = 1.4426950408889634f;
constexpr float CA = 0.07216878364870322f * LOG2E;
constexpr float CD = 0.125f * LOG2E;
constexpr int PC_CQ = 0, PC_CKV = 256, PC_KR = 384, PC_DQ = 448, PC_DK = 960, PC_DV = 1472;

constexpr size_t MiB = 1u << 20;
constexpr size_t WS_CTL = 0;
constexpr size_t WS_RH = 1 * MiB;
constexpr size_t WS_RQ = WS_RH + 256 * 1024;
constexpr size_t WS_RKV = WS_RQ + 256 * 1024;
constexpr size_t WS_HM = WS_RKV + 256 * 1024;
constexpr size_t WS_LAM = WS_HM + 64 * 1024;
constexpr size_t WS_COS = 2 * MiB;
constexpr size_t WS_SIN = WS_COS + 512 * 1024;
constexpr size_t WS_W = 4 * MiB;
constexpr size_t W_IN = 0, W_Q = W_IN + (size_t)INWP * DM * 2, W_KV = W_Q + (size_t)1024 * 256 * 2, W_O = W_KV + (size_t)1024 * 256 * 2,
                 W_GU = W_O + (size_t)DM * DM * 2, W_D = W_GU + (size_t)2 * DFF * DM * 2, W_LAYER = W_D + (size_t)DM * DFF * 2;
static_assert(WS_W + 2 * W_LAYER <= 52 * MiB, "weights");
constexpr size_t WS_PROJ = 52 * MiB;
constexpr size_t WS_KVRAW = WS_PROJ + (size_t)MP * INWP * 2;
constexpr size_t WS_QA = WS_KVRAW + (size_t)MP * 1024 * 2;
constexpr size_t WS_KA = WS_QA + (size_t)MP * 768 * 2;
constexpr size_t WS_QD = WS_KA + (size_t)MP * 768 * 2;
constexpr size_t WS_KD = WS_QD + (size_t)MP * 512 * 2;
constexpr size_t WS_AO = WS_KD + (size_t)MP * 512 * 2;
constexpr size_t WS_TMP = WS_AO + (size_t)MP * 1024 * 2;
constexpr size_t WS_END = WS_TMP + (size_t)256 * 64 * 512 * 4;
constexpr size_t WS_ACT = WS_PROJ;
static_assert(WS_ACT + (size_t)MP * DFF * 2 <= WS_QA, "ACT overlay");

#define LAS __attribute__((address_space(3)))
typedef unsigned short bf16_t;
typedef short bf16x8 __attribute__((ext_vector_type(8)));
typedef short s16x4 __attribute__((ext_vector_type(4)));
typedef float f32x4 __attribute__((ext_vector_type(4)));
typedef float f32x16 __attribute__((ext_vector_type(16)));
typedef unsigned u32x4 __attribute__((ext_vector_type(4)));
typedef unsigned u32x2 __attribute__((ext_vector_type(2)));
#define GAS __attribute__((address_space(1)))
typedef GAS bf16_t gbf16_t; typedef GAS float gfloat; typedef GAS unsigned char guchar; typedef GAS char gchar; typedef GAS unsigned gunsigned;
typedef GAS u32x4 gu32x4; typedef GAS u32x2 gu32x2; typedef GAS f32x4 gf32x4; typedef GAS bf16x8 gbf16x8;

__device__ __forceinline__ unsigned f2bf(float f) { unsigned u = __builtin_bit_cast(unsigned, f); return (u + 0x7fffu + ((u >> 16) & 1u)) >> 16; }
__device__ __forceinline__ unsigned pk2(float lo, float hi) { return f2bf(lo) | (f2bf(hi) << 16); }
__device__ __forceinline__ float bf2f(unsigned b) { return __builtin_bit_cast(float, b << 16); }
__device__ __forceinline__ unsigned cvt_pk_bf16(float lo, float hi) { unsigned r; asm volatile("v_cvt_pk_bf16_f32 %0, %1, %2" : "=v"(r) : "v"(lo), "v"(hi)); return r; }
__device__ __forceinline__ float wave_sum(float v) {
#pragma unroll
    for (int o = 1; o < 64; o <<= 1) v += __shfl_xor(v, o);
    return v;
}
#define LDS_WAIT() asm volatile("s_waitcnt lgkmcnt(0)" ::: "memory")

namespace pg8 {
constexpr int BM = 256, BK = 64, HALF = 128, HTB = HALF * BK * 2, STAGE_BYTES = 8 * HTB, NXCD = 8, WGM = 8;
__host__ __device__ __forceinline__ int lds_byte(int r, int c) { const int st = (r >> 4) * 2 + (c >> 5), rr = r & 15, cc = c & 31, ob = rr * 64 + cc * 2; return st * 1024 + (ob ^ (((ob >> 9) & 1) << 5)); }
__host__ __device__ __forceinline__ void stage_rc(int b, int& R, int& C) { const int st = b / 1024, sb = b % 1024, swz = sb ^ (((sb >> 9) & 1) << 5); R = (st >> 1) * 16 + swz / 64; C = (st & 1) * 32 + (swz % 64) / 2; }
__host__ __device__ __forceinline__ int perm32(int rho) { const int n = rho >> 4, i = rho & 15; return 8 * (i >> 2) + 4 * n + (i & 3); }

struct Unit { int pm, pn; };
struct Gemm { const gbf16_t* A; const gbf16_t* Bt; int M, N, K, lda; };

struct StaticOrder {
    int nM, nN, nwg, G, c;
    __device__ void init(int M, int N, int G_, int c_) { nM = M / BM; nN = N / BM; nwg = nM * nN; G = G_; c = c_; }
    __device__ bool next(int i, Unit& u) const {
        const long L = (long)i * G + c; if (L >= nwg) return false;
        int wgid = (int)L; { const int q = nwg / NXCD, r = nwg % NXCD, xcd = wgid % NXCD, off = wgid / NXCD; wgid = (xcd < r ? xcd * (q + 1) : r * (q + 1) + (xcd - r) * q) + off; }
        const int nig = WGM * nN, gid = wgid / nig, fm = gid * WGM, gsz = (nM - fm) < WGM ? (nM - fm) : WGM;
        u.pm = fm + ((wgid % nig) % gsz); u.pn = (wgid % nig) / gsz; return true;
    }
};

struct EpiScaleBf16 {
    static constexpr bool PERM = true;
    gbf16_t* O; int ldc; const gfloat* rs;
    __device__ __forceinline__ void operator()(const f32x4 (&acc)[2][2][4][2], const Unit& u, int wr, int wc, int fr, int fq) const {
        const int row0 = u.pm * BM + wr * 64 + fr, col0 = u.pn * BM + wc * 32 + 8 * fq;
#pragma unroll
        for (int ai = 0; ai < 2; ++ai)
#pragma unroll
            for (int m = 0; m < 4; ++m) { const int row = row0 + ai * HALF + m * 16; const float sc = rs[row]; gbf16_t* rowp = O + (size_t)row * ldc + col0;
#pragma unroll
                for (int bj = 0; bj < 2; ++bj) { const f32x4 v0 = acc[ai][bj][m][0] * sc, v1 = acc[ai][bj][m][1] * sc;
                    u32x4 w; w.x = cvt_pk_bf16(v0[0], v0[1]); w.y = cvt_pk_bf16(v0[2], v0[3]); w.z = cvt_pk_bf16(v1[0], v1[1]); w.w = cvt_pk_bf16(v1[2], v1[3]);
                    *(gu32x4*)(rowp + bj * HALF) = w; } }
    }
};
__device__ __forceinline__ float silu_mul(float g, float u) { const float e = __builtin_amdgcn_exp2f(-g * LOG2E); return g * __builtin_amdgcn_rcpf(1.0f + e) * u; }
struct EpiSwiglu {
    static constexpr bool PERM = true;
    gbf16_t* O; int ldc; const gfloat* rs;
    __device__ __forceinline__ void operator()(const f32x4 (&acc)[2][2][4][2], const Unit& u, int wr, int wc, int fr, int fq) const {
        const int row0 = u.pm * BM + wr * 64 + fr, col0 = u.pn * HALF + wc * 32 + 8 * fq;
#pragma unroll
        for (int ai = 0; ai < 2; ++ai)
#pragma unroll
            for (int m = 0; m < 4; ++m) { const int row = row0 + ai * HALF + m * 16; const float sc = rs[row];
                const f32x4 g0 = acc[ai][0][m][0] * sc, g1 = acc[ai][0][m][1] * sc, u0 = acc[ai][1][m][0] * sc, u1 = acc[ai][1][m][1] * sc;
                u32x4 w; w.x = cvt_pk_bf16(silu_mul(g0[0], u0[0]), silu_mul(g0[1], u0[1])); w.y = cvt_pk_bf16(silu_mul(g0[2], u0[2]), silu_mul(g0[3], u0[3]));
                w.z = cvt_pk_bf16(silu_mul(g1[0], u1[0]), silu_mul(g1[1], u1[1])); w.w = cvt_pk_bf16(silu_mul(g1[2], u1[2]), silu_mul(g1[3], u1[3]));
                *(gu32x4*)(O + (size_t)row * ldc + col0) = w; }
    }
};
struct EpiResidual {
    static constexpr bool PERM = false;
    const gfloat* src_real; const gfloat* src_meta; gfloat* dst_real; gfloat* dst_meta;
    __device__ __forceinline__ void operator()(const f32x4 (&acc)[2][2][4][2], const Unit& u, int wr, int wc, int fr, int fq) const {
        const int row0 = u.pm * BM + wr * 64 + fr, col0 = u.pn * BM + wc * 32 + 4 * fq;
#pragma unroll
        for (int ai = 0; ai < 2; ++ai)
#pragma unroll
            for (int m = 0; m < 4; ++m) { const int row = row0 + ai * HALF + m * 16;
                if (row < NROWS) {
                    const gfloat* s = row < NREAL ? src_real + (size_t)row * DM : src_meta + (size_t)(row - NREAL) * DM;
                    gfloat* d = row < NREAL ? dst_real + (size_t)row * DM : dst_meta + (size_t)(row - NREAL) * DM;
#pragma unroll
                    for (int bj = 0; bj < 2; ++bj)
#pragma unroll
                        for (int n = 0; n < 2; ++n) { const int c = col0 + bj * HALF + n * 16; *(gf32x4*)(d + c) = *(const gf32x4*)(s + c) + acc[ai][bj][m][n]; }
                } }
    }
};

template <class Epi, class Sched>
__device__ __forceinline__ void gemm_phase(LAS unsigned char* lds, const Gemm g, const Sched& S, const Epi& E) {
    int tid_ = threadIdx.x; asm volatile("" : "+v"(tid_));
    const int tid = tid_, wid = __builtin_amdgcn_readfirstlane(tid >> 6), lane = tid & 63, wr = wid >> 2, wc = wid & 3, fr = lane & 15, fq = lane >> 4;
    const int K = g.K, nt = K / BK, lda = g.lda;
    unsigned voffA[2], voffB[2];
#pragma unroll
    for (int i = 0; i < 2; ++i) { int R, C; stage_rc(tid * 16 + i * 8192, R, C); const int Rb = Epi::PERM ? ((R & ~31) + perm32(R & 31)) : R;
        voffA[i] = (unsigned)(R * lda + C) * 2u; voffB[i] = (unsigned)(Rb * K + C) * 2u; }
    const size_t kstep = (size_t)(BK * 2);
    const size_t hstepA = (size_t)HALF * lda * 2, hstepB = (size_t)HALF * K * 2;
    const size_t tstepA = 2 * hstepA, tstepB = 2 * hstepB;
    const unsigned ldsw = (unsigned)wid * 1024u;
    const int aoff = lds_byte(wr * 64 + fr, fq * 8), boff = lds_byte(wc * 32 + fr, fq * 8);
#define PG8_SA(b, h) (((b) * 2 + (h)) * HTB)
#define PG8_SB(b, h) ((4 + (b) * 2 + (h)) * HTB)
#define PG8_STAGE(bufoff, gbase, voff) do { _Pragma("unroll") for (int _i = 0; _i < 2; ++_i) \
        __builtin_amdgcn_global_load_lds((const gunsigned*)((const gchar*)(gbase) + (voff)[_i]), (LAS unsigned*)(lds + (bufoff) + ldsw + _i * 8192), 16, 0, 0); } while (0)
#define PG8_LDA(dst, b, h) do { _Pragma("unroll") for (int m = 0; m < 4; ++m) _Pragma("unroll") for (int k = 0; k < 2; ++k) dst[m][k] = *(const LAS bf16x8*)(lds + PG8_SA(b, h) + aoff + m * 2048 + k * 1024); } while (0)
#define PG8_LDB(dst, b, h) do { _Pragma("unroll") for (int n = 0; n < 2; ++n) _Pragma("unroll") for (int k = 0; k < 2; ++k) dst[n][k] = *(const LAS bf16x8*)(lds + PG8_SB(b, h) + boff + n * 2048 + k * 1024); } while (0)
#define PG8_MMA(ai, bj, At, Bt) do { __builtin_amdgcn_s_setprio(1); _Pragma("unroll") for (int m = 0; m < 4; ++m) _Pragma("unroll") for (int n = 0; n < 2; ++n) _Pragma("unroll") for (int k = 0; k < 2; ++k) \
        acc[ai][bj][m][n] = __builtin_amdgcn_mfma_f32_16x16x32_bf16(Bt[n][k], At[m][k], acc[ai][bj][m][n], 0, 0, 0); __builtin_amdgcn_s_setprio(0); } while (0)
#define PG8_WAIT_V(n) asm volatile("s_waitcnt vmcnt(" #n ")" ::: "memory")
#define PG8_WAIT_L(n) asm volatile("s_waitcnt lgkmcnt(" #n ")" ::: "memory")
#define PG8_BAR __builtin_amdgcn_s_barrier()
#define PG8_SCHED __builtin_amdgcn_sched_barrier(0)
    Unit cur, nxt; int ui = 0;
    if (!S.next(0, cur)) return;
    f32x4 acc[2][2][4][2];
#pragma unroll
    for (int a = 0; a < 2; ++a)
#pragma unroll
        for (int b = 0; b < 2; ++b)
#pragma unroll
            for (int m = 0; m < 4; ++m)
#pragma unroll
                for (int n = 0; n < 2; ++n) acc[a][b][m][n] = (f32x4){0.f, 0.f, 0.f, 0.f};
    bf16x8 At[4][2], B0[2][2], B1[2][2];
    const gchar* cA = (const gchar*)g.A + (size_t)cur.pm * tstepA; const gchar* cB = (const gchar*)g.Bt + (size_t)cur.pn * tstepB;
    PG8_STAGE(PG8_SB(0, 0), cB, voffB); PG8_STAGE(PG8_SB(0, 1), cB + hstepB, voffB); PG8_STAGE(PG8_SA(0, 0), cA, voffA); PG8_STAGE(PG8_SA(0, 1), cA + hstepA, voffA);
    if (wr == 1) PG8_BAR;
    PG8_WAIT_V(2); PG8_BAR;
    PG8_STAGE(PG8_SB(1, 0), cB + kstep, voffB); PG8_STAGE(PG8_SA(1, 0), cA + kstep, voffA); PG8_STAGE(PG8_SB(1, 1), cB + hstepB + kstep, voffB);
    PG8_WAIT_V(6); PG8_BAR;
    for (;;) {
        const bool has_next = S.next(ui + 1, nxt);
        const gchar* nA = has_next ? (const gchar*)g.A + (size_t)nxt.pm * tstepA : cA; const gchar* nB = has_next ? (const gchar*)g.Bt + (size_t)nxt.pn * tstepB : cB;
        for (int t = 0; t < nt; t += 2) {
            const bool last = (t == nt - 2);
            const gchar* a1 = cA + (size_t)(t + 1) * kstep;
            const gchar* a2 = last ? nA : cA + (size_t)(t + 2) * kstep; const gchar* b2 = last ? nB : cB + (size_t)(t + 2) * kstep;
            const gchar* a3 = a2 + kstep; const gchar* b3 = b2 + kstep;
            PG8_LDB(B0, 0, 0); PG8_LDB(B1, 0, 1); PG8_SCHED; PG8_LDA(At, 0, 0); PG8_STAGE(PG8_SA(1, 1), a1 + hstepA, voffA);
            PG8_WAIT_V(8); PG8_WAIT_L(0); PG8_BAR; PG8_MMA(0, 0, At, B0); PG8_MMA(0, 1, At, B1); PG8_BAR; PG8_SCHED;
            PG8_LDA(At, 0, 1); PG8_STAGE(PG8_SB(0, 0), b2, voffB); PG8_STAGE(PG8_SB(0, 1), b2 + hstepB, voffB); PG8_STAGE(PG8_SA(0, 0), a2, voffA);
            PG8_WAIT_V(8); PG8_WAIT_L(0); PG8_BAR; PG8_MMA(1, 0, At, B0); PG8_MMA(1, 1, At, B1); PG8_BAR; PG8_SCHED;
            PG8_LDB(B0, 1, 0); PG8_LDB(B1, 1, 1); PG8_SCHED; PG8_LDA(At, 1, 0); PG8_STAGE(PG8_SA(0, 1), a2 + hstepA, voffA);
            PG8_WAIT_V(8); PG8_WAIT_L(0); PG8_BAR; PG8_MMA(0, 0, At, B0); PG8_MMA(0, 1, At, B1); PG8_BAR; PG8_SCHED;
            PG8_LDA(At, 1, 1); PG8_STAGE(PG8_SB(1, 0), b3, voffB); PG8_STAGE(PG8_SB(1, 1), b3 + hstepB, voffB); PG8_STAGE(PG8_SA(1, 0), a3, voffA);
            PG8_WAIT_V(8); PG8_WAIT_L(0); PG8_BAR; PG8_MMA(1, 0, At, B0); PG8_MMA(1, 1, At, B1); PG8_BAR; PG8_SCHED;
        }
        if (wr == 0) PG8_BAR;
        E(acc, cur, wr, wc, fr, fq);
        if (!has_next) break;
#pragma unroll
        for (int a = 0; a < 2; ++a)
#pragma unroll
            for (int b = 0; b < 2; ++b)
#pragma unroll
                for (int m = 0; m < 4; ++m)
#pragma unroll
                    for (int n = 0; n < 2; ++n) acc[a][b][m][n] = (f32x4){0.f, 0.f, 0.f, 0.f};
        cur = nxt; cA = nA; cB = nB; ++ui;
        if (wr == 1) PG8_BAR;
    }
    PG8_WAIT_V(0);
    PG8_BAR;
#undef PG8_SA
#undef PG8_SB
#undef PG8_STAGE
#undef PG8_LDA
#undef PG8_LDB
#undef PG8_MMA
#undef PG8_WAIT_V
#undef PG8_WAIT_L
#undef PG8_BAR
#undef PG8_SCHED
}
}

namespace att {
#define SBAR() __builtin_amdgcn_sched_barrier(0)
constexpr int OFF_K = 0, OFF_V = 24576, OFF_WS = 24576 + 16384, ATT_LDS = OFF_WS + 8 * 64 * 4;
__device__ __forceinline__ int crow(int r, int hi) { return (r & 3) + 8 * (r >> 2) + 4 * hi; }
__device__ __forceinline__ int v_st(int k, int c) { const int kk = (k & ~0xC) | ((k & 4) << 1) | ((k & 8) >> 1); return ((kk >> 3) * 4 + (c >> 5)) * 512 + ((kk & 7) * 32 + (c & 31)) * 2; }
__device__ __forceinline__ int v_rd_base(int lane) { return ((lane & 3) << 3) | (((lane >> 2) & 3) << 6) | (((lane >> 4) & 1) << 5) | (((lane >> 5) & 1) << 8); }
constexpr int v_rd_off(int d0, int ks, int half) { return d0 * 512 + ks * 4096 + half * 2048; }
template <int OFF> __device__ __forceinline__ s16x4 tr_read(int vb) {
    s16x4 r; asm volatile("ds_read_b64_tr_b16 %0, %1 offset:%2" : "=&v"(r) : "v"(vb), "i"(OFF) : "memory"); return r;
}
template <int D0> __device__ __forceinline__ void pv_one(f32x16& od, int vb, bf16x8 pa0, bf16x8 pa1, bf16x8 pa2, bf16x8 pa3) {
    const s16x4 l0 = tr_read<v_rd_off(D0, 0, 0)>(vb), h0 = tr_read<v_rd_off(D0, 0, 1)>(vb), l1 = tr_read<v_rd_off(D0, 1, 0)>(vb), h1 = tr_read<v_rd_off(D0, 1, 1)>(vb);
    const s16x4 l2 = tr_read<v_rd_off(D0, 2, 0)>(vb), h2 = tr_read<v_rd_off(D0, 2, 1)>(vb), l3 = tr_read<v_rd_off(D0, 3, 0)>(vb), h3 = tr_read<v_rd_off(D0, 3, 1)>(vb);
    asm volatile("s_waitcnt lgkmcnt(0)" ::: "memory"); SBAR();
#define PK(L, H) (bf16x8){L[0], L[1], L[2], L[3], H[0], H[1], H[2], H[3]}
    od = __builtin_amdgcn_mfma_f32_32x32x16_bf16(pa0, PK(l0, h0), od, 0, 0, 0);
    od = __builtin_amdgcn_mfma_f32_32x32x16_bf16(pa1, PK(l1, h1), od, 0, 0, 0);
    od = __builtin_amdgcn_mfma_f32_32x32x16_bf16(pa2, PK(l2, h2), od, 0, 0, 0);
    od = __builtin_amdgcn_mfma_f32_32x32x16_bf16(pa3, PK(l3, h3), od, 0, 0, 0);
#undef PK
}
__device__ __forceinline__ int key_row(int b, int p) { p = p < LSEQ ? p : LSEQ - 1; return p < NMETA ? NREAL + p : b * SEQ + p - NMETA; }

template <int DQK>
__device__ __forceinline__ void attn_map(const gbf16_t* __restrict__ Qp, int ldq, const gbf16_t* __restrict__ Kp, int ldk, const gbf16_t* __restrict__ Vp, int ldv,
                                         int b, int qpos0, int NT, f32x16 (&o)[4], float& l_out, LAS char* lds) {
    constexpr int RB = DQK * 2, CPR = DQK / 8, NKC = (64 * CPR) / 512, ND = DQK / 16;
    int tid_ = threadIdx.x; asm volatile("" : "+v"(tid_));
    const int tid = tid_, wid = __builtin_amdgcn_readfirstlane(tid >> 6), lane = tid & 63, r32 = lane & 31, hi = lane >> 5;
    LAS char* K_lds = lds + OFF_K; LAS char* V_lds = lds + OFF_V; LAS float* al_l = (LAS float*)(lds + OFF_WS) + wid * 64;
    bf16x8 qr[ND];
    { const gbf16_t* Qw = Qp + (size_t)(wid * 32 + r32) * ldq + hi * 8;
#pragma unroll
      for (int d0 = 0; d0 < ND; ++d0) qr[d0] = *(const gbf16x8*)(Qw + d0 * 16); }
    float m_reg = -1e30f, l_reg = 0.f;
#pragma unroll
    for (int d = 0; d < 4; ++d) o[d] = f32x16{};
    const int vb = (int)(unsigned)(uintptr_t)V_lds + v_rd_base(lane);
    const int qpos = qpos0 + wid * 32 + r32, wq_min = qpos0 + wid * 32, wq_max = wq_min + 31;
    int kb4[4];
#pragma unroll
    for (int i = 0; i < 4; ++i) kb4[i] = r32 * RB + (((i * 2 + hi) ^ (r32 & 7)) << 4);
    bf16x8 kst[NKC], vst[2];
#define ATT_SLOAD(j) do { \
        _Pragma("unroll") for (int i_ = 0; i_ < NKC; ++i_) { const int c_ = tid + i_ * 512, row_ = c_ / CPR, cc_ = c_ % CPR; \
            kst[i_] = *(const gbf16x8*)(Kp + (size_t)key_row(b, 64 * (j) + row_) * ldk + cc_ * 8); } \
        _Pragma("unroll") for (int i_ = 0; i_ < 2; ++i_) { const int row_ = (tid >> 4) + 32 * i_, col_ = (tid & 15) * 8; \
            vst[i_] = *(const gbf16x8*)(Vp + (size_t)key_row(b, 64 * (j) + row_) * ldv + col_); } } while (0)
#define ATT_SWRITE() do { \
        _Pragma("unroll") for (int i_ = 0; i_ < NKC; ++i_) { const int c_ = tid + i_ * 512, row_ = c_ / CPR, cc_ = c_ % CPR; \
            *(LAS bf16x8*)(K_lds + row_ * RB + ((cc_ * 16) ^ ((row_ & 7) << 4))) = kst[i_]; } \
        _Pragma("unroll") for (int i_ = 0; i_ < 2; ++i_) { const int row_ = (tid >> 4) + 32 * i_, col_ = (tid & 15) * 8; \
            *(LAS bf16x8*)(V_lds + v_st(row_, col_)) = vst[i_]; } } while (0)
    ATT_SLOAD(0);
    for (int j = 0; j < NT; ++j) {
        __syncthreads();
        ATT_SWRITE();
        __syncthreads();
        if (j + 1 < NT) ATT_SLOAD(j + 1);
        if (64 * j <= wq_max) {
            f32x16 p0 = f32x16{}, p1 = f32x16{};
#pragma unroll
            for (int d0 = 0; d0 < ND; ++d0) { const LAS char* kp_ = K_lds + kb4[d0 & 3] + (d0 >> 2) * 128;
                const bf16x8 b0 = *(const LAS bf16x8*)(kp_);
                const bf16x8 b1 = *(const LAS bf16x8*)(kp_ + 32 * RB);
                p0 = __builtin_amdgcn_mfma_f32_32x32x16_bf16(b0, qr[d0], p0, 0, 0, 0);
                p1 = __builtin_amdgcn_mfma_f32_32x32x16_bf16(b1, qr[d0], p1, 0, 0, 0);
                if ((d0 & 3) == 3) SBAR(); }
            if (64 * j + 63 > wq_min) {
#pragma unroll
                for (int r = 0; r < 16; ++r) { const int kp = 64 * j + crow(r, hi); if (kp > qpos) p0[r] = -1e30f; if (kp + 32 > qpos) p1[r] = -1e30f; }
            }
            float pmax = p0[0];
#pragma unroll
            for (int r = 1; r < 16; ++r) pmax = fmaxf(pmax, p0[r]);
#pragma unroll
            for (int r = 0; r < 16; ++r) pmax = fmaxf(pmax, p1[r]);
            { auto rr = __builtin_amdgcn_permlane32_swap(__float_as_uint(pmax), __float_as_uint(pmax), false, false);
              pmax = fmaxf(__uint_as_float(rr[0]), __uint_as_float(rr[1])); }
            const float mn = fmaxf(m_reg, pmax), alpha = __builtin_amdgcn_exp2f(m_reg - mn); m_reg = mn;
#pragma unroll
            for (int r = 0; r < 16; ++r) { p0[r] = __builtin_amdgcn_exp2f(p0[r] - mn); p1[r] = __builtin_amdgcn_exp2f(p1[r] - mn); }
            float ps = 0.f;
#pragma unroll
            for (int r = 0; r < 16; ++r) ps += p0[r] + p1[r];
            { auto rr = __builtin_amdgcn_permlane32_swap(__float_as_uint(ps), __float_as_uint(ps), false, false);
              ps = __uint_as_float(rr[0]) + __uint_as_float(rr[1]); }
            l_reg = l_reg * alpha + ps;
            bf16x8 pa0, pa1, pa2, pa3;
#define PK4(P, BASE, OUT) do { unsigned a0 = cvt_pk_bf16(P[BASE + 0], P[BASE + 1]), a1 = cvt_pk_bf16(P[BASE + 2], P[BASE + 3]);   \
    unsigned b0_ = cvt_pk_bf16(P[BASE + 4], P[BASE + 5]), b1_ = cvt_pk_bf16(P[BASE + 6], P[BASE + 7]);                              \
    auto r0 = __builtin_amdgcn_permlane32_swap(a0, b0_, false, false); auto r1 = __builtin_amdgcn_permlane32_swap(a1, b1_, false, false); \
    u32x4 w = {r0[0], r1[0], r0[1], r1[1]}; OUT = __builtin_bit_cast(bf16x8, w); } while (0)
            PK4(p0, 0, pa0); PK4(p0, 8, pa1); PK4(p1, 0, pa2); PK4(p1, 8, pa3);
#undef PK4
            if (__any(alpha < 1.f)) {
                if (hi == 0) al_l[r32] = alpha;
                LDS_WAIT();
#pragma unroll
                for (int r = 0; r < 16; ++r) { const float a = al_l[crow(r, hi)];
#pragma unroll
                    for (int d = 0; d < 4; ++d) o[d][r] *= a; }
            }
            pv_one<0>(o[0], vb, pa0, pa1, pa2, pa3); pv_one<1>(o[1], vb, pa0, pa1, pa2, pa3); pv_one<2>(o[2], vb, pa0, pa1, pa2, pa3); pv_one<3>(o[3], vb, pa0, pa1, pa2, pa3);
        }
    }
#undef ATT_SLOAD
#undef ATT_SWRITE
    l_out = l_reg;
}
__device__ __forceinline__ void row_recip(float l, float (&rli)[16], LAS char* lds, int wid, int r32, int hi) {
    LAS float* li_l = (LAS float*)(lds + OFF_WS) + wid * 64 + 32;
    if (hi == 0) li_l[r32] = l;
    LDS_WAIT();
#pragma unroll
    for (int r = 0; r < 16; ++r) rli[r] = __builtin_amdgcn_rcpf(li_l[crow(r, hi)]);
    LDS_WAIT();
}
#undef SBAR
}


#define XB_TMO      128
#define XB_XCNT(j)  (256  + 64 * (j))
#define XB_XSUB(j)  (1280 + 64 * (j))
#define XB_XGEN(j)  (2304 + 64 * (j))
#define XB_TOP      3328
#define XB_TOPGEN   3392
#define XCD_BAR_WORDS 3456
#define XB_SPIN_CAP (1u << 18)
__device__ __forceinline__ unsigned xb_ld(unsigned* p)              { return __hip_atomic_load(p, __ATOMIC_RELAXED, __HIP_MEMORY_SCOPE_AGENT); }
__device__ __forceinline__ unsigned xb_add(unsigned* p, unsigned v) { return __hip_atomic_fetch_add(p, v, __ATOMIC_RELAXED, __HIP_MEMORY_SCOPE_AGENT); }
__device__ __forceinline__ unsigned xb_xcc_id() { return (unsigned)__builtin_amdgcn_s_getreg((3 << 11) | 20) & 0xFu; }
#define XB_SPIN(cond, bar) do { unsigned _sp = 0; while (cond) { __builtin_amdgcn_s_sleep(1); \
    if ((++_sp & 255u) == 0u) { if (xb_ld(&(bar)[XB_TMO])) break; if (_sp > XB_SPIN_CAP) { atomicAdd(&(bar)[XB_TMO], 1u); break; } } } } while (0)
struct XcdBarrier { unsigned* bar; unsigned x; volatile LAS unsigned* st; };
__device__ __forceinline__ XcdBarrier xcd_barrier_post(unsigned* bar, volatile LAS unsigned* st) {
    XcdBarrier b; b.bar = bar; b.x = xb_xcc_id(); b.st = st;
    if (threadIdx.x == 0) (void)xb_add(&bar[XB_XCNT(b.x)], 1u);
    return b;
}
__device__ __forceinline__ void xcd_barrier_complete(unsigned* bar, unsigned x, unsigned& nloc, unsigned& nx) {
    const unsigned G = gridDim.x * gridDim.y * gridDim.z;
    unsigned sum, cnt, mine, sp = 0u;
    for (;;) {
        sum = 0u; cnt = 0u; mine = 0u;
#pragma unroll
        for (unsigned j = 0; j < 16; ++j) { const unsigned c = xb_ld(&bar[XB_XCNT(j)]); sum += c; cnt += (c > 0u) ? 1u : 0u; mine = (j == x) ? c : mine; }
        if (sum == G) break;
        __builtin_amdgcn_s_sleep(1);
        if ((++sp & 255u) == 0u) { if (xb_ld(&bar[XB_TMO])) break; if (sp > XB_SPIN_CAP) { atomicAdd(&bar[XB_TMO], 1u); break; } }
    }
    nloc = mine > 0u ? mine : 1u; nx = cnt > 0u ? cnt : 1u;
}
__device__ __forceinline__ void xcd_barrier(const XcdBarrier& b) {
    asm volatile("s_waitcnt vmcnt(0)" ::: "memory");
    __syncthreads();
    if (threadIdx.x == 0) {
        unsigned* bar = b.bar;
        __builtin_amdgcn_s_waitcnt(0);
        unsigned nloc = b.st[0], nx = b.st[1];
        if (nloc == 0u) { xcd_barrier_complete(bar, b.x, nloc, nx); b.st[0] = nloc; b.st[1] = nx; }
        const unsigned old = xb_add(&bar[XB_XSUB(b.x)], 1u);
        const unsigned gen = old / nloc;
        if (old + 1u == (gen + 1u) * nloc) {
            __builtin_amdgcn_fence(__ATOMIC_RELEASE, "agent");
            asm volatile("s_waitcnt vmcnt(0)" ::: "memory");
            const unsigned og = xb_add(&bar[XB_TOP], 1u);
            const unsigned tg = og / nx;
            if (og + 1u == (tg + 1u) * nx) xb_add(&bar[XB_TOPGEN], 1u);
            else XB_SPIN(xb_ld(&bar[XB_TOPGEN]) == tg, bar);
            __builtin_amdgcn_fence(__ATOMIC_ACQUIRE, "agent");
            xb_add(&bar[XB_XGEN(b.x)], 1u);
            asm volatile("s_waitcnt vmcnt(0)" ::: "memory");
        } else {
            XB_SPIN(xb_ld(&bar[XB_XGEN(b.x)]) == gen, bar);
            __builtin_amdgcn_fence(__ATOMIC_ACQUIRE, "agent");
            asm volatile("s_waitcnt vmcnt(0)" ::: "memory");
        }
    }
    __syncthreads();
}

struct Params { const float* in[21]; float* out; unsigned char* ws; int s_lo, s_hi; };
struct DParams { const gfloat* in[21]; gfloat* out; guchar* ws; int s_lo, s_hi; };
enum { I_X = 0, I_META, I_ATTN_NORM, I_W_IN, I_QA_NORM, I_W_Q_UP, I_KVA_NORM, I_W_KV_UP, I_Q_NORM, I_K_NORM, I_DQ_NORM, I_DK_NORM, I_LQ1, I_LK1, I_LQ2, I_LK2, I_SUBLN, I_W_O, I_FFN_NORM,
       I_W_GU, I_W_D };
constexpr int LDS_BYTES = 147456;
constexpr int NTHREADS = 512, NWAVES = 8;

struct Frame {
    LAS unsigned char* lds; DParams p; int tid, lane, wave, vcu, G, gw, ngw;
};

__device__ __forceinline__ void transpose_item(const gfloat* W, int ldw, int Ksrc, const gfloat* gain, gbf16_t* WT, int Kd, int k0, int sc0, int dr0, LAS float* scr, int lane) {
    const bool zero = (sc0 < 0) || (k0 >= Ksrc);
    const int c = lane & 7;
    if (zero) {
#pragma unroll
        for (int j = 0; j < 4; ++j) { const int n = (lane >> 3) + 8 * j; *(gu32x4*)(WT + (size_t)(dr0 + n) * Kd + k0 + 8 * c) = (u32x4){0u, 0u, 0u, 0u}; }
        return;
    }
#pragma unroll 8
    for (int i = 0; i < 32; ++i) { const int kk = 2 * i + (lane >> 5); const float gsc = gain ? gain[k0 + kk] : 1.0f; scr[kk * 33 + (lane & 31)] = W[(size_t)(k0 + kk) * ldw + sc0 + (lane & 31)] * gsc; }
    LDS_WAIT(); asm volatile("" ::: "memory");
#pragma unroll
    for (int j = 0; j < 4; ++j) { const int n = (lane >> 3) + 8 * j; const LAS float* s = scr + (8 * c) * 33 + n;
        u32x4 o; o.x = pk2(s[0 * 33], s[1 * 33]); o.y = pk2(s[2 * 33], s[3 * 33]); o.z = pk2(s[4 * 33], s[5 * 33]); o.w = pk2(s[6 * 33], s[7 * 33]);
        *(gu32x4*)(WT + (size_t)(dr0 + n) * Kd + k0 + 8 * c) = o; }
    LDS_WAIT(); asm volatile("" ::: "memory");
}
__device__ __forceinline__ void stage_prep(Frame& F) {
    LAS float* scr = (LAS float*)(F.lds + F.wave * 16384);
    const DParams& P = F.p;
    constexpr int IT_IN = 16 * 64, IT_Q = 4 * 32, IT_KV = 4 * 32, IT_O = 16 * 32, IT_GU = 16 * 176, IT_D = 44 * 32, IT_L = IT_IN + IT_Q + IT_KV + IT_O + IT_GU + IT_D;
    for (int it = F.gw; it < 2 * IT_L; it += F.ngw) {
        const int l = it / IT_L; int r = it % IT_L;
        gbf16_t* wb = (gbf16_t*)(P.ws + WS_W + (size_t)l * W_LAYER);
        if (r < IT_IN) { const int kb = r / 64, g = r % 64;
            transpose_item(P.in[I_W_IN] + (size_t)l * DM * INW, INW, DM, P.in[I_ATTN_NORM] + l * DM, (gbf16_t*)((gchar*)wb + W_IN), DM, kb * 64, (32 * g < INW) ? 32 * g : -1, 32 * g, scr, F.lane); continue; }
        r -= IT_IN;
        if (r < IT_Q) { const int kb = r / 32, g = r % 32, h = g >> 3, d0 = (g & 7) * 32;
            transpose_item(P.in[I_W_Q_UP] + (size_t)l * 256 * 768, 768, 256, P.in[I_QA_NORM] + l * 256, (gbf16_t*)((gchar*)wb + W_Q), 256, kb * 64, d0 < 192 ? h * 192 + d0 : -1, 32 * g, scr, F.lane); continue; }
        r -= IT_Q;
        if (r < IT_KV) { const int kb = r / 32, g = r % 32;
            transpose_item(P.in[I_W_KV_UP] + (size_t)l * 128 * 1024, 1024, 128, P.in[I_KVA_NORM] + l * 128, (gbf16_t*)((gchar*)wb + W_KV), 256, kb * 64, 32 * g, 32 * g, scr, F.lane); continue; }
        r -= IT_KV;
        if (r < IT_O) { const int kb = r / 32, g = r % 32;
            transpose_item(P.in[I_W_O] + (size_t)l * DM * DM, DM, DM, nullptr, (gbf16_t*)((gchar*)wb + W_O), DM, kb * 64, 32 * g, 32 * g, scr, F.lane); continue; }
        r -= IT_O;
        if (r < IT_GU) { const int kb = r / 176, g = r % 176, pn = g >> 3, half = (g & 7) >> 2, i0 = (g & 3) * 32;
            transpose_item(P.in[I_W_GU] + (size_t)l * DM * 2 * DFF, 2 * DFF, DM, P.in[I_FFN_NORM] + l * DM, (gbf16_t*)((gchar*)wb + W_GU), DM, kb * 64, half * DFF + pn * 128 + i0, 32 * g, scr, F.lane); continue; }
        r -= IT_GU;
        { const int kb = r / 32, g = r % 32;
          transpose_item(P.in[I_W_D] + (size_t)l * DFF * DM, DM, DFF, nullptr, (gbf16_t*)((gchar*)wb + W_D), DFF, kb * 64, 32 * g, 32 * g, scr, F.lane); }
    }
    gfloat* COS = (gfloat*)(P.ws + WS_COS); gfloat* SIN = (gfloat*)(P.ws + WS_SIN);
    for (int i = blockIdx.x * NTHREADS + F.tid; i < LSEQ * 32; i += F.G * NTHREADS) {
        const int pos = i >> 5, m = i & 31;
        const float inv = 1.0f / powf(10000.0f, (float)(2 * m) / 64.0f), ang = (float)pos * inv;
        COS[i] = cosf(ang); SIN[i] = sinf(ang);
    }
    if (blockIdx.x == 0 && F.tid < DEPTH) {
        const int l = F.tid; float a = 0.f, b = 0.f;
        for (int i = 0; i < 64; ++i) { a += P.in[I_LQ1][l * 64 + i] * P.in[I_LK1][l * 64 + i]; b += P.in[I_LQ2][l * 64 + i] * P.in[I_LK2][l * 64 + i]; }
        const float lam_init = 0.8f - 0.6f * expf(-0.3f * (float)l);
        ((gfloat*)(P.ws + WS_LAM))[l] = expf(a) - expf(b) + lam_init;
    }
}

__device__ __forceinline__ void stage_cast(Frame& F, const gfloat* h_real, const gfloat* h_meta) {
    gbf16_t* XN = (gbf16_t*)(F.p.ws + WS_AO); gfloat* RH = (gfloat*)(F.p.ws + WS_RH);
    for (int row = F.gw; row < NROWS; row += F.ngw) {
        const gfloat* hr = row < NREAL ? h_real + (size_t)row * DM : h_meta + (size_t)(row - NREAL) * DM;
        f32x4 v[4]; float s = 0.f;
#pragma unroll
        for (int j = 0; j < 4; ++j) { v[j] = *((const gf32x4*)hr + F.lane + 64 * j); s += (v[j].x * v[j].x + v[j].y * v[j].y) + (v[j].z * v[j].z + v[j].w * v[j].w); }
        s = wave_sum(s);
        if (F.lane == 0) RH[row] = 1.0f / sqrtf(s * (1.0f / DM) + EPS);
        gu32x2* o8 = (gu32x2*)(XN + (size_t)row * DM) + F.lane;
#pragma unroll
        for (int j = 0; j < 4; ++j) o8[64 * j] = (u32x2){pk2(v[j].x, v[j].y), pk2(v[j].z, v[j].w)};
    }
}

__device__ __forceinline__ void stage_postproj(Frame& F, int l) {
    const DParams& P = F.p;
    const gbf16_t* PROJ = (const gbf16_t*)(P.ws + WS_PROJ); gbf16_t* QD = (gbf16_t*)(P.ws + WS_QD); gbf16_t* KD = (gbf16_t*)(P.ws + WS_KD);
    gfloat* RQ = (gfloat*)(P.ws + WS_RQ); gfloat* RKV = (gfloat*)(P.ws + WS_RKV);
    const gfloat* COS = (const gfloat*)(P.ws + WS_COS); const gfloat* SIN = (const gfloat*)(P.ws + WS_SIN);
    const float gq = P.in[I_DQ_NORM][l * 64 + F.lane], gk = P.in[I_DK_NORM][l * 64 + F.lane];
    for (int row = F.gw; row < NROWS; row += F.ngw) {
        const int pos = row < NREAL ? NMETA + (row & (SEQ - 1)) : row - NREAL;
        const gbf16_t* pr = PROJ + (size_t)row * INWP;
        { const u32x2 v = *(const gu32x2*)(pr + PC_CQ + F.lane * 4); const float a = bf2f(v.x & 0xffffu), b = bf2f(v.x >> 16), c = bf2f(v.y & 0xffffu), d = bf2f(v.y >> 16);
          const float s = wave_sum((a * a + b * b) + (c * c + d * d)); if (F.lane == 0) RQ[row] = 1.0f / sqrtf(s * (1.0f / 256.0f) + EPS); }
        { const unsigned v = *(const gunsigned*)(pr + PC_CKV + F.lane * 2); const float a = bf2f(v & 0xffffu), b = bf2f(v >> 16);
          const float s = wave_sum(a * a + b * b); if (F.lane == 0) RKV[row] = 1.0f / sqrtf(s * (1.0f / 128.0f) + EPS); }
        const float cs = COS[pos * 32 + (F.lane & 31)], sn = SIN[pos * 32 + (F.lane & 31)];
#pragma unroll 4
        for (int seg = 0; seg < 16; ++seg) {
            const float x = bf2f(pr[PC_DQ + seg * 64 + F.lane]);
            const float r = 1.0f / sqrtf(wave_sum(x * x) * (1.0f / 64.0f) + EPS);
            const float y = x * r * (seg < 8 ? gq : gk), pt = __shfl_xor(y, 32);
            const float o = F.lane < 32 ? y * cs - pt * sn : y * cs + pt * sn;
            if (seg < 8) QD[(size_t)row * 512 + seg * 64 + F.lane] = (bf16_t)f2bf(o * CD);
            else KD[(size_t)row * 512 + (seg - 8) * 64 + F.lane] = (bf16_t)f2bf(o);
        }
    }
}

__device__ __forceinline__ void stage_mla_qk(Frame& F, int l) {
    const DParams& P = F.p;
    const gbf16_t* PROJ = (const gbf16_t*)(P.ws + WS_PROJ); const gbf16_t* QRAW = (const gbf16_t*)(P.ws + WS_AO); const gbf16_t* KVRAW = (const gbf16_t*)(P.ws + WS_KVRAW);
    gbf16_t* QA = (gbf16_t*)(P.ws + WS_QA); gbf16_t* KA = (gbf16_t*)(P.ws + WS_KA);
    const gfloat* COS = (const gfloat*)(P.ws + WS_COS); const gfloat* SIN = (const gfloat*)(P.ws + WS_SIN);
    const gfloat* gqp = P.in[I_Q_NORM] + l * 192; const gfloat* gkp = P.in[I_K_NORM] + l * 192;
    const float gq0 = gqp[F.lane], gq1 = gqp[64 + F.lane], gq2 = gqp[128 + F.lane], gk0 = gkp[F.lane], gk1 = gkp[64 + F.lane], gk2 = gkp[128 + F.lane];
    for (int row = F.gw; row < NROWS; row += F.ngw) {
        const int pos = row < NREAL ? NMETA + (row & (SEQ - 1)) : row - NREAL;
        const float cs = COS[pos * 32 + (F.lane & 31)], sn = SIN[pos * 32 + (F.lane & 31)];
        const float kr = bf2f(PROJ[(size_t)row * INWP + PC_KR + F.lane]);
#pragma unroll
        for (int h = 0; h < 4; ++h) {
            { const gbf16_t* qp = QRAW + (size_t)row * 1024 + h * 256;
              const float x0 = bf2f(qp[F.lane]), x1 = bf2f(qp[64 + F.lane]), x2 = bf2f(qp[128 + F.lane]);
              const float r = 1.0f / sqrtf(wave_sum(x0 * x0 + x1 * x1 + x2 * x2) * (1.0f / 192.0f) + EPS);
              const float y0 = x0 * r * gq0, y1 = x1 * r * gq1, y2 = x2 * r * gq2, pt = __shfl_xor(y2, 32);
              const float y2r = F.lane < 32 ? y2 * cs - pt * sn : y2 * cs + pt * sn;
              gbf16_t* qo = QA + (size_t)row * 768 + h * 192;
              qo[F.lane] = (bf16_t)f2bf(y0 * CA); qo[64 + F.lane] = (bf16_t)f2bf(y1 * CA); qo[128 + F.lane] = (bf16_t)f2bf(y2r * CA); }
            { const gbf16_t* kp = KVRAW + (size_t)row * 1024 + h * 256;
              const float x0 = bf2f(kp[F.lane]), x1 = bf2f(kp[64 + F.lane]), x2 = kr;
              const float r = 1.0f / sqrtf(wave_sum(x0 * x0 + x1 * x1 + x2 * x2) * (1.0f / 192.0f) + EPS);
              const float y0 = x0 * r * gk0, y1 = x1 * r * gk1, y2 = x2 * r * gk2, pt = __shfl_xor(y2, 32);
              const float y2r = F.lane < 32 ? y2 * cs - pt * sn : y2 * cs + pt * sn;
              gbf16_t* ko = KA + (size_t)row * 768 + h * 192;
              ko[F.lane] = (bf16_t)f2bf(y0); ko[64 + F.lane] = (bf16_t)f2bf(y1); ko[128 + F.lane] = (bf16_t)f2bf(y2r); }
        }
    }
}

__device__ __forceinline__ void attn_unit_mla(Frame& F, int b, int h, int qrow0, int qpos0, int NT, int nvalid) {
    const DParams& P = F.p;
    const gbf16_t* QA = (const gbf16_t*)(P.ws + WS_QA); const gbf16_t* KA = (const gbf16_t*)(P.ws + WS_KA); const gbf16_t* KVRAW = (const gbf16_t*)(P.ws + WS_KVRAW);
    gbf16_t* AO = (gbf16_t*)(P.ws + WS_AO);
    const int r32 = F.lane & 31, hi = F.lane >> 5;
    f32x16 o[4]; float l;
    att::attn_map<192>(QA + (size_t)qrow0 * 768 + h * 192, 768, KA + h * 192, 768, KVRAW + h * 256 + 128, 1024, b, qpos0, NT, o, l, (LAS char*)F.lds);
    float rli[16]; att::row_recip(l, rli, (LAS char*)F.lds, F.wave, r32, hi);
#pragma unroll
    for (int r = 0; r < 16; ++r) { const int lr = F.wave * 32 + att::crow(r, hi);
        if (lr < nvalid) { gbf16_t* op = AO + (size_t)(qrow0 + lr) * DM + h * 128 + r32;
#pragma unroll
            for (int d0 = 0; d0 < 4; ++d0) op[d0 * 32] = (bf16_t)f2bf(o[d0][r] * rli[r]); } }
}
__device__ __forceinline__ void attn_unit_diff(Frame& F, int l_idx, int b, int h, int qrow0, int qpos0, int NT, int nvalid) {
    const DParams& P = F.p;
    const gbf16_t* QD = (const gbf16_t*)(P.ws + WS_QD); const gbf16_t* KD = (const gbf16_t*)(P.ws + WS_KD); const gbf16_t* PROJ = (const gbf16_t*)(P.ws + WS_PROJ);
    gbf16_t* AO = (gbf16_t*)(P.ws + WS_AO);
    gf32x4* tmp = (gf32x4*)((gfloat*)(P.ws + WS_TMP) + ((size_t)blockIdx.x * 512 + F.tid) * 64);
    const int r32 = F.lane & 31, hi = F.lane >> 5;
    const float lam = ((const gfloat*)(P.ws + WS_LAM))[l_idx];
    const float lam_init = 0.8f - 0.6f * expf(-0.3f * (float)l_idx);
    f32x16 o[4]; float lsum; float rli[16];
#pragma unroll 1
    for (int c = 0; c < 2; ++c) {
        att::attn_map<64>(QD + (size_t)qrow0 * 512 + h * 128 + c * 64, 512, KD + h * 128 + c * 64, 512, PROJ + PC_DV + h * 128, INWP, b, qpos0, NT, o, lsum, (LAS char*)F.lds);
        att::row_recip(lsum, rli, (LAS char*)F.lds, F.wave, r32, hi);
        if (c == 0) {
#pragma unroll
            for (int d = 0; d < 4; ++d)
#pragma unroll
                for (int q = 0; q < 4; ++q) tmp[d * 4 + q] = (f32x4){o[d][4 * q] * rli[4 * q], o[d][4 * q + 1] * rli[4 * q + 1], o[d][4 * q + 2] * rli[4 * q + 2], o[d][4 * q + 3] * rli[4 * q + 3]};
        }
    }
    float ss[16];
#pragma unroll
    for (int r = 0; r < 16; ++r) ss[r] = 0.f;
#pragma unroll
    for (int d = 0; d < 4; ++d) {
#pragma unroll
        for (int q = 0; q < 4; ++q) { const f32x4 t = tmp[d * 4 + q];
#pragma unroll
            for (int e = 0; e < 4; ++e) { const int r = 4 * q + e; const float v = t[e] - lam * rli[r] * o[d][r]; o[d][r] = v; ss[r] += v * v; } }
        asm volatile("" ::: "memory"); }
#pragma unroll
    for (int off = 1; off < 32; off <<= 1)
#pragma unroll
        for (int r = 0; r < 16; ++r) ss[r] += __shfl_xor(ss[r], off);
    const gfloat* gs = P.in[I_SUBLN] + l_idx * 128; const float post = 1.0f - lam_init;
    float gcol[4];
#pragma unroll
    for (int d = 0; d < 4; ++d) gcol[d] = gs[d * 32 + r32] * post;
#pragma unroll
    for (int r = 0; r < 16; ++r) { const int lr = F.wave * 32 + att::crow(r, hi); const float rn = 1.0f / sqrtf(ss[r] * (1.0f / 128.0f) + EPS);
        if (lr < nvalid) { gbf16_t* op = AO + (size_t)(qrow0 + lr) * DM + 512 + h * 128 + r32;
#pragma unroll
            for (int d0 = 0; d0 < 4; ++d0) op[d0 * 32] = (bf16_t)f2bf(o[d0][r] * rn * gcol[d0]); } }
}
__device__ __forceinline__ void stage_attention(Frame& F, int l) {
    const int v = F.vcu, bh = v >> 2, s = v & 3, b = bh >> 2, h = bh & 3;
#pragma unroll 1
    for (int u = 0; u < 5; ++u) {
        int type, b_, h_, qrow0, qpos0, NT, nvalid;
        if (u < 4) { const int qb = (u & 1) ? 7 - s : s; type = u >> 1; b_ = b; h_ = h; qrow0 = b * SEQ + qb * 256; qpos0 = NMETA + qb * 256; NT = 4 * qb + 5; nvalid = 256; }
        else { if (v >= 8) break; type = v >> 2; b_ = 0; h_ = v & 3; qrow0 = NREAL; qpos0 = 0; NT = 1; nvalid = NMETA; }
        if (type == 0) attn_unit_mla(F, b_, h_, qrow0, qpos0, NT, nvalid);
        else attn_unit_diff(F, l, b_, h_, qrow0, qpos0, NT, nvalid);
    }
    __syncthreads();
}

constexpr int SPL = 11, NSTAGES = 1 + SPL * DEPTH;
__device__ __forceinline__ bool stage_needs_sync(int st) { return !(st >= 1 && (st - 1) % SPL == 4); }
__device__ __forceinline__ void run_stage(const Params& p, LAS unsigned char* ldsp, int st) {
    Frame F;
    F.lds = ldsp;
    { int t = threadIdx.x; asm volatile("" : "+v"(t)); F.tid = t; }
    { unsigned char* w = p.ws; asm volatile("" : "+s"(w)); F.p.ws = (guchar*)w; }
#pragma unroll
    for (int i = 0; i < 21; ++i) F.p.in[i] = (const gfloat*)p.in[i];
    F.p.out = (gfloat*)p.out; F.p.s_lo = p.s_lo; F.p.s_hi = p.s_hi;
    F.lane = F.tid & 63; F.wave = __builtin_amdgcn_readfirstlane(F.tid >> 6);
    F.G = gridDim.x; { const int bx = blockIdx.x; F.vcu = (F.G % 8 == 0) ? (bx % 8) * (F.G / 8) + bx / 8 : bx; }
    F.gw = blockIdx.x * NWAVES + F.wave; F.ngw = F.G * NWAVES;
    const DParams& P = F.p;
    guchar* ws = P.ws;
    if (st == 0) { stage_prep(F); return; }
    const int l = (st - 1) / SPL, s = (st - 1) % SPL;
    const gchar* wb = (const gchar*)(ws + WS_W + (size_t)l * W_LAYER);
    gfloat* HM = (gfloat*)(ws + WS_HM);
    int kind = -1; pg8::Gemm g{nullptr, nullptr, MP, 0, 0, 0};
    gbf16_t* eo = nullptr; int eld = 0; const gfloat* ers = nullptr;
    const gfloat* sr = nullptr; const gfloat* sm = nullptr;
    switch (s) {
    case 0: stage_cast(F, l == 0 ? P.in[I_X] : P.out, l == 0 ? P.in[I_META] : HM); break;
    case 1: kind = 0; g.A = (const gbf16_t*)(ws + WS_AO); g.Bt = (const gbf16_t*)(wb + W_IN); g.N = INWP; g.K = DM; g.lda = DM; eo = (gbf16_t*)(ws + WS_PROJ); eld = INWP; ers = (const gfloat*)(ws + WS_RH); break;
    case 2: stage_postproj(F, l); break;
    case 3: kind = 0; g.A = (const gbf16_t*)(ws + WS_PROJ) + PC_CQ; g.Bt = (const gbf16_t*)(wb + W_Q); g.N = 1024; g.K = 256; g.lda = INWP; eo = (gbf16_t*)(ws + WS_AO); eld = 1024; ers = (const gfloat*)(ws + WS_RQ); break;
    case 4: kind = 0; g.A = (const gbf16_t*)(ws + WS_PROJ) + PC_CKV; g.Bt = (const gbf16_t*)(wb + W_KV); g.N = 1024; g.K = 256; g.lda = INWP; eo = (gbf16_t*)(ws + WS_KVRAW); eld = 1024; ers = (const gfloat*)(ws + WS_RKV); break;
    case 5: stage_mla_qk(F, l); break;
    case 6: stage_attention(F, l); break;
    case 7: kind = 2; g.A = (const gbf16_t*)(ws + WS_AO); g.Bt = (const gbf16_t*)(wb + W_O); g.N = DM; g.K = DM; g.lda = DM; sr = l == 0 ? P.in[I_X] : P.out; sm = l == 0 ? P.in[I_META] : HM; break;
    case 8: stage_cast(F, P.out, HM); break;
    case 9: kind = 1; g.A = (const gbf16_t*)(ws + WS_AO); g.Bt = (const gbf16_t*)(wb + W_GU); g.N = 2 * DFF; g.K = DM; g.lda = DM; eo = (gbf16_t*)(ws + WS_ACT); eld = DFF; ers = (const gfloat*)(ws + WS_RH); break;
    case 10: kind = 2; g.A = (const gbf16_t*)(ws + WS_ACT); g.Bt = (const gbf16_t*)(wb + W_D); g.N = DM; g.K = DFF; g.lda = DFF; sr = P.out; sm = HM; break;
    }
    if (kind >= 0) {
        pg8::StaticOrder S; S.init(MP, g.N, F.G, (int)blockIdx.x);
        if (kind == 0) { pg8::EpiScaleBf16 E{eo, eld, ers}; pg8::gemm_phase(F.lds, g, S, E); }
        else if (kind == 1) { pg8::EpiSwiglu E{eo, eld, ers}; pg8::gemm_phase(F.lds, g, S, E); }
        else { pg8::EpiResidual E{sr, sm, P.out, HM}; pg8::gemm_phase(F.lds, g, S, E); }
    }
}

__global__ void __launch_bounds__(NTHREADS, 2) stage_kernel(Params p) {
    extern __shared__ __attribute__((aligned(16))) unsigned char lds[];
#pragma unroll 1
    for (int st = p.s_lo; st < p.s_hi; ++st) run_stage(p, (LAS unsigned char*)lds, st);
}
constexpr int LDS_MISC_OFF = 131072 + 4096;
constexpr size_t CTL_BAR_OFF = 16384;
__global__ void __launch_bounds__(NTHREADS, 2) mega_kernel(Params p) {
    extern __shared__ __attribute__((aligned(16))) unsigned char lds[];
    cg::grid_group grid = cg::this_grid();
    volatile LAS unsigned* misc = (volatile LAS unsigned*)((LAS unsigned char*)lds + LDS_MISC_OFF);
    if (threadIdx.x < 4) misc[threadIdx.x] = 0u;
    __syncthreads();
    const XcdBarrier bar = xcd_barrier_post((unsigned*)(p.ws + WS_CTL + CTL_BAR_OFF), misc);
#pragma unroll 1
    for (int st = p.s_lo; st < p.s_hi; ++st) {
        if (st > p.s_lo && stage_needs_sync(st)) { if (st == 1) grid.sync(); else xcd_barrier(bar); }
        run_stage(p, (LAS unsigned char*)lds, st);
    }
}

extern "C" void kernel_launch(void* const* d_in, const int* in_sizes, int n_in, void* d_out, int out_size, void* d_ws, size_t ws_size, hipStream_t stream) {
    static int state = 0;
    if (state == 0) {
        if (n_in != 21 || in_sizes[0] != NREAL * DM || out_size != NREAL * DM || ws_size < WS_END) {
            fprintf(stderr, "kernel_launch: unexpected shapes: n_in %d in0 %d out %d ws %zu (need %zu)\n", n_in, n_in > 0 ? in_sizes[0] : -1, out_size, ws_size, (size_t)WS_END); state = -1; return; }
        int dev = 0, cus = 0;
        hipGetDevice(&dev); hipDeviceGetAttribute(&cus, hipDeviceAttributeMultiprocessorCount, dev);
        if (hipFuncSetAttribute((const void*)stage_kernel, hipFuncAttributeMaxDynamicSharedMemorySize, LDS_BYTES) != hipSuccess ||
            hipFuncSetAttribute((const void*)mega_kernel, hipFuncAttributeMaxDynamicSharedMemorySize, LDS_BYTES) != hipSuccess) { fprintf(stderr, "kernel_launch: hipFuncSetAttribute failed\n"); state = -1; return; }
        int per_cu = 0;
        hipOccupancyMaxActiveBlocksPerMultiprocessor(&per_cu, (const void*)mega_kernel, NTHREADS, LDS_BYTES);
        (void)hipGetLastError();
        if (cus != 256 || per_cu < 1) { fprintf(stderr, "kernel_launch: needs a 256-CU device with one resident workgroup per CU (cus %d, per_cu %d)\n", cus, per_cu); state = -1; return; }
        state = 1;
    }
    if (state < 0) return;
    Params p{};
    for (int i = 0; i < 21; ++i) p.in[i] = (const float*)d_in[i];
    p.out = (float*)d_out; p.ws = (unsigned char*)d_ws;
#if MK_ONE_LAUNCH
    p.s_lo = 0; p.s_hi = NSTAGES;
    if (hipMemsetAsync((char*)d_ws + WS_CTL, 0, 65536, stream) != hipSuccess) { fprintf(stderr, "kernel_launch: hipMemsetAsync failed\n"); return; }
    void* args[] = {&p};
    hipError_t e = hipLaunchCooperativeKernel((const void*)mega_kernel, dim3(256), dim3(NTHREADS), args, LDS_BYTES, stream);
    if (e != hipSuccess) fprintf(stderr, "kernel_launch: cooperative launch failed: %s\n", hipGetErrorString(e));
#else
    for (int st = 0; st < NSTAGES; ++st) {
        p.s_lo = st; p.s_hi = st + 1;
        hipLaunchKernelGGL(stage_kernel, dim3(256), dim3(NTHREADS), LDS_BYTES, stream, p);
    }
    const hipError_t le = hipPeekAtLastError();
    if (le != hipSuccess) fprintf(stderr, "kernel_launch: launch failed: %s\n", hipGetErrorName(le));
#endif
}
```

```cpp
#include <hip/hip_runtime.h>
#include <hip/hip_cooperative_groups.h>
#include <cstdio>
#include <cstdint>
namespace cg = cooperative_groups;

#ifndef MK_ONE_LAUNCH
#define MK_ONE_LAUNCH 1
#endif

constexpr int DM = 1024, BATCH = 16, SEQ = 2048, NMETA = 16, DEPTH = 2;
constexpr int NREAL = BATCH * SEQ;
constexpr int NROWS = NREAL + NMETA;
constexpr int MP = 33024;
constexpr int LSEQ = SEQ + NMETA;
constexpr int INW = 1984, INWP = 2048, DFF = 2816;
constexpr float EPS = 1e-6f;
constexpr float LOG2E = 1.4426950408889634f;
constexpr float CA = 0.07216878364870322f * LOG2E;
constexpr float CD = 0.125f * LOG2E;
constexpr int PC_CQ = 0, PC_CKV = 256, PC_KR = 384, PC_DQ = 448, PC_DK = 960, PC_DV = 1472;

constexpr size_t MiB = 1u << 20;
constexpr size_t WS_CTL = 0;
constexpr size_t WS_RH = 1 * MiB;
constexpr size_t WS_RQ = WS_RH + 256 * 1024;
constexpr size_t WS_RKV = WS_RQ + 256 * 1024;
constexpr size_t WS_HM = WS_RKV + 256 * 1024;
constexpr size_t WS_LAM = WS_HM + 64 * 1024;
constexpr size_t WS_MSSQ = WS_LAM + 1024;
constexpr size_t WS_COS = 2 * MiB;
constexpr size_t WS_SIN = WS_COS + 512 * 1024;
constexpr size_t WS_W = 4 * MiB;
constexpr size_t W_IN = 0, W_Q = W_IN + (size_t)INWP * DM * 2, W_KV = W_Q + (size_t)1024 * 256 * 2, W_O = W_KV + (size_t)1024 * 256 * 2,
                 W_GU = W_O + (size_t)DM * DM * 2, W_D = W_GU + (size_t)2 * DFF * DM * 2, W_LAYER = W_D + (size_t)DM * DFF * 2;
static_assert(WS_W + 2 * W_LAYER <= 52 * MiB, "weights");
constexpr size_t WS_PROJ = 52 * MiB;
constexpr size_t WS_KVRAW = WS_PROJ + (size_t)MP * INWP * 2;
constexpr size_t WS_QA = WS_KVRAW + (size_t)MP * 1024 * 2;
constexpr size_t WS_KA = WS_QA + (size_t)MP * 768 * 2;
constexpr size_t WS_QD = WS_KA + (size_t)MP * 768 * 2;
constexpr size_t WS_KD = WS_QD + (size_t)MP * 512 * 2;
constexpr size_t WS_AO = WS_KD + (size_t)MP * 512 * 2;
constexpr size_t WS_TMP = WS_AO + (size_t)MP * 1024 * 2;
constexpr size_t WS_SSQH = WS_TMP + (size_t)256 * 64 * 512 * 4;
constexpr size_t WS_END = WS_SSQH + (size_t)NREAL * 16 * 4;
constexpr size_t WS_QRAW = WS_AO;
constexpr size_t WS_XN2 = WS_QA;
constexpr size_t WS_ACT = WS_PROJ;
static_assert(WS_ACT + (size_t)MP * DFF * 2 <= WS_QA, "ACT overlay");

#define LAS __attribute__((address_space(3)))
typedef unsigned short bf16_t;
typedef short bf16x8 __attribute__((ext_vector_type(8)));
typedef short s16x4 __attribute__((ext_vector_type(4)));
typedef float f32x4 __attribute__((ext_vector_type(4)));
typedef float f32x16 __attribute__((ext_vector_type(16)));
typedef unsigned u32x4 __attribute__((ext_vector_type(4)));
typedef unsigned u32x2 __attribute__((ext_vector_type(2)));
#define GAS __attribute__((address_space(1)))
typedef GAS bf16_t gbf16_t; typedef GAS float gfloat; typedef GAS unsigned char guchar; typedef GAS char gchar; typedef GAS unsigned gunsigned;
typedef GAS u32x4 gu32x4; typedef GAS u32x2 gu32x2; typedef GAS f32x4 gf32x4; typedef GAS bf16x8 gbf16x8;

__device__ __forceinline__ unsigned f2bf(float f) { unsigned u = __builtin_bit_cast(unsigned, f); return (u + 0x7fffu + ((u >> 16) & 1u)) >> 16; }
__device__ __forceinline__ unsigned pk2(float lo, float hi) { return f2bf(lo) | (f2bf(hi) << 16); }
__device__ __forceinline__ float bf2f(unsigned b) { return __builtin_bit_cast(float, b << 16); }
__device__ __forceinline__ unsigned cvt_pk_bf16(float lo, float hi) { unsigned r; asm volatile("v_cvt_pk_bf16_f32 %0, %1, %2" : "=v"(r) : "v"(lo), "v"(hi)); return r; }
__device__ __forceinline__ float wave_sum(float v) {
#pragma unroll
    for (int o = 1; o < 64; o <<= 1) v += __shfl_xor(v, o);
    return v;
}
#define LDS_WAIT() asm volatile("s_waitcnt lgkmcnt(0)" ::: "memory")

namespace pg8 {
constexpr int BM = 256, BK = 64, HALF = 128, HTB = HALF * BK * 2, STAGE_BYTES = 8 * HTB, NXCD = 8, WGM = 8;
__host__ __device__ __forceinline__ int lds_byte(int r, int c) { const int st = (r >> 4) * 2 + (c >> 5), rr = r & 15, cc = c & 31, ob = rr * 64 + cc * 2; return st * 1024 + (ob ^ (((ob >> 9) & 1) << 5)); }
__host__ __device__ __forceinline__ void stage_rc(int b, int& R, int& C) { const int st = b / 1024, sb = b % 1024, swz = sb ^ (((sb >> 9) & 1) << 5); R = (st >> 1) * 16 + swz / 64; C = (st & 1) * 32 + (swz % 64) / 2; }
__host__ __device__ __forceinline__ int perm32(int rho) { const int n = rho >> 4, i = rho & 15; return 8 * (i >> 2) + 4 * n + (i & 3); }

struct Unit { int pm, pn; };
struct Gemm { const gbf16_t* A; const gbf16_t* Bt; int M, N, K, lda; };

struct StaticOrder {
    int nM, nN, nwg, G, c;
    __device__ void init(int M, int N, int G_, int c_) { nM = M / BM; nN = N / BM; nwg = nM * nN; G = G_; c = c_; }
    __device__ bool next(int i, Unit& u) const {
        const long L = (long)i * G + c; if (L >= nwg) return false;
        int wgid = (int)L; { const int q = nwg / NXCD, r = nwg % NXCD, xcd = wgid % NXCD, off = wgid / NXCD; wgid = (xcd < r ? xcd * (q + 1) : r * (q + 1) + (xcd - r) * q) + off; }
        const int nig = WGM * nN, gid = wgid / nig, fm = gid * WGM, gsz = (nM - fm) < WGM ? (nM - fm) : WGM;
        u.pm = fm + ((wgid % nig) % gsz); u.pn = (wgid % nig) / gsz; return true;
    }
};

__device__ __forceinline__ void row_scales(float (&sc)[2][4], const gfloat* rs, const gfloat* part, int row0, int fq) {
#pragma unroll
    for (int ai = 0; ai < 2; ++ai)
#pragma unroll
        for (int m = 0; m < 4; ++m) { const int row = row0 + ai * HALF + m * 16;
            if (part) { const f32x4 v = *(const gf32x4*)(part + (size_t)row * 16 + 4 * fq); float s = (v[0] + v[1]) + (v[2] + v[3]);
                s += __shfl_xor(s, 16); s += __shfl_xor(s, 32); sc[ai][m] = 1.0f / sqrtf(s * (1.0f / DM) + EPS); }
            else sc[ai][m] = rs[row]; }
}
struct EpiScaleBf16 {
    static constexpr bool PERM = true;
    gbf16_t* O; int ldc; const gfloat* rs; const gfloat* part;
    __device__ __forceinline__ void operator()(const f32x4 (&acc)[2][2][4][2], const Unit& u, int wr, int wc, int fr, int fq) const {
        const int row0 = u.pm * BM + wr * 64 + fr, col0 = u.pn * BM + wc * 32 + 8 * fq;
        float sc[2][4]; row_scales(sc, rs, part, row0, fq);
#pragma unroll
        for (int ai = 0; ai < 2; ++ai)
#pragma unroll
            for (int m = 0; m < 4; ++m) { const int row = row0 + ai * HALF + m * 16; const float s = sc[ai][m]; gbf16_t* rowp = O + (size_t)row * ldc + col0;
#pragma unroll
                for (int bj = 0; bj < 2; ++bj) { const f32x4 v0 = acc[ai][bj][m][0] * s, v1 = acc[ai][bj][m][1] * s;
                    u32x4 w; w.x = cvt_pk_bf16(v0[0], v0[1]); w.y = cvt_pk_bf16(v0[2], v0[3]); w.z = cvt_pk_bf16(v1[0], v1[1]); w.w = cvt_pk_bf16(v1[2], v1[3]);
                    *(gu32x4*)(rowp + bj * HALF) = w; } }
    }
};
__device__ __forceinline__ float silu_mul(float g, float u) { const float e = __builtin_amdgcn_exp2f(-g * LOG2E); return g * __builtin_amdgcn_rcpf(1.0f + e) * u; }
struct EpiSwiglu {
    static constexpr bool PERM = true;
    gbf16_t* O; int ldc; const gfloat* rs; const gfloat* part;
    __device__ __forceinline__ void operator()(const f32x4 (&acc)[2][2][4][2], const Unit& u, int wr, int wc, int fr, int fq) const {
        const int row0 = u.pm * BM + wr * 64 + fr, col0 = u.pn * HALF + wc * 32 + 8 * fq;
        float sc[2][4]; row_scales(sc, rs, part, row0, fq);
#pragma unroll
        for (int ai = 0; ai < 2; ++ai)
#pragma unroll
            for (int m = 0; m < 4; ++m) { const int row = row0 + ai * HALF + m * 16; const float s = sc[ai][m];
                const f32x4 g0 = acc[ai][0][m][0] * s, g1 = acc[ai][0][m][1] * s, u0 = acc[ai][1][m][0] * s, u1 = acc[ai][1][m][1] * s;
                u32x4 w; w.x = cvt_pk_bf16(silu_mul(g0[0], u0[0]), silu_mul(g0[1], u0[1])); w.y = cvt_pk_bf16(silu_mul(g0[2], u0[2]), silu_mul(g0[3], u0[3]));
                w.z = cvt_pk_bf16(silu_mul(g1[0], u1[0]), silu_mul(g1[1], u1[1])); w.w = cvt_pk_bf16(silu_mul(g1[2], u1[2]), silu_mul(g1[3], u1[3]));
                *(gu32x4*)(O + (size_t)row * ldc + col0) = w; }
    }
};
struct EpiResidual {
    static constexpr bool PERM = false;
    const gfloat* src; gfloat* dst; gbf16_t* XN; gfloat* part;
    __device__ __forceinline__ void operator()(const f32x4 (&acc)[2][2][4][2], const Unit& u, int wr, int wc, int fr, int fq) const {
        const int row0 = u.pm * BM + wr * 64 + fr, col0 = u.pn * BM + wc * 32 + 4 * fq;
#pragma unroll
        for (int ai = 0; ai < 2; ++ai)
#pragma unroll
            for (int m = 0; m < 4; ++m) { const int row = row0 + ai * HALF + m * 16;
                const gfloat* s = src + (size_t)row * DM; gfloat* d = dst + (size_t)row * DM; gbf16_t* x = XN + (size_t)row * DM; float q = 0.f;
#pragma unroll
                for (int bj = 0; bj < 2; ++bj)
#pragma unroll
                    for (int n = 0; n < 2; ++n) { const int c = col0 + bj * HALF + n * 16; const f32x4 h = *(const gf32x4*)(s + c) + acc[ai][bj][m][n];
                        *(gf32x4*)(d + c) = h; *(gu32x2*)(x + c) = (u32x2){cvt_pk_bf16(h[0], h[1]), cvt_pk_bf16(h[2], h[3])};
                        q += (h[0] * h[0] + h[1] * h[1]) + (h[2] * h[2] + h[3] * h[3]); }
                q += __shfl_xor(q, 16); q += __shfl_xor(q, 32);
                if (fq == 0) part[(size_t)row * 16 + u.pn * 4 + wc] = q; }
    }
};

template <class Epi, class Sched>
__device__ __forceinline__ void gemm_phase(LAS unsigned char* lds, const Gemm g, const Sched& S, const Epi& E) {
    int tid_ = threadIdx.x; asm volatile("" : "+v"(tid_));
    const int tid = tid_, wid = __builtin_amdgcn_readfirstlane(tid >> 6), lane = tid & 63, wr = wid >> 2, wc = wid & 3, fr = lane & 15, fq = lane >> 4;
    const int K = g.K, nt = K / BK, lda = g.lda;
    unsigned voffA[2], voffB[2];
#pragma unroll
    for (int i = 0; i < 2; ++i) { int R, C; stage_rc(tid * 16 + i * 8192, R, C); const int Rb = Epi::PERM ? ((R & ~31) + perm32(R & 31)) : R;
        voffA[i] = (unsigned)(R * lda + C) * 2u; voffB[i] = (unsigned)(Rb * K + C) * 2u; }
    const size_t kstep = (size_t)(BK * 2);
    const size_t hstepA = (size_t)HALF * lda * 2, hstepB = (size_t)HALF * K * 2;
    const size_t tstepA = 2 * hstepA, tstepB = 2 * hstepB;
    const unsigned ldsw = (unsigned)wid * 1024u;
    const int aoff = lds_byte(wr * 64 + fr, fq * 8), boff = lds_byte(wc * 32 + fr, fq * 8);
#define PG8_SA(b, h) (((b) * 2 + (h)) * HTB)
#define PG8_SB(b, h) ((4 + (b) * 2 + (h)) * HTB)
#define PG8_STAGE(bufoff, gbase, voff) do { _Pragma("unroll") for (int _i = 0; _i < 2; ++_i) \
        __builtin_amdgcn_global_load_lds((const gunsigned*)((const gchar*)(gbase) + (voff)[_i]), (LAS unsigned*)(lds + (bufoff) + ldsw + _i * 8192), 16, 0, 0); } while (0)
#define PG8_LDA(dst, b, h) do { _Pragma("unroll") for (int m = 0; m < 4; ++m) _Pragma("unroll") for (int k = 0; k < 2; ++k) dst[m][k] = *(const LAS bf16x8*)(lds + PG8_SA(b, h) + aoff + m * 2048 + k * 1024); } while (0)
#define PG8_LDB(dst, b, h) do { _Pragma("unroll") for (int n = 0; n < 2; ++n) _Pragma("unroll") for (int k = 0; k < 2; ++k) dst[n][k] = *(const LAS bf16x8*)(lds + PG8_SB(b, h) + boff + n * 2048 + k * 1024); } while (0)
#define PG8_MMA(ai, bj, At, Bt) do { __builtin_amdgcn_s_setprio(1); _Pragma("unroll") for (int m = 0; m < 4; ++m) _Pragma("unroll") for (int n = 0; n < 2; ++n) _Pragma("unroll") for (int k = 0; k < 2; ++k) \
        acc[ai][bj][m][n] = __builtin_amdgcn_mfma_f32_16x16x32_bf16(Bt[n][k], At[m][k], acc[ai][bj][m][n], 0, 0, 0); __builtin_amdgcn_s_setprio(0); } while (0)
#define PG8_WAIT_V(n) asm volatile("s_waitcnt vmcnt(" #n ")" ::: "memory")
#define PG8_WAIT_L(n) asm volatile("s_waitcnt lgkmcnt(" #n ")" ::: "memory")
#define PG8_BAR __builtin_amdgcn_s_barrier()
#define PG8_SCHED __builtin_amdgcn_sched_barrier(0)
    Unit cur, nxt; int ui = 0;
    if (!S.next(0, cur)) return;
    f32x4 acc[2][2][4][2];
#pragma unroll
    for (int a = 0; a < 2; ++a)
#pragma unroll
        for (int b = 0; b < 2; ++b)
#pragma unroll
            for (int m = 0; m < 4; ++m)
#pragma unroll
                for (int n = 0; n < 2; ++n) acc[a][b][m][n] = (f32x4){0.f, 0.f, 0.f, 0.f};
    bf16x8 At[4][2], B0[2][2], B1[2][2];
    const gchar* cA = (const gchar*)g.A + (size_t)cur.pm * tstepA; const gchar* cB = (const gchar*)g.Bt + (size_t)cur.pn * tstepB;
    PG8_STAGE(PG8_SB(0, 0), cB, voffB); PG8_STAGE(PG8_SB(0, 1), cB + hstepB, voffB); PG8_STAGE(PG8_SA(0, 0), cA, voffA); PG8_STAGE(PG8_SA(0, 1), cA + hstepA, voffA);
    if (wr == 1) PG8_BAR;
    PG8_WAIT_V(2); PG8_BAR;
    PG8_STAGE(PG8_SB(1, 0), cB + kstep, voffB); PG8_STAGE(PG8_SA(1, 0), cA + kstep, voffA); PG8_STAGE(PG8_SB(1, 1), cB + hstepB + kstep, voffB);
    PG8_WAIT_V(6); PG8_BAR;
    for (;;) {
        const bool has_next = S.next(ui + 1, nxt);
        const gchar* nA = has_next ? (const gchar*)g.A + (size_t)nxt.pm * tstepA : cA; const gchar* nB = has_next ? (const gchar*)g.Bt + (size_t)nxt.pn * tstepB : cB;
        for (int t = 0; t < nt; t += 2) {
            const bool last = (t == nt - 2);
            const gchar* a1 = cA + (size_t)(t + 1) * kstep;
            const gchar* a2 = last ? nA : cA + (size_t)(t + 2) * kstep; const gchar* b2 = last ? nB : cB + (size_t)(t + 2) * kstep;
            const gchar* a3 = a2 + kstep; const gchar* b3 = b2 + kstep;
            PG8_LDB(B0, 0, 0); PG8_LDB(B1, 0, 1); PG8_SCHED; PG8_LDA(At, 0, 0); PG8_STAGE(PG8_SA(1, 1), a1 + hstepA, voffA);
            PG8_WAIT_V(8); PG8_WAIT_L(0); PG8_BAR; PG8_MMA(0, 0, At, B0); PG8_MMA(0, 1, At, B1); PG8_BAR; PG8_SCHED;
            PG8_LDA(At, 0, 1); PG8_STAGE(PG8_SB(0, 0), b2, voffB); PG8_STAGE(PG8_SB(0, 1), b2 + hstepB, voffB); PG8_STAGE(PG8_SA(0, 0), a2, voffA);
            PG8_WAIT_V(8); PG8_WAIT_L(0); PG8_BAR; PG8_MMA(1, 0, At, B0); PG8_MMA(1, 1, At, B1); PG8_BAR; PG8_SCHED;
            PG8_LDB(B0, 1, 0); PG8_LDB(B1, 1, 1); PG8_SCHED; PG8_LDA(At, 1, 0); PG8_STAGE(PG8_SA(0, 1), a2 + hstepA, voffA);
            PG8_WAIT_V(8); PG8_WAIT_L(0); PG8_BAR; PG8_MMA(0, 0, At, B0); PG8_MMA(0, 1, At, B1); PG8_BAR; PG8_SCHED;
            PG8_LDA(At, 1, 1); PG8_STAGE(PG8_SB(1, 0), b3, voffB); PG8_STAGE(PG8_SB(1, 1), b3 + hstepB, voffB); PG8_STAGE(PG8_SA(1, 0), a3, voffA);
            PG8_WAIT_V(8); PG8_WAIT_L(0); PG8_BAR; PG8_MMA(1, 0, At, B0); PG8_MMA(1, 1, At, B1); PG8_BAR; PG8_SCHED;
        }
        if (wr == 0) PG8_BAR;
        E(acc, cur, wr, wc, fr, fq);
        if (!has_next) break;
#pragma unroll
        for (int a = 0; a < 2; ++a)
#pragma unroll
            for (int b = 0; b < 2; ++b)
#pragma unroll
                for (int m = 0; m < 4; ++m)
#pragma unroll
                    for (int n = 0; n < 2; ++n) acc[a][b][m][n] = (f32x4){0.f, 0.f, 0.f, 0.f};
        cur = nxt; cA = nA; cB = nB; ++ui;
        if (wr == 1) PG8_BAR;
    }
    PG8_WAIT_V(0);
    PG8_BAR;
#undef PG8_SA
#undef PG8_SB
#undef PG8_STAGE
#undef PG8_LDA
#undef PG8_LDB
#undef PG8_MMA
#undef PG8_WAIT_V
#undef PG8_WAIT_L
#undef PG8_BAR
#undef PG8_SCHED
}
}

namespace att {
#define SBAR() __builtin_amdgcn_sched_barrier(0)
constexpr int OFF_K = 0, OFF_V = 24576, OFF_WS = 24576 + 16384, ATT_LDS = OFF_WS + 8 * 64 * 4;
__device__ __forceinline__ int crow(int r, int hi) { return (r & 3) + 8 * (r >> 2) + 4 * hi; }
__device__ __forceinline__ int v_st(int k, int c) { const int kk = (k & ~0xC) | ((k & 4) << 1) | ((k & 8) >> 1); return ((kk >> 3) * 4 + (c >> 5)) * 512 + ((kk & 7) * 32 + (c & 31)) * 2; }
__device__ __forceinline__ int v_rd_base(int lane) { return ((lane & 3) << 3) | (((lane >> 2) & 3) << 6) | (((lane >> 4) & 1) << 5) | (((lane >> 5) & 1) << 8); }
constexpr int v_rd_off(int d0, int ks, int half) { return d0 * 512 + ks * 4096 + half * 2048; }
template <int OFF> __device__ __forceinline__ s16x4 tr_read(int vb) {
    s16x4 r; asm volatile("ds_read_b64_tr_b16 %0, %1 offset:%2" : "=&v"(r) : "v"(vb), "i"(OFF) : "memory"); return r;
}
template <int D0> __device__ __forceinline__ void pv_one(f32x16& od, int vb, bf16x8 pa0, bf16x8 pa1, bf16x8 pa2, bf16x8 pa3) {
    const s16x4 l0 = tr_read<v_rd_off(D0, 0, 0)>(vb), h0 = tr_read<v_rd_off(D0, 0, 1)>(vb), l1 = tr_read<v_rd_off(D0, 1, 0)>(vb), h1 = tr_read<v_rd_off(D0, 1, 1)>(vb);
    const s16x4 l2 = tr_read<v_rd_off(D0, 2, 0)>(vb), h2 = tr_read<v_rd_off(D0, 2, 1)>(vb), l3 = tr_read<v_rd_off(D0, 3, 0)>(vb), h3 = tr_read<v_rd_off(D0, 3, 1)>(vb);
    asm volatile("s_waitcnt lgkmcnt(0)" ::: "memory"); SBAR();
#define PK(L, H) (bf16x8){L[0], L[1], L[2], L[3], H[0], H[1], H[2], H[3]}
    od = __builtin_amdgcn_mfma_f32_32x32x16_bf16(pa0, PK(l0, h0), od, 0, 0, 0);
    od = __builtin_amdgcn_mfma_f32_32x32x16_bf16(pa1, PK(l1, h1), od, 0, 0, 0);
    od = __builtin_amdgcn_mfma_f32_32x32x16_bf16(pa2, PK(l2, h2), od, 0, 0, 0);
    od = __builtin_amdgcn_mfma_f32_32x32x16_bf16(pa3, PK(l3, h3), od, 0, 0, 0);
#undef PK
}
__device__ __forceinline__ int key_row(int b, int p) { p = p < LSEQ ? p : LSEQ - 1; return p < NMETA ? NREAL + p : b * SEQ + p - NMETA; }

template <int DQK>
__device__ __forceinline__ void attn_map(const gbf16_t* __restrict__ Qp, int ldq, const gbf16_t* __restrict__ Kp, int ldk, const gbf16_t* __restrict__ Vp, int ldv,
                                         int b, int qpos0, int NT, f32x16 (&o)[4], float& l_out, LAS char* lds) {
    constexpr int RB = DQK * 2, CPR = DQK / 8, NKC = (64 * CPR) / 512, ND = DQK / 16;
    int tid_ = threadIdx.x; asm volatile("" : "+v"(tid_));
    const int tid = tid_, wid = __builtin_amdgcn_readfirstlane(tid >> 6), lane = tid & 63, r32 = lane & 31, hi = lane >> 5;
    LAS char* K_lds = lds + OFF_K; LAS char* V_lds = lds + OFF_V; LAS float* al_l = (LAS float*)(lds + OFF_WS) + wid * 64;
    bf16x8 qr[ND];
    { const gbf16_t* Qw = Qp + (size_t)(wid * 32 + r32) * ldq + hi * 8;
#pragma unroll
      for (int d0 = 0; d0 < ND; ++d0) qr[d0] = *(const gbf16x8*)(Qw + d0 * 16); }
    float m_reg = -1e30f, l_reg = 0.f;
#pragma unroll
    for (int d = 0; d < 4; ++d) o[d] = f32x16{};
    const int vb = (int)(unsigned)(uintptr_t)V_lds + v_rd_base(lane);
    const int qpos = qpos0 + wid * 32 + r32, wq_min = qpos0 + wid * 32, wq_max = wq_min + 31;
    int kb4[4];
#pragma unroll
    for (int i = 0; i < 4; ++i) kb4[i] = r32 * RB + (((i * 2 + hi) ^ (r32 & 7)) << 4);
    bf16x8 kst[NKC], vst[2];
#define ATT_SLOAD(j) do { \
        _Pragma("unroll") for (int i_ = 0; i_ < NKC; ++i_) { const int c_ = tid + i_ * 512, row_ = c_ / CPR, cc_ = c_ % CPR; \
            kst[i_] = *(const gbf16x8*)(Kp + (size_t)key_row(b, 64 * (j) + row_) * ldk + cc_ * 8); } \
        _Pragma("unroll") for (int i_ = 0; i_ < 2; ++i_) { const int row_ = (tid >> 4) + 32 * i_, col_ = (tid & 15) * 8; \
            vst[i_] = *(const gbf16x8*)(Vp + (size_t)key_row(b, 64 * (j) + row_) * ldv + col_); } } while (0)
#define ATT_SWRITE() do { \
        _Pragma("unroll") for (int i_ = 0; i_ < NKC; ++i_) { const int c_ = tid + i_ * 512, row_ = c_ / CPR, cc_ = c_ % CPR; \
            *(LAS bf16x8*)(K_lds + row_ * RB + ((cc_ * 16) ^ ((row_ & 7) << 4))) = kst[i_]; } \
        _Pragma("unroll") for (int i_ = 0; i_ < 2; ++i_) { const int row_ = (tid >> 4) + 32 * i_, col_ = (tid & 15) * 8; \
            *(LAS bf16x8*)(V_lds + v_st(row_, col_)) = vst[i_]; } } while (0)
    ATT_SLOAD(0);
    for (int j = 0; j < NT; ++j) {
        __syncthreads();
        ATT_SWRITE();
        __syncthreads();
        if (j + 1 < NT) ATT_SLOAD(j + 1);
        if (64 * j <= wq_max) {
            f32x16 p0 = f32x16{}, p1 = f32x16{};
#pragma unroll
            for (int d0 = 0; d0 < ND; ++d0) { const LAS char* kp_ = K_lds + kb4[d0 & 3] + (d0 >> 2) * 128;
                const bf16x8 b0 = *(const LAS bf16x8*)(kp_);
                const bf16x8 b1 = *(const LAS bf16x8*)(kp_ + 32 * RB);
                p0 = __builtin_amdgcn_mfma_f32_32x32x16_bf16(b0, qr[d0], p0, 0, 0, 0);
                p1 = __builtin_amdgcn_mfma_f32_32x32x16_bf16(b1, qr[d0], p1, 0, 0, 0);
                if ((d0 & 3) == 3) SBAR(); }
            if (64 * j + 63 > wq_min) {
#pragma unroll
                for (int r = 0; r < 16; ++r) { const int kp = 64 * j + crow(r, hi); if (kp > qpos) p0[r] = -1e30f; if (kp + 32 > qpos) p1[r] = -1e30f; }
            }
            float pmax = p0[0];
#pragma unroll
            for (int r = 1; r < 16; ++r) pmax = fmaxf(pmax, p0[r]);
#pragma unroll
            for (int r = 0; r < 16; ++r) pmax = fmaxf(pmax, p1[r]);
            { auto rr = __builtin_amdgcn_permlane32_swap(__float_as_uint(pmax), __float_as_uint(pmax), false, false);
              pmax = fmaxf(__uint_as_float(rr[0]), __uint_as_float(rr[1])); }
            const float mn = fmaxf(m_reg, pmax), alpha = __builtin_amdgcn_exp2f(m_reg - mn); m_reg = mn;
#pragma unroll
            for (int r = 0; r < 16; ++r) { p0[r] = __builtin_amdgcn_exp2f(p0[r] - mn); p1[r] = __builtin_amdgcn_exp2f(p1[r] - mn); }
            float ps = 0.f;
#pragma unroll
            for (int r = 0; r < 16; ++r) ps += p0[r] + p1[r];
            { auto rr = __builtin_amdgcn_permlane32_swap(__float_as_uint(ps), __float_as_uint(ps), false, false);
              ps = __uint_as_float(rr[0]) + __uint_as_float(rr[1]); }
            l_reg = l_reg * alpha + ps;
            bf16x8 pa0, pa1, pa2, pa3;
#define PK4(P, BASE, OUT) do { unsigned a0 = cvt_pk_bf16(P[BASE + 0], P[BASE + 1]), a1 = cvt_pk_bf16(P[BASE + 2], P[BASE + 3]);   \
    unsigned b0_ = cvt_pk_bf16(P[BASE + 4], P[BASE + 5]), b1_ = cvt_pk_bf16(P[BASE + 6], P[BASE + 7]);                              \
    auto r0 = __builtin_amdgcn_permlane32_swap(a0, b0_, false, false); auto r1 = __builtin_amdgcn_permlane32_swap(a1, b1_, false, false); \
    u32x4 w = {r0[0], r1[0], r0[1], r1[1]}; OUT = __builtin_bit_cast(bf16x8, w); } while (0)
            PK4(p0, 0, pa0); PK4(p0, 8, pa1); PK4(p1, 0, pa2); PK4(p1, 8, pa3);
#undef PK4
            if (__any(alpha < 1.f)) {
                if (hi == 0) al_l[r32] = alpha;
                LDS_WAIT();
#pragma unroll
                for (int r = 0; r < 16; ++r) { const float a = al_l[crow(r, hi)];
#pragma unroll
                    for (int d = 0; d < 4; ++d) o[d][r] *= a; }
            }
            pv_one<0>(o[0], vb, pa0, pa1, pa2, pa3); pv_one<1>(o[1], vb, pa0, pa1, pa2, pa3); pv_one<2>(o[2], vb, pa0, pa1, pa2, pa3); pv_one<3>(o[3], vb, pa0, pa1, pa2, pa3);
        }
    }
#undef ATT_SLOAD
#undef ATT_SWRITE
    l_out = l_reg;
}
__device__ __forceinline__ void row_recip(float l, float (&rli)[16], LAS char* lds, int wid, int r32, int hi) {
    LAS float* li_l = (LAS float*)(lds + OFF_WS) + wid * 64 + 32;
    if (hi == 0) li_l[r32] = l;
    LDS_WAIT();
#pragma unroll
    for (int r = 0; r < 16; ++r) rli[r] = __builtin_amdgcn_rcpf(li_l[crow(r, hi)]);
    LDS_WAIT();
}
#undef SBAR
}


#define XB_TMO      128
#define XB_XCNT(j)  (256  + 64 * (j))
#define XB_XSUB(j)  (1280 + 64 * (j))
#define XB_XGEN(j)  (2304 + 64 * (j))
#define XB_TOP      3328
#define XB_TOPGEN   3392
#define XCD_BAR_WORDS 3456
#define XB_SPIN_CAP (1u << 18)
__device__ __forceinline__ unsigned xb_ld(unsigned* p)              { return __hip_atomic_load(p, __ATOMIC_RELAXED, __HIP_MEMORY_SCOPE_AGENT); }
__device__ __forceinline__ unsigned xb_add(unsigned* p, unsigned v) { return __hip_atomic_fetch_add(p, v, __ATOMIC_RELAXED, __HIP_MEMORY_SCOPE_AGENT); }
__device__ __forceinline__ unsigned xb_xcc_id() { return (unsigned)__builtin_amdgcn_s_getreg((3 << 11) | 20) & 0xFu; }
#define XB_SPIN(cond, bar) do { unsigned _sp = 0; while (cond) { __builtin_amdgcn_s_sleep(1); \
    if ((++_sp & 255u) == 0u) { if (xb_ld(&(bar)[XB_TMO])) break; if (_sp > XB_SPIN_CAP) { atomicAdd(&(bar)[XB_TMO], 1u); break; } } } } while (0)
struct XcdBarrier { unsigned* bar; unsigned x; volatile LAS unsigned* st; };
__device__ __forceinline__ XcdBarrier xcd_barrier_post(unsigned* bar, volatile LAS unsigned* st) {
    XcdBarrier b; b.bar = bar; b.x = xb_xcc_id(); b.st = st;
    if (threadIdx.x == 0) (void)xb_add(&bar[XB_XCNT(b.x)], 1u);
    return b;
}
__device__ __forceinline__ void xcd_barrier_complete(unsigned* bar, unsigned x, unsigned& nloc, unsigned& nx) {
    const unsigned G = gridDim.x * gridDim.y * gridDim.z;
    unsigned sum, cnt, mine, sp = 0u;
    for (;;) {
        sum = 0u; cnt = 0u; mine = 0u;
#pragma unroll
        for (unsigned j = 0; j < 16; ++j) { const unsigned c = xb_ld(&bar[XB_XCNT(j)]); sum += c; cnt += (c > 0u) ? 1u : 0u; mine = (j == x) ? c : mine; }
        if (sum == G) break;
        __builtin_amdgcn_s_sleep(1);
        if ((++sp & 255u) == 0u) { if (xb_ld(&bar[XB_TMO])) break; if (sp > XB_SPIN_CAP) { atomicAdd(&bar[XB_TMO], 1u); break; } }
    }
    nloc = mine > 0u ? mine : 1u; nx = cnt > 0u ? cnt : 1u;
}
__device__ __forceinline__ void xcd_barrier(const XcdBarrier& b) {
    asm volatile("s_waitcnt vmcnt(0)" ::: "memory");
    __syncthreads();
    if (threadIdx.x == 0) {
        unsigned* bar = b.bar;
        __builtin_amdgcn_s_waitcnt(0);
        unsigned nloc = b.st[0], nx = b.st[1];
        if (nloc == 0u) { xcd_barrier_complete(bar, b.x, nloc, nx); b.st[0] = nloc; b.st[1] = nx; }
        const unsigned old = xb_add(&bar[XB_XSUB(b.x)], 1u);
        const unsigned gen = old / nloc;
        if (old + 1u == (gen + 1u) * nloc) {
            __builtin_amdgcn_fence(__ATOMIC_RELEASE, "agent");
            asm volatile("s_waitcnt vmcnt(0)" ::: "memory");
            const unsigned og = xb_add(&bar[XB_TOP], 1u);
            const unsigned tg = og / nx;
            if (og + 1u == (tg + 1u) * nx) xb_add(&bar[XB_TOPGEN], 1u);
            else XB_SPIN(xb_ld(&bar[XB_TOPGEN]) == tg, bar);
            __builtin_amdgcn_fence(__ATOMIC_ACQUIRE, "agent");
            xb_add(&bar[XB_XGEN(b.x)], 1u);
            asm volatile("s_waitcnt vmcnt(0)" ::: "memory");
        } else {
            XB_SPIN(xb_ld(&bar[XB_XGEN(b.x)]) == gen, bar);
            __builtin_amdgcn_fence(__ATOMIC_ACQUIRE, "agent");
            asm volatile("s_waitcnt vmcnt(0)" ::: "memory");
        }
    }
    __syncthreads();
}

struct Params { const float* in[21]; float* out; unsigned char* ws; int s_lo, s_hi; };
struct DParams { const gfloat* in[21]; gfloat* out; guchar* ws; int s_lo, s_hi; };
enum { I_X = 0, I_META, I_ATTN_NORM, I_W_IN, I_QA_NORM, I_W_Q_UP, I_KVA_NORM, I_W_KV_UP, I_Q_NORM, I_K_NORM, I_DQ_NORM, I_DK_NORM, I_LQ1, I_LK1, I_LQ2, I_LK2, I_SUBLN, I_W_O, I_FFN_NORM,
       I_W_GU, I_W_D };
constexpr int LDS_BYTES = 147456;
constexpr int NTHREADS = 512, NWAVES = 8;

struct Frame {
    LAS unsigned char* lds; DParams p; int tid, lane, wave, vcu, G, gw, ngw;
};

__device__ __forceinline__ void transpose_item(const gfloat* W, int ldw, int Ksrc, const gfloat* gain, gbf16_t* WT, int Kd, int k0, int sc0, int dr0, LAS float* scr, int lane) {
    const bool zero = (sc0 < 0) || (k0 >= Ksrc);
    const int c = lane & 7;
    if (zero) {
#pragma unroll
        for (int j = 0; j < 4; ++j) { const int n = (lane >> 3) + 8 * j; *(gu32x4*)(WT + (size_t)(dr0 + n) * Kd + k0 + 8 * c) = (u32x4){0u, 0u, 0u, 0u}; }
        return;
    }
#pragma unroll 8
    for (int i = 0; i < 32; ++i) { const int kk = 2 * i + (lane >> 5); const float gsc = gain ? gain[k0 + kk] : 1.0f; scr[kk * 33 + (lane & 31)] = W[(size_t)(k0 + kk) * ldw + sc0 + (lane & 31)] * gsc; }
    LDS_WAIT(); asm volatile("" ::: "memory");
#pragma unroll
    for (int j = 0; j < 4; ++j) { const int n = (lane >> 3) + 8 * j; const LAS float* s = scr + (8 * c) * 33 + n;
        u32x4 o; o.x = pk2(s[0 * 33], s[1 * 33]); o.y = pk2(s[2 * 33], s[3 * 33]); o.z = pk2(s[4 * 33], s[5 * 33]); o.w = pk2(s[6 * 33], s[7 * 33]);
        *(gu32x4*)(WT + (size_t)(dr0 + n) * Kd + k0 + 8 * c) = o; }
    LDS_WAIT(); asm volatile("" ::: "memory");
}
__device__ __forceinline__ void stage_prep(Frame& F) {
    LAS float* scr = (LAS float*)(F.lds + F.wave * 16384);
    const DParams& P = F.p;
    constexpr int IT_IN = 16 * 64, IT_Q = 4 * 32, IT_KV = 4 * 32, IT_O = 16 * 32, IT_GU = 16 * 176, IT_D = 44 * 32, IT_L = IT_IN + IT_Q + IT_KV + IT_O + IT_GU + IT_D;
    for (int it = F.gw; it < 2 * IT_L; it += F.ngw) {
        const int l = it / IT_L; int r = it % IT_L;
        gbf16_t* wb = (gbf16_t*)(P.ws + WS_W + (size_t)l * W_LAYER);
        if (r < IT_IN) { const int kb = r / 64, g = r % 64;
            transpose_item(P.in[I_W_IN] + (size_t)l * DM * INW, INW, DM, P.in[I_ATTN_NORM] + l * DM, (gbf16_t*)((gchar*)wb + W_IN), DM, kb * 64, (32 * g < INW) ? 32 * g : -1, 32 * g, scr, F.lane); continue; }
        r -= IT_IN;
        if (r < IT_Q) { const int kb = r / 32, g = r % 32, h = g >> 3, d0 = (g & 7) * 32;
            transpose_item(P.in[I_W_Q_UP] + (size_t)l * 256 * 768, 768, 256, P.in[I_QA_NORM] + l * 256, (gbf16_t*)((gchar*)wb + W_Q), 256, kb * 64, d0 < 192 ? h * 192 + d0 : -1, 32 * g, scr, F.lane); continue; }
        r -= IT_Q;
        if (r < IT_KV) { const int kb = r / 32, g = r % 32;
            transpose_item(P.in[I_W_KV_UP] + (size_t)l * 128 * 1024, 1024, 128, P.in[I_KVA_NORM] + l * 128, (gbf16_t*)((gchar*)wb + W_KV), 256, kb * 64, 32 * g, 32 * g, scr, F.lane); continue; }
        r -= IT_KV;
        if (r < IT_O) { const int kb = r / 32, g = r % 32;
            transpose_item(P.in[I_W_O] + (size_t)l * DM * DM, DM, DM, nullptr, (gbf16_t*)((gchar*)wb + W_O), DM, kb * 64, 32 * g, 32 * g, scr, F.lane); continue; }
        r -= IT_O;
        if (r < IT_GU) { const int kb = r / 176, g = r % 176, pn = g >> 3, half = (g & 7) >> 2, i0 = (g & 3) * 32;
            transpose_item(P.in[I_W_GU] + (size_t)l * DM * 2 * DFF, 2 * DFF, DM, P.in[I_FFN_NORM] + l * DM, (gbf16_t*)((gchar*)wb + W_GU), DM, kb * 64, half * DFF + pn * 128 + i0, 32 * g, scr, F.lane); continue; }
        r -= IT_GU;
        { const int kb = r / 32, g = r % 32;
          transpose_item(P.in[I_W_D] + (size_t)l * DFF * DM, DM, DFF, nullptr, (gbf16_t*)((gchar*)wb + W_D), DFF, kb * 64, 32 * g, 32 * g, scr, F.lane); }
    }
    { gbf16_t* XN = (gbf16_t*)(P.ws + WS_AO); gfloat* SSQ = (gfloat*)(P.ws + WS_SSQH); gfloat* MSSQ = (gfloat*)(P.ws + WS_MSSQ);
      for (int row = F.gw; row < NROWS; row += F.ngw) {
        const gfloat* hr = row < NREAL ? P.in[I_X] + (size_t)row * DM : P.in[I_META] + (size_t)(row - NREAL) * DM;
        f32x4 v[4]; float s = 0.f;
#pragma unroll
        for (int j = 0; j < 4; ++j) { v[j] = *((const gf32x4*)hr + F.lane + 64 * j); s += (v[j].x * v[j].x + v[j].y * v[j].y) + (v[j].z * v[j].z + v[j].w * v[j].w); }
        s = wave_sum(s);
        if (row < NREAL) { if (F.lane < 16) SSQ[(size_t)row * 16 + F.lane] = F.lane == 0 ? s : 0.f; }
        else MSSQ[(row - NREAL) * 64 + F.lane] = F.lane == 0 ? s : 0.f;
        gu32x2* o8 = (gu32x2*)(XN + (size_t)row * DM) + F.lane;
#pragma unroll
        for (int j = 0; j < 4; ++j) o8[64 * j] = (u32x2){pk2(v[j].x, v[j].y), pk2(v[j].z, v[j].w)};
      } }
    gfloat* COS = (gfloat*)(P.ws + WS_COS); gfloat* SIN = (gfloat*)(P.ws + WS_SIN);
    for (int i = blockIdx.x * NTHREADS + F.tid; i < LSEQ * 32; i += F.G * NTHREADS) {
        const int pos = i >> 5, m = i & 31;
        const float inv = 1.0f / powf(10000.0f, (float)(2 * m) / 64.0f), ang = (float)pos * inv;
        COS[i] = cosf(ang); SIN[i] = sinf(ang);
    }
    if (blockIdx.x == 0 && F.tid < DEPTH) {
        const int l = F.tid; float a = 0.f, b = 0.f;
        for (int i = 0; i < 64; ++i) { a += P.in[I_LQ1][l * 64 + i] * P.in[I_LK1][l * 64 + i]; b += P.in[I_LQ2][l * 64 + i] * P.in[I_LK2][l * 64 + i]; }
        const float lam_init = 0.8f - 0.6f * expf(-0.3f * (float)l);
        ((gfloat*)(P.ws + WS_LAM))[l] = expf(a) - expf(b) + lam_init;
    }
}

__device__ __forceinline__ void unpack8(const u32x4 v, float (&x)[8]) {
    x[0] = bf2f(v.x & 0xffffu); x[1] = bf2f(v.x >> 16); x[2] = bf2f(v.y & 0xffffu); x[3] = bf2f(v.y >> 16);
    x[4] = bf2f(v.z & 0xffffu); x[5] = bf2f(v.z >> 16); x[6] = bf2f(v.w & 0xffffu); x[7] = bf2f(v.w >> 16);
}
__device__ __forceinline__ u32x4 pack8(const float (&x)[8]) { return (u32x4){pk2(x[0], x[1]), pk2(x[2], x[3]), pk2(x[4], x[5]), pk2(x[6], x[7])}; }
__device__ __forceinline__ float ssq8(const float (&x)[8]) { return ((x[0] * x[0] + x[1] * x[1]) + (x[2] * x[2] + x[3] * x[3])) + ((x[4] * x[4] + x[5] * x[5]) + (x[6] * x[6] + x[7] * x[7])); }
__device__ __forceinline__ void norm_rope8(float (&x)[8], float r, const float (&g)[8], const float (&cs)[8], const float (&sn)[8], bool upper, float post) {
#pragma unroll
    for (int e = 0; e < 8; ++e) { const float y = x[e] * r * g[e], pt = __shfl_xor(y, 4); x[e] = (upper ? y * cs[e] + pt * sn[e] : y * cs[e] - pt * sn[e]) * post; }
}
__device__ __forceinline__ void load8f(float (&d)[8], const gfloat* p) { const f32x4 a = *(const gf32x4*)p, b = *(const gf32x4*)(p + 4); d[0] = a[0]; d[1] = a[1]; d[2] = a[2]; d[3] = a[3]; d[4] = b[0]; d[5] = b[1]; d[6] = b[2]; d[7] = b[3]; }

__device__ __forceinline__ void stage_postproj(Frame& F, int l) {
    const DParams& P = F.p;
    const gbf16_t* PROJ = (const gbf16_t*)(P.ws + WS_PROJ); gbf16_t* QD = (gbf16_t*)(P.ws + WS_QD); gbf16_t* KD = (gbf16_t*)(P.ws + WS_KD);
    gfloat* RQ = (gfloat*)(P.ws + WS_RQ); gfloat* RKV = (gfloat*)(P.ws + WS_RKV);
    const gfloat* COS = (const gfloat*)(P.ws + WS_COS); const gfloat* SIN = (const gfloat*)(P.ws + WS_SIN);
    const int lane = F.lane, k = lane & 7; const bool upper = (k & 4) != 0, hiL = lane >= 56;
    float gq[8], gk[8]; load8f(gq, P.in[I_DQ_NORM] + l * 64 + 8 * k); load8f(gk, P.in[I_DK_NORM] + l * 64 + 8 * k);
    float gb[8];
#pragma unroll
    for (int e = 0; e < 8; ++e) gb[e] = hiL ? gk[e] : gq[e];
    const float postB = hiL ? 1.0f : CD;
    u32x4 vA, vB, vC; const u32x4 z4 = {0u, 0u, 0u, 0u};
    int row = F.gw;
    if (row < NROWS) { const gbf16_t* pr = PROJ + (size_t)row * INWP + 8 * lane; vA = *(const gu32x4*)pr; vB = *(const gu32x4*)(pr + 512); vC = lane < 56 ? *(const gu32x4*)(pr + 1024) : z4; }
    for (; row < NROWS; row += F.ngw) {
        const int nrow = row + F.ngw; u32x4 nA = z4, nB = z4, nC = z4;
        if (nrow < NROWS) { const gbf16_t* pr = PROJ + (size_t)nrow * INWP + 8 * lane; nA = *(const gu32x4*)pr; nB = *(const gu32x4*)(pr + 512); nC = lane < 56 ? *(const gu32x4*)(pr + 1024) : z4; }
        const int pos = row < NREAL ? NMETA + (row & (SEQ - 1)) : row - NREAL;
        float cs[8], sn[8]; load8f(cs, COS + pos * 32 + 8 * (k & 3)); load8f(sn, SIN + pos * 32 + 8 * (k & 3));
        float xa[8], xb[8], xc[8]; unpack8(vA, xa); unpack8(vB, xb); unpack8(vC, xc);
        float sA = ssq8(xa), sB = ssq8(xb), sC = ssq8(xc);
        sA += __shfl_xor(sA, 1); sA += __shfl_xor(sA, 2); sA += __shfl_xor(sA, 4);
        sB += __shfl_xor(sB, 1); sB += __shfl_xor(sB, 2); sB += __shfl_xor(sB, 4);
        sC += __shfl_xor(sC, 1); sC += __shfl_xor(sC, 2); sC += __shfl_xor(sC, 4);
        float s16 = sA + __shfl_xor(sA, 8);
        float s32 = s16 + __shfl_xor(s16, 16);
        if (lane == 0) RQ[row] = 1.0f / sqrtf(s32 * (1.0f / 256.0f) + EPS);
        if (lane == 32) RKV[row] = 1.0f / sqrtf(s16 * (1.0f / 128.0f) + EPS);
        norm_rope8(xa, 1.0f / sqrtf(sA * (1.0f / 64.0f) + EPS), gq, cs, sn, upper, CD);
        norm_rope8(xb, 1.0f / sqrtf(sB * (1.0f / 64.0f) + EPS), gb, cs, sn, upper, postB);
        norm_rope8(xc, 1.0f / sqrtf(sC * (1.0f / 64.0f) + EPS), gk, cs, sn, upper, 1.0f);
        if (hiL) { *(gu32x4*)(QD + (size_t)row * 512 + 8 * k) = pack8(xa);
                   *(gu32x4*)(KD + (size_t)row * 512 + 8 * k) = pack8(xb); }
        else { *(gu32x4*)(QD + (size_t)row * 512 + 64 + 8 * lane) = pack8(xb);
               *(gu32x4*)(KD + (size_t)row * 512 + 64 + 8 * lane) = pack8(xc); }
        vA = nA; vB = nB; vC = nC;
    }
}

__device__ __forceinline__ void stage_mla_qk(Frame& F, int l) {
    const DParams& P = F.p;
    const gbf16_t* PROJ = (const gbf16_t*)(P.ws + WS_PROJ); const gbf16_t* QRAW = (const gbf16_t*)(P.ws + WS_QRAW); const gbf16_t* KVRAW = (const gbf16_t*)(P.ws + WS_KVRAW);
    gbf16_t* QA = (gbf16_t*)(P.ws + WS_QA); gbf16_t* KA = (gbf16_t*)(P.ws + WS_KA);
    const gfloat* COS = (const gfloat*)(P.ws + WS_COS); const gfloat* SIN = (const gfloat*)(P.ws + WS_SIN);
    const int lane = F.lane, half = lane >> 5, c = lane & 31; const bool act = c < 24, rp = c >= 16, upper = (c & 4) != 0;
    const int cg_ = act ? c : 0;
    float gq[8], gk[8]; load8f(gq, P.in[I_Q_NORM] + l * 192 + 8 * cg_); load8f(gk, P.in[I_K_NORM] + l * 192 + 8 * cg_);
    const u32x4 z4 = {0u, 0u, 0u, 0u};
    u32x4 v[4];
#define MLA_LOAD(dst, r_) do { \
        _Pragma("unroll") for (int p_ = 0; p_ < 2; ++p_) { const int h_ = 2 * p_ + half; \
            dst[p_] = act ? *(const gu32x4*)(QRAW + (size_t)(r_) * 1024 + h_ * 256 + 8 * c) : z4; \
            const gbf16_t* ks_ = c < 16 ? KVRAW + (size_t)(r_) * 1024 + h_ * 256 + 8 * c : PROJ + (size_t)(r_) * INWP + PC_KR + 8 * (c - 16); \
            dst[2 + p_] = act ? *(const gu32x4*)ks_ : z4; } } while (0)
    int row = F.gw;
    if (row < NROWS) MLA_LOAD(v, row);
    for (; row < NROWS; row += F.ngw) {
        const int nrow = row + F.ngw; u32x4 nv[4] = {z4, z4, z4, z4};
        if (nrow < NROWS) MLA_LOAD(nv, nrow);
        const int pos = row < NREAL ? NMETA + (row & (SEQ - 1)) : row - NREAL;
        float cs[8], sn[8]; load8f(cs, COS + pos * 32 + 8 * (c & 3)); load8f(sn, SIN + pos * 32 + 8 * (c & 3));
#pragma unroll
        for (int p = 0; p < 4; ++p) {
            const bool isq = p < 2; const int h = 2 * (p & 1) + half;
            float x[8]; unpack8(v[p], x);
            float s = ssq8(x);
            s += __shfl_xor(s, 1); s += __shfl_xor(s, 2); s += __shfl_xor(s, 4); s += __shfl_xor(s, 8); s += __shfl_xor(s, 16);
            const float r = 1.0f / sqrtf(s * (1.0f / 192.0f) + EPS), post = isq ? CA : 1.0f;
#pragma unroll
            for (int e = 0; e < 8; ++e) { const float y = x[e] * r * (isq ? gq[e] : gk[e]), pt = __shfl_xor(y, 4);
                const float yr = upper ? y * cs[e] + pt * sn[e] : y * cs[e] - pt * sn[e]; x[e] = (rp ? yr : y) * post; }
            if (act) *(gu32x4*)((isq ? QA : KA) + (size_t)row * 768 + h * 192 + 8 * c) = pack8(x);
        }
#pragma unroll
        for (int p = 0; p < 4; ++p) v[p] = nv[p];
    }
#undef MLA_LOAD
}

__device__ __forceinline__ void attn_unit_mla(Frame& F, int b, int h, int qrow0, int qpos0, int NT, int nvalid) {
    const DParams& P = F.p;
    const gbf16_t* QA = (const gbf16_t*)(P.ws + WS_QA); const gbf16_t* KA = (const gbf16_t*)(P.ws + WS_KA); const gbf16_t* KVRAW = (const gbf16_t*)(P.ws + WS_KVRAW);
    gbf16_t* AO = (gbf16_t*)(P.ws + WS_AO);
    const int r32 = F.lane & 31, hi = F.lane >> 5;
    f32x16 o[4]; float l;
    att::attn_map<192>(QA + (size_t)qrow0 * 768 + h * 192, 768, KA + h * 192, 768, KVRAW + h * 256 + 128, 1024, b, qpos0, NT, o, l, (LAS char*)F.lds);
    float rli[16]; att::row_recip(l, rli, (LAS char*)F.lds, F.wave, r32, hi);
#pragma unroll
    for (int r = 0; r < 16; ++r) { const int lr = F.wave * 32 + att::crow(r, hi);
        if (lr < nvalid) { gbf16_t* op = AO + (size_t)(qrow0 + lr) * DM + h * 128 + r32;
#pragma unroll
            for (int d0 = 0; d0 < 4; ++d0) op[d0 * 32] = (bf16_t)f2bf(o[d0][r] * rli[r]); } }
}
__device__ __forceinline__ void attn_unit_diff(Frame& F, int l_idx, int b, int h, int qrow0, int qpos0, int NT, int nvalid) {
    const DParams& P = F.p;
    const gbf16_t* QD = (const gbf16_t*)(P.ws + WS_QD); const gbf16_t* KD = (const gbf16_t*)(P.ws + WS_KD); const gbf16_t* PROJ = (const gbf16_t*)(P.ws + WS_PROJ);
    gbf16_t* AO = (gbf16_t*)(P.ws + WS_AO);
    gf32x4* tmp = (gf32x4*)((gfloat*)(P.ws + WS_TMP) + ((size_t)blockIdx.x * 512 + F.tid) * 64);
    const int r32 = F.lane & 31, hi = F.lane >> 5;
    const float lam = ((const gfloat*)(P.ws + WS_LAM))[l_idx];
    const float lam_init = 0.8f - 0.6f * expf(-0.3f * (float)l_idx);
    f32x16 o[4]; float lsum; float rli[16];
#pragma unroll 1
    for (int c = 0; c < 2; ++c) {
        att::attn_map<64>(QD + (size_t)qrow0 * 512 + h * 128 + c * 64, 512, KD + h * 128 + c * 64, 512, PROJ + PC_DV + h * 128, INWP, b, qpos0, NT, o, lsum, (LAS char*)F.lds);
        att::row_recip(lsum, rli, (LAS char*)F.lds, F.wave, r32, hi);
        if (c == 0) {
#pragma unroll
            for (int d = 0; d < 4; ++d)
#pragma unroll
                for (int q = 0; q < 4; ++q) tmp[d * 4 + q] = (f32x4){o[d][4 * q] * rli[4 * q], o[d][4 * q + 1] * rli[4 * q + 1], o[d][4 * q + 2] * rli[4 * q + 2], o[d][4 * q + 3] * rli[4 * q + 3]};
        }
    }
    float ss[16];
#pragma unroll
    for (int r = 0; r < 16; ++r) ss[r] = 0.f;
#pragma unroll
    for (int d = 0; d < 4; ++d) {
#pragma unroll
        for (int q = 0; q < 4; ++q) { const f32x4 t = tmp[d * 4 + q];
#pragma unroll
            for (int e = 0; e < 4; ++e) { const int r = 4 * q + e; const float v = t[e] - lam * rli[r] * o[d][r]; o[d][r] = v; ss[r] += v * v; } }
        asm volatile("" ::: "memory"); }
#pragma unroll
    for (int off = 1; off < 32; off <<= 1)
#pragma unroll
        for (int r = 0; r < 16; ++r) ss[r] += __shfl_xor(ss[r], off);
    const gfloat* gs = P.in[I_SUBLN] + l_idx * 128; const float post = 1.0f - lam_init;
    float gcol[4];
#pragma unroll
    for (int d = 0; d < 4; ++d) gcol[d] = gs[d * 32 + r32] * post;
#pragma unroll
    for (int r = 0; r < 16; ++r) { const int lr = F.wave * 32 + att::crow(r, hi); const float rn = 1.0f / sqrtf(ss[r] * (1.0f / 128.0f) + EPS);
        if (lr < nvalid) { gbf16_t* op = AO + (size_t)(qrow0 + lr) * DM + 512 + h * 128 + r32;
#pragma unroll
            for (int d0 = 0; d0 < 4; ++d0) op[d0 * 32] = (bf16_t)f2bf(o[d0][r] * rn * gcol[d0]); } }
}
__device__ __forceinline__ void stage_attention(Frame& F, int l) {
    const int v = F.vcu, bh = v >> 2, s = v & 3, b = bh >> 2, h = bh & 3;
#pragma unroll 1
    for (int u = 0; u < 5; ++u) {
        int type, b_, h_, qrow0, qpos0, NT, nvalid;
        if (u < 4) { const int qb = (u & 1) ? 7 - s : s; type = u >> 1; b_ = b; h_ = h; qrow0 = b * SEQ + qb * 256; qpos0 = NMETA + qb * 256; NT = 4 * qb + 5; nvalid = 256; }
        else { if (v >= 8) break; type = v >> 2; b_ = 0; h_ = v & 3; qrow0 = NREAL; qpos0 = 0; NT = 1; nvalid = NMETA; }
        if (type == 0) attn_unit_mla(F, b_, h_, qrow0, qpos0, NT, nvalid);
        else attn_unit_diff(F, l, b_, h_, qrow0, qpos0, NT, nvalid);
    }
    __syncthreads();
}

__device__ __forceinline__ f32x4 meta_dot(const gbf16_t* arow, const gbf16_t* wrow, int K) {
    f32x4 acc = {0.f, 0.f, 0.f, 0.f};
#pragma unroll 8
    for (int k = 0; k < K; k += 32) { const bf16x8 a = *(const gbf16x8*)(arow + k); const bf16x8 w = *(const gbf16x8*)(wrow + k);
        acc = __builtin_amdgcn_mfma_f32_16x16x32_bf16(w, a, acc, 0, 0, 0); }
    return acc;
}
__device__ __forceinline__ float meta_rh(const gfloat* mssq, int tr) {
    float s = 0.f;
#pragma unroll
    for (int i = 0; i < 16; ++i) { const f32x4 v = *(const gf32x4*)(mssq + tr * 64 + 4 * i); s += (v[0] + v[1]) + (v[2] + v[3]); }
    return 1.0f / sqrtf(s * (1.0f / DM) + EPS);
}
__device__ __forceinline__ void meta_tasks(Frame& F, int kind, const pg8::Gemm& g, gbf16_t* eo, int eld, const gfloat* ers, const gfloat* src_meta, gbf16_t* xn) {
    const int tr = F.lane & 15, q = F.lane >> 4, row = NREAL + tr;
    const int kc = g.K >> 3, k0 = F.wave * kc;
    const gbf16_t* arow = g.A + (size_t)row * g.lda + 8 * q + k0;
    gfloat* mssq = (gfloat*)(F.p.ws + WS_MSSQ);
    LAS f32x4* red = (LAS f32x4*)F.lds;
    const int ntasks = (kind == 1 ? DFF : g.N) / 16;
    for (int t = blockIdx.x; t < ntasks; t += F.G) {
        int wr0 = 16 * t + tr, wr1 = 0;
        if (kind == 1) { const int c0 = 16 * t, pn = c0 >> 7, i0 = c0 & 127; wr0 = pn * 256 + i0 + tr; wr1 = wr0 + 128; }
        const f32x4 p0 = meta_dot(arow, g.Bt + (size_t)wr0 * g.K + 8 * q + k0, kc);
        red[F.wave * 64 + F.lane] = p0;
        if (kind == 1) { const f32x4 p1 = meta_dot(arow, g.Bt + (size_t)wr1 * g.K + 8 * q + k0, kc); red[512 + F.wave * 64 + F.lane] = p1; }
        __syncthreads();
        if (F.wave == 0) {
            f32x4 acc = red[F.lane];
#pragma unroll
            for (int w = 1; w < 8; ++w) acc += red[w * 64 + F.lane];
            if (kind == 0) {
                const float sc = ers ? ers[row] : meta_rh(mssq, tr);
                *(gu32x2*)(eo + (size_t)row * eld + 16 * t + 4 * q) = (u32x2){cvt_pk_bf16(acc[0] * sc, acc[1] * sc), cvt_pk_bf16(acc[2] * sc, acc[3] * sc)};
            } else if (kind == 1) {
                f32x4 au = red[512 + F.lane];
#pragma unroll
                for (int w = 1; w < 8; ++w) au += red[512 + w * 64 + F.lane];
                const float sc = meta_rh(mssq, tr);
                *(gu32x2*)(eo + (size_t)row * eld + 16 * t + 4 * q) = (u32x2){cvt_pk_bf16(pg8::silu_mul(acc[0] * sc, au[0] * sc), pg8::silu_mul(acc[1] * sc, au[1] * sc)),
                                                                           cvt_pk_bf16(pg8::silu_mul(acc[2] * sc, au[2] * sc), pg8::silu_mul(acc[3] * sc, au[3] * sc))};
            } else {
                const int c = 16 * t + 4 * q;
                const f32x4 h = *(const gf32x4*)(src_meta + (size_t)tr * DM + c) + acc;
                *(gf32x4*)((gfloat*)(F.p.ws + WS_HM) + (size_t)tr * DM + c) = h;
                *(gu32x2*)(xn + (size_t)row * DM + c) = (u32x2){cvt_pk_bf16(h[0], h[1]), cvt_pk_bf16(h[2], h[3])};
                float s = (h[0] * h[0] + h[1] * h[1]) + (h[2] * h[2] + h[3] * h[3]);
                s += __shfl_xor(s, 16); s += __shfl_xor(s, 32);
                if (q == 0) mssq[tr * 64 + t] = s;
            }
        }
        __syncthreads();
    }
    asm volatile("s_waitcnt vmcnt(0)" ::: "memory");
}

constexpr int SPL = 9, NSTAGES = 1 + SPL * DEPTH;
__device__ __forceinline__ bool stage_needs_sync(int st) { return !(st >= 1 && (st - 1) % SPL == 3); }
__device__ __forceinline__ void run_stage(const Params& p, LAS unsigned char* ldsp, int st) {
    Frame F;
    F.lds = ldsp;
    { int t = threadIdx.x; asm volatile("" : "+v"(t)); F.tid = t; }
    { unsigned char* w = p.ws; asm volatile("" : "+s"(w)); F.p.ws = (guchar*)w; }
#pragma unroll
    for (int i = 0; i < 21; ++i) F.p.in[i] = (const gfloat*)p.in[i];
    F.p.out = (gfloat*)p.out; F.p.s_lo = p.s_lo; F.p.s_hi = p.s_hi;
    F.lane = F.tid & 63; F.wave = __builtin_amdgcn_readfirstlane(F.tid >> 6);
    F.G = gridDim.x; { const int bx = blockIdx.x; F.vcu = (F.G % 8 == 0) ? (bx % 8) * (F.G / 8) + bx / 8 : bx; }
    F.gw = blockIdx.x * NWAVES + F.wave; F.ngw = F.G * NWAVES;
    const DParams& P = F.p;
    guchar* ws = P.ws;
    if (st == 0) { stage_prep(F); return; }
    const int l = (st - 1) / SPL, s = (st - 1) % SPL;
    const gchar* wb = (const gchar*)(ws + WS_W + (size_t)l * W_LAYER);
    gfloat* HM = (gfloat*)(ws + WS_HM);
    int kind = -1; pg8::Gemm g{nullptr, nullptr, NREAL, 0, 0, 0};
    gbf16_t* eo = nullptr; int eld = 0; const gfloat* ers = nullptr; const gfloat* epart = nullptr;
    const gfloat* sr = nullptr; const gfloat* sm = nullptr;
    switch (s) {
    case 0: kind = 0; g.A = (const gbf16_t*)(ws + WS_AO); g.Bt = (const gbf16_t*)(wb + W_IN); g.N = INWP; g.K = DM; g.lda = DM; eo = (gbf16_t*)(ws + WS_PROJ); eld = INWP; epart = (const gfloat*)(ws + WS_SSQH); break;
    case 1: stage_postproj(F, l); break;
    case 2: kind = 0; g.A = (const gbf16_t*)(ws + WS_PROJ) + PC_CQ; g.Bt = (const gbf16_t*)(wb + W_Q); g.N = 1024; g.K = 256; g.lda = INWP; eo = (gbf16_t*)(ws + WS_QRAW); eld = 1024; ers = (const gfloat*)(ws + WS_RQ); break;
    case 3: kind = 0; g.A = (const gbf16_t*)(ws + WS_PROJ) + PC_CKV; g.Bt = (const gbf16_t*)(wb + W_KV); g.N = 1024; g.K = 256; g.lda = INWP; eo = (gbf16_t*)(ws + WS_KVRAW); eld = 1024; ers = (const gfloat*)(ws + WS_RKV); break;
    case 4: stage_mla_qk(F, l); break;
    case 5: stage_attention(F, l); break;
    case 6: kind = 2; g.A = (const gbf16_t*)(ws + WS_AO); g.Bt = (const gbf16_t*)(wb + W_O); g.N = DM; g.K = DM; g.lda = DM; sr = l == 0 ? P.in[I_X] : P.out; sm = l == 0 ? P.in[I_META] : HM; break;
    case 7: kind = 1; g.A = (const gbf16_t*)(ws + WS_XN2); g.Bt = (const gbf16_t*)(wb + W_GU); g.N = 2 * DFF; g.K = DM; g.lda = DM; eo = (gbf16_t*)(ws + WS_ACT); eld = DFF; epart = (const gfloat*)(ws + WS_SSQH); break;
    case 8: kind = 2; g.A = (const gbf16_t*)(ws + WS_ACT); g.Bt = (const gbf16_t*)(wb + W_D); g.N = DM; g.K = DFF; g.lda = DFF; sr = P.out; sm = HM; break;
    }
    if (kind >= 0) {
        gbf16_t* xn = (gbf16_t*)(ws + (s == 6 ? WS_XN2 : WS_AO));
        meta_tasks(F, kind, g, eo, eld, ers, sm, xn);
        pg8::StaticOrder S; S.init(NREAL, g.N, F.G, (int)blockIdx.x);
        if (kind == 0) { pg8::EpiScaleBf16 E{eo, eld, ers, epart}; pg8::gemm_phase(F.lds, g, S, E); }
        else if (kind == 1) { pg8::EpiSwiglu E{eo, eld, ers, epart}; pg8::gemm_phase(F.lds, g, S, E); }
        else { pg8::EpiResidual E{sr, P.out, xn, (gfloat*)(ws + WS_SSQH)}; pg8::gemm_phase(F.lds, g, S, E); }
    }
}

__global__ void __launch_bounds__(NTHREADS, 2) stage_kernel(Params p) {
    extern __shared__ __attribute__((aligned(16))) unsigned char lds[];
#pragma unroll 1
    for (int st = p.s_lo; st < p.s_hi; ++st) run_stage(p, (LAS unsigned char*)lds, st);
}
constexpr int LDS_MISC_OFF = 131072 + 4096;
constexpr size_t CTL_BAR_OFF = 16384;
__global__ void __launch_bounds__(NTHREADS, 2) mega_kernel(Params p) {
    extern __shared__ __attribute__((aligned(16))) unsigned char lds[];
    cg::grid_group grid = cg::this_grid();
    volatile LAS unsigned* misc = (volatile LAS unsigned*)((LAS unsigned char*)lds + LDS_MISC_OFF);
    if (threadIdx.x < 4) misc[threadIdx.x] = 0u;
    __syncthreads();
    const XcdBarrier bar = xcd_barrier_post((unsigned*)(p.ws + WS_CTL + CTL_BAR_OFF), misc);
#pragma unroll 1
    for (int st = p.s_lo; st < p.s_hi; ++st) {
        if (st > p.s_lo && stage_needs_sync(st)) { if (st == 1) grid.sync(); else xcd_barrier(bar); }
        run_stage(p, (LAS unsigned char*)lds, st);
#if defined(PROBE_DUP)
        if ((st == 0 && (PROBE_DUP & 0x8000)) || (st >= 1 && ((PROBE_DUP >> ((st - 1) % SPL)) & 1))) { xcd_barrier(bar); run_stage(p, (LAS unsigned char*)lds, st); }
#endif
    }
}

extern "C" void kernel_launch(void* const* d_in, const int* in_sizes, int n_in, void* d_out, int out_size, void* d_ws, size_t ws_size, hipStream_t stream) {
    static int state = 0;
    if (state == 0) {
        if (n_in != 21 || in_sizes[0] != NREAL * DM || out_size != NREAL * DM || ws_size < WS_END) {
            fprintf(stderr, "kernel_launch: unexpected shapes: n_in %d in0 %d out %d ws %zu (need %zu)\n", n_in, n_in > 0 ? in_sizes[0] : -1, out_size, ws_size, (size_t)WS_END); state = -1; return; }
        int dev = 0, cus = 0;
        hipGetDevice(&dev); hipDeviceGetAttribute(&cus, hipDeviceAttributeMultiprocessorCount, dev);
        if (hipFuncSetAttribute((const void*)stage_kernel, hipFuncAttributeMaxDynamicSharedMemorySize, LDS_BYTES) != hipSuccess ||
            hipFuncSetAttribute((const void*)mega_kernel, hipFuncAttributeMaxDynamicSharedMemorySize, LDS_BYTES) != hipSuccess) { fprintf(stderr, "kernel_launch: hipFuncSetAttribute failed\n"); state = -1; return; }
        int per_cu = 0;
        hipOccupancyMaxActiveBlocksPerMultiprocessor(&per_cu, (const void*)mega_kernel, NTHREADS, LDS_BYTES);
        (void)hipGetLastError();
        if (cus != 256 || per_cu < 1) { fprintf(stderr, "kernel_launch: needs a 256-CU device with one resident workgroup per CU (cus %d, per_cu %d)\n", cus, per_cu); state = -1; return; }
        state = 1;
    }
    if (state < 0) return;
    Params p{};
    for (int i = 0; i < 21; ++i) p.in[i] = (const float*)d_in[i];
    p.out = (float*)d_out; p.ws = (unsigned char*)d_ws;
#if MK_ONE_LAUNCH
    p.s_lo = 0; p.s_hi = NSTAGES;
    if (hipMemsetAsync((char*)d_ws + WS_CTL, 0, 65536, stream) != hipSuccess) { fprintf(stderr, "kernel_launch: hipMemsetAsync failed\n"); return; }
    void* args[] = {&p};
    hipError_t e = hipLaunchCooperativeKernel((const void*)mega_kernel, dim3(256), dim3(NTHREADS), args, LDS_BYTES, stream);
    if (e != hipSuccess) fprintf(stderr, "kernel_launch: cooperative launch failed: %s\n", hipGetErrorString(e));
#else
    for (int st = 0; st < NSTAGES; ++st) {
        p.s_lo = st; p.s_hi = st + 1;
        hipLaunchKernelGGL(stage_kernel, dim3(256), dim3(NTHREADS), LDS_BYTES, stream, p);
    }
    const hipError_t le = hipPeekAtLastError();
    if (le != hipSuccess) fprintf(stderr, "kernel_launch: launch failed: %s\n", hipGetErrorName(le));
#endif
}
```

```cpp
#include <hip/hip_runtime.h>
#include <hip/hip_cooperative_groups.h>
#include <cstdio>
#include <cstdint>
namespace cg = cooperative_groups;


constexpr int DM = 1024, BATCH = 16, SEQ = 2048, NMETA = 16, DEPTH = 2;
constexpr int NREAL = BATCH * SEQ;
constexpr int NROWS = NREAL + NMETA;
constexpr int MP = 33024;
constexpr int LSEQ = SEQ + NMETA;
constexpr int INW = 1984, INWP = 2048, DFF = 2816;
constexpr float EPS = 1e-6f;
constexpr float LOG2E = 1.4426950408889634f;
constexpr float CA = 0.07216878364870322f * LOG2E;
constexpr float CD = 0.125f * LOG2E;
constexpr int PC_CQ = 0, PC_CKV = 256, PC_KR = 384, PC_DQ = 512, PC_DK = 1024, PC_DV = 1536;
constexpr int SRC_DQ = 448, SRC_DK = 960, SRC_DV = 1472;

constexpr size_t MiB = 1u << 20;
constexpr size_t WS_CTL = 0;
constexpr size_t WS_RH = 1 * MiB;
constexpr size_t WS_RQ = WS_RH + 256 * 1024;
constexpr size_t WS_RKV = WS_RQ + 256 * 1024;
constexpr size_t WS_HM = WS_RKV + 256 * 1024;
constexpr size_t WS_LAM = WS_HM + 64 * 1024;
constexpr size_t WS_MSSQ = WS_LAM + 1024;
constexpr size_t WS_RQP = 3 * MiB;
constexpr size_t WS_RKVP = WS_RQP + 512 * 1024;
constexpr size_t WS_KRSS = WS_RH;
constexpr size_t WS_COS = 2 * MiB;
constexpr size_t WS_SIN = WS_COS + 512 * 1024;
constexpr size_t WS_W = 4 * MiB;
constexpr size_t W_IN = 0, W_Q = W_IN + (size_t)INWP * DM * 2, W_KV = W_Q + (size_t)1024 * 256 * 2, W_O = W_KV + (size_t)1024 * 256 * 2,
                 W_GU = W_O + (size_t)DM * DM * 2, W_D = W_GU + (size_t)2 * DFF * DM * 2, W_LAYER = W_D + (size_t)DM * DFF * 2;
static_assert(WS_W + 2 * W_LAYER <= 52 * MiB, "weights");
constexpr size_t WS_PROJ = 52 * MiB;
constexpr size_t WS_KVRAW = WS_PROJ + (size_t)MP * INWP * 2;
constexpr size_t WS_QA = WS_KVRAW + (size_t)MP * 1024 * 2;
constexpr size_t WS_KA = WS_QA + (size_t)MP * 768 * 2;
constexpr size_t WS_HBA = WS_KA + (size_t)MP * 768 * 2;
constexpr size_t WS_AO = WS_HBA + (size_t)MP * 1024 * 2;
constexpr size_t WS_TMP = WS_AO + (size_t)MP * 1024 * 2;
constexpr size_t WS_SSQH = WS_TMP + (size_t)256 * 64 * 512 * 4;
constexpr size_t WS_END = WS_SSQH + (size_t)NREAL * 16 * 4;
constexpr size_t WS_QRAW = WS_QA;
constexpr size_t WS_QRAW_OLD_UNUSED = WS_AO;
constexpr size_t WS_HBB = WS_QA;
constexpr size_t WS_ACT = WS_PROJ;
static_assert(WS_ACT + (size_t)MP * DFF * 2 <= WS_QA, "ACT overlay");

#define LAS __attribute__((address_space(3)))
typedef unsigned short bf16_t;
typedef short bf16x8 __attribute__((ext_vector_type(8)));
typedef short s16x4 __attribute__((ext_vector_type(4)));
typedef float f32x4 __attribute__((ext_vector_type(4)));
typedef float f32x16 __attribute__((ext_vector_type(16)));
typedef unsigned u32x4 __attribute__((ext_vector_type(4)));
typedef unsigned u32x2 __attribute__((ext_vector_type(2)));
#define GAS __attribute__((address_space(1)))
typedef GAS bf16_t gbf16_t; typedef GAS float gfloat; typedef GAS unsigned char guchar; typedef GAS char gchar; typedef GAS unsigned gunsigned;
typedef GAS u32x4 gu32x4; typedef GAS u32x2 gu32x2; typedef GAS f32x4 gf32x4; typedef GAS bf16x8 gbf16x8;

__device__ __forceinline__ unsigned f2bf(float f) { unsigned u = __builtin_bit_cast(unsigned, f); return (u + 0x7fffu + ((u >> 16) & 1u)) >> 16; }
__device__ __forceinline__ unsigned pk2(float lo, float hi) { return f2bf(lo) | (f2bf(hi) << 16); }
__device__ __forceinline__ float bf2f(unsigned b) { return __builtin_bit_cast(float, b << 16); }
__device__ __forceinline__ unsigned cvt_pk_bf16(float lo, float hi) { unsigned r; asm volatile("v_cvt_pk_bf16_f32 %0, %1, %2" : "=v"(r) : "v"(lo), "v"(hi)); return r; }
__device__ __forceinline__ float wave_sum(float v) {
#pragma unroll
    for (int o = 1; o < 64; o <<= 1) v += __shfl_xor(v, o);
    return v;
}
#define LDS_WAIT() asm volatile("s_waitcnt lgkmcnt(0)" ::: "memory")

__device__ __forceinline__ void unpack8(const u32x4 v, float (&x)[8]) {
    x[0] = bf2f(v.x & 0xffffu); x[1] = bf2f(v.x >> 16); x[2] = bf2f(v.y & 0xffffu); x[3] = bf2f(v.y >> 16);
    x[4] = bf2f(v.z & 0xffffu); x[5] = bf2f(v.z >> 16); x[6] = bf2f(v.w & 0xffffu); x[7] = bf2f(v.w >> 16);
}
__device__ __forceinline__ u32x4 pack8(const float (&x)[8]) { return (u32x4){pk2(x[0], x[1]), pk2(x[2], x[3]), pk2(x[4], x[5]), pk2(x[6], x[7])}; }
__device__ __forceinline__ float ssq8(const float (&x)[8]) { return ((x[0] * x[0] + x[1] * x[1]) + (x[2] * x[2] + x[3] * x[3])) + ((x[4] * x[4] + x[5] * x[5]) + (x[6] * x[6] + x[7] * x[7])); }
__device__ __forceinline__ void norm_rope8(float (&x)[8], float r, const float (&g)[8], const float (&cs)[8], const float (&sn)[8], bool upper, float post) {
#pragma unroll
    for (int e = 0; e < 8; ++e) { const float y = x[e] * r * g[e], pt = __shfl_xor(y, 4); x[e] = (upper ? y * cs[e] + pt * sn[e] : y * cs[e] - pt * sn[e]) * post; }
}
__device__ __forceinline__ void load8f(float (&d)[8], const gfloat* p) { const f32x4 a = *(const gf32x4*)p, b = *(const gf32x4*)(p + 4); d[0] = a[0]; d[1] = a[1]; d[2] = a[2]; d[3] = a[3]; d[4] = b[0]; d[5] = b[1]; d[6] = b[2]; d[7] = b[3]; }


namespace pg8 {
constexpr int BM = 256, BK = 64, HALF = 128, HTB = HALF * BK * 2, STAGE_BYTES = 8 * HTB, NXCD = 8, WGM = 8;
__host__ __device__ __forceinline__ int lds_byte(int r, int c) { const int st = (r >> 4) * 2 + (c >> 5), rr = r & 15, cc = c & 31, ob = rr * 64 + cc * 2; return st * 1024 + (ob ^ (((ob >> 9) & 1) << 5)); }
__host__ __device__ __forceinline__ void stage_rc(int b, int& R, int& C) { const int st = b / 1024, sb = b % 1024, swz = sb ^ (((sb >> 9) & 1) << 5); R = (st >> 1) * 16 + swz / 64; C = (st & 1) * 32 + (swz % 64) / 2; }
__host__ __device__ __forceinline__ int perm32(int rho) { const int n = rho >> 4, i = rho & 15; return 8 * (i >> 2) + 4 * n + (i & 3); }

struct Unit { int pm, pn; };
struct Gemm { const gbf16_t* A; const gbf16_t* Bt; int M, N, K, lda; };

struct StaticOrder {
    int nM, nN, nwg, G, c;
    __device__ void init(int M, int N, int G_, int c_) { nM = M / BM; nN = N / BM; nwg = nM * nN; G = G_; c = c_; }
    __device__ bool next(int i, Unit& u) const {
        const long L = (long)i * G + c; if (L >= nwg) return false;
        int wgid = (int)L; { const int q = nwg / NXCD, r = nwg % NXCD, xcd = wgid % NXCD, off = wgid / NXCD; wgid = (xcd < r ? xcd * (q + 1) : r * (q + 1) + (xcd - r) * q) + off; }
        const int nig = WGM * nN, gid = wgid / nig, fm = gid * WGM, gsz = (nM - fm) < WGM ? (nM - fm) : WGM;
        u.pm = fm + ((wgid % nig) % gsz); u.pn = (wgid % nig) / gsz; return true;
    }
};

__device__ __forceinline__ void row_scales(float (&sc)[2][4], const gfloat* rs, const gfloat* part, int npart, float inv_div, int row0, int fq) {
    if (!part) {
#pragma unroll
        for (int ai = 0; ai < 2; ++ai)
#pragma unroll
            for (int m = 0; m < 4; ++m) sc[ai][m] = rs[row0 + ai * HALF + m * 16];
        return;
    }
    f32x4 v[8];
#pragma unroll
    for (int i = 0; i < 8; ++i) { const int row = row0 + (i >> 2) * HALF + (i & 3) * 16; v[i] = npart == 16 ? *(const gf32x4*)(part + (size_t)row * 16 + 4 * fq) : *(const gf32x4*)(part + (size_t)row * 4); }
    __builtin_amdgcn_sched_barrier(0);
    float s[8];
#pragma unroll
    for (int i = 0; i < 8; ++i) s[i] = (v[i][0] + v[i][1]) + (v[i][2] + v[i][3]);
    if (npart == 16) { float t[8];
#pragma unroll
        for (int i = 0; i < 8; ++i) t[i] = __shfl_xor(s[i], 16);
#pragma unroll
        for (int i = 0; i < 8; ++i) s[i] += t[i];
#pragma unroll
        for (int i = 0; i < 8; ++i) t[i] = __shfl_xor(s[i], 32);
#pragma unroll
        for (int i = 0; i < 8; ++i) s[i] += t[i]; }
#pragma unroll
    for (int i = 0; i < 8; ++i) sc[i >> 2][i & 3] = 1.0f / sqrtf(s[i] * inv_div + EPS);
}
struct EpiScaleBf16 {
    static constexpr bool PERM = true;
    gbf16_t* O; int ldc; const gfloat* part; int npart; float inv_div; int tstride, tvalid;
    __device__ __forceinline__ void operator()(const f32x4 (&acc)[2][2][4][2], const Unit& u, int wr, int wc, int fr, int fq, LAS unsigned char*) const {
        const int row0 = u.pm * BM + wr * 64 + fr, cin = wc * 32 + 8 * fq, col0 = u.pn * tstride + cin;
        float sc[2][4]; row_scales(sc, nullptr, part, npart, inv_div, row0, fq);
#pragma unroll
        for (int ai = 0; ai < 2; ++ai)
#pragma unroll
            for (int m = 0; m < 4; ++m) { const int row = row0 + ai * HALF + m * 16; const float s = sc[ai][m]; gbf16_t* rowp = O + (size_t)row * ldc + col0;
#pragma unroll
                for (int bj = 0; bj < 2; ++bj) { const f32x4 v0 = acc[ai][bj][m][0] * s, v1 = acc[ai][bj][m][1] * s;
                    u32x4 w; w.x = cvt_pk_bf16(v0[0], v0[1]); w.y = cvt_pk_bf16(v0[2], v0[3]); w.z = cvt_pk_bf16(v1[0], v1[1]); w.w = cvt_pk_bf16(v1[2], v1[3]);
                    if (cin + bj * HALF < tvalid) *(gu32x4*)(rowp + bj * HALF) = w; } }
    }
};
struct EpiInProj {
    static constexpr bool PERM = true;
    gbf16_t* O; const gfloat* part; gfloat* rqp; gfloat* rkvp; gfloat* krss; const gfloat* COS; const gfloat* SIN; const gfloat* gdq; const gfloat* gdk;
    __device__ __forceinline__ void operator()(const f32x4 (&acc)[2][2][4][2], const Unit& u, int wr, int wc, int fr, int fq, LAS unsigned char*) const {
        const int row0 = u.pm * BM + wr * 64 + fr, cin = wc * 32 + 8 * fq;
        float sc[2][4]; row_scales(sc, nullptr, part, 16, 1.0f / DM, row0, fq);
        if (u.pn >= 2 && u.pn < 6) {
            const gfloat* gp = (u.pn < 4 ? gdq : gdk) + 8 * fq; const float post = u.pn < 4 ? CD : 1.0f;
            const f32x4 gl0 = *(const gf32x4*)gp, gl1 = *(const gf32x4*)(gp + 4), gh0 = *(const gf32x4*)(gp + 32), gh1 = *(const gf32x4*)(gp + 36);
#pragma unroll
            for (int ai = 0; ai < 2; ++ai)
#pragma unroll
                for (int m = 0; m < 4; ++m) { const int row = row0 + ai * HALF + m * 16, pos = NMETA + (row & (SEQ - 1)); const float s = sc[ai][m];
                    f32x4 l0 = acc[ai][0][m][0] * s, l1 = acc[ai][0][m][1] * s, h0 = acc[ai][1][m][0] * s, h1 = acc[ai][1][m][1] * s;
                    float q = (((l0[0] * l0[0] + l0[1] * l0[1]) + (l0[2] * l0[2] + l0[3] * l0[3])) + ((l1[0] * l1[0] + l1[1] * l1[1]) + (l1[2] * l1[2] + l1[3] * l1[3])))
                            + (((h0[0] * h0[0] + h0[1] * h0[1]) + (h0[2] * h0[2] + h0[3] * h0[3])) + ((h1[0] * h1[0] + h1[1] * h1[1]) + (h1[2] * h1[2] + h1[3] * h1[3])));
                    q += __shfl_xor(q, 16); q += __shfl_xor(q, 32);
                    const float r = 1.0f / sqrtf(q * (1.0f / 64.0f) + EPS);
                    const f32x4 c0 = *(const gf32x4*)(COS + pos * 32 + 8 * fq), c1 = *(const gf32x4*)(COS + pos * 32 + 8 * fq + 4), s0 = *(const gf32x4*)(SIN + pos * 32 + 8 * fq), s1 = *(const gf32x4*)(SIN + pos * 32 + 8 * fq + 4);
                    l0 = l0 * r * gl0; l1 = l1 * r * gl1; h0 = h0 * r * gh0; h1 = h1 * r * gh1;
                    const f32x4 ol0 = (l0 * c0 - h0 * s0) * post, ol1 = (l1 * c1 - h1 * s1) * post, oh0 = (h0 * c0 + l0 * s0) * post, oh1 = (h1 * c1 + l1 * s1) * post;
                    gbf16_t* rowp = O + (size_t)row * INWP + u.pn * BM + 64 * wc + 8 * fq;
                    u32x4 w; w.x = cvt_pk_bf16(ol0[0], ol0[1]); w.y = cvt_pk_bf16(ol0[2], ol0[3]); w.z = cvt_pk_bf16(ol1[0], ol1[1]); w.w = cvt_pk_bf16(ol1[2], ol1[3]);
                    *(gu32x4*)rowp = w;
                    w.x = cvt_pk_bf16(oh0[0], oh0[1]); w.y = cvt_pk_bf16(oh0[2], oh0[3]); w.z = cvt_pk_bf16(oh1[0], oh1[1]); w.w = cvt_pk_bf16(oh1[2], oh1[3]);
                    *(gu32x4*)(rowp + 32) = w;
                    asm volatile("" ::: "memory"); }
            return;
        }
#pragma unroll
        for (int ai = 0; ai < 2; ++ai)
#pragma unroll
            for (int m = 0; m < 4; ++m) { const int row = row0 + ai * HALF + m * 16; const float s = sc[ai][m]; gbf16_t* rowp = O + (size_t)row * INWP + u.pn * BM + cin; float q[2];
#pragma unroll
                for (int bj = 0; bj < 2; ++bj) { const f32x4 v0 = acc[ai][bj][m][0] * s, v1 = acc[ai][bj][m][1] * s;
                    u32x4 w; w.x = cvt_pk_bf16(v0[0], v0[1]); w.y = cvt_pk_bf16(v0[2], v0[3]); w.z = cvt_pk_bf16(v1[0], v1[1]); w.w = cvt_pk_bf16(v1[2], v1[3]);
                    *(gu32x4*)(rowp + bj * HALF) = w;
                    q[bj] = ((v0[0] * v0[0] + v0[1] * v0[1]) + (v0[2] * v0[2] + v0[3] * v0[3])) + ((v1[0] * v1[0] + v1[1] * v1[1]) + (v1[2] * v1[2] + v1[3] * v1[3])); }
                if (u.pn < 2) {
                    q[0] += __shfl_xor(q[0], 16); q[0] += __shfl_xor(q[0], 32); q[1] += __shfl_xor(q[1], 16); q[1] += __shfl_xor(q[1], 32);
                    if (fq == 0) { if (u.pn == 0) rqp[(size_t)row * 4 + wc] = q[0] + q[1];
                                   else { rkvp[(size_t)row * 4 + wc] = q[0]; if (wc < 2) krss[(size_t)row * 2 + wc] = q[1]; } } } }
    }
};
__device__ __forceinline__ float silu_mul(float g, float u) { const float e = __builtin_amdgcn_exp2f(-g * LOG2E); return g * __builtin_amdgcn_rcpf(1.0f + e) * u; }
typedef float f32x2 __attribute__((ext_vector_type(2)));
__device__ __forceinline__ f32x2 swiglu_pk(f32x2 g, f32x2 u, float ks, float s2) {
    const f32x2 a = g * ks; f32x2 e; e.x = __builtin_amdgcn_exp2f(a.x); e.y = __builtin_amdgcn_exp2f(a.y);
    const f32x2 d = e + 1.0f; f32x2 r; r.x = __builtin_amdgcn_rcpf(d.x); r.y = __builtin_amdgcn_rcpf(d.y);
    return (g * u) * (r * s2);
}
struct EpiSwiglu {
    static constexpr bool PERM = true;
    gbf16_t* O; int ldc; const gfloat* rs; const gfloat* part;
    __device__ __forceinline__ void operator()(const f32x4 (&acc)[2][2][4][2], const Unit& u, int wr, int wc, int fr, int fq, LAS unsigned char*) const {
        const int row0 = u.pm * BM + wr * 64 + fr, col0 = u.pn * HALF + wc * 32 + 8 * fq;
        float sc[2][4]; row_scales(sc, rs, part, 16, 1.0f / DM, row0, fq);
#pragma unroll
        for (int ai = 0; ai < 2; ++ai)
#pragma unroll
            for (int m = 0; m < 4; ++m) { const int row = row0 + ai * HALF + m * 16; const float s = sc[ai][m], ks = -s * LOG2E, s2 = s * s;
                u32x4 w;
#pragma unroll
                for (int n = 0; n < 2; ++n) { const f32x4 g = acc[ai][0][m][n], uu = acc[ai][1][m][n];
                    const f32x2 o0 = swiglu_pk((f32x2){g[0], g[1]}, (f32x2){uu[0], uu[1]}, ks, s2), o1 = swiglu_pk((f32x2){g[2], g[3]}, (f32x2){uu[2], uu[3]}, ks, s2);
                    w[2 * n] = cvt_pk_bf16(o0.x, o0.y); w[2 * n + 1] = cvt_pk_bf16(o1.x, o1.y); }
                *(gu32x4*)(O + (size_t)row * ldc + col0) = w; }
    }
};
template <bool LAST> struct EpiResidual {
    static constexpr bool PERM = true;
    const gbf16_t* hsrc; gbf16_t* hdst; gfloat* part; gfloat* out;
    __device__ __forceinline__ void operator()(const f32x4 (&acc)[2][2][4][2], const Unit& u, int wr, int wc, int fr, int fq, LAS unsigned char*) const {
        const int row0 = u.pm * BM + wr * 64 + fr, col0 = u.pn * BM + wc * 32 + 8 * fq;
#pragma unroll
        for (int ai = 0; ai < 2; ++ai) {
            u32x4 hv[4][2];
#pragma unroll
            for (int m = 0; m < 4; ++m)
#pragma unroll
                for (int bj = 0; bj < 2; ++bj) hv[m][bj] = *(const gu32x4*)(hsrc + (size_t)(row0 + ai * HALF + m * 16) * DM + col0 + bj * HALF);
            __builtin_amdgcn_sched_barrier(0);
#pragma unroll
            for (int m = 0; m < 4; ++m) { const int row = row0 + ai * HALF + m * 16;
                float q = 0.f;
#pragma unroll
                for (int bj = 0; bj < 2; ++bj) { float x[8]; unpack8(hv[m][bj], x);
                    const f32x4 h0 = (f32x4){x[0], x[1], x[2], x[3]} + acc[ai][bj][m][0], h1 = (f32x4){x[4], x[5], x[6], x[7]} + acc[ai][bj][m][1];
                    if (LAST) { gfloat* o = out + (size_t)row * DM + col0 + bj * HALF; *(gf32x4*)o = h0; *(gf32x4*)(o + 4) = h1; }
                    else { u32x4 w; w.x = cvt_pk_bf16(h0[0], h0[1]); w.y = cvt_pk_bf16(h0[2], h0[3]); w.z = cvt_pk_bf16(h1[0], h1[1]); w.w = cvt_pk_bf16(h1[2], h1[3]);
                           *(gu32x4*)(hdst + (size_t)row * DM + col0 + bj * HALF) = w;
                           q += ((h0[0] * h0[0] + h0[1] * h0[1]) + (h0[2] * h0[2] + h0[3] * h0[3])) + ((h1[0] * h1[0] + h1[1] * h1[1]) + (h1[2] * h1[2] + h1[3] * h1[3])); } }
                if (!LAST) { q += __shfl_xor(q, 16); q += __shfl_xor(q, 32);
                    if (fq == 0) part[(size_t)row * 16 + u.pn * 4 + wc] = q; } }
            __builtin_amdgcn_sched_barrier(0); }
    }
};

struct EpiKV {
    static constexpr bool PERM = true;
    gbf16_t* KA; gbf16_t* KV; const gbf16_t* PROJ; const gfloat* rkvp; const gfloat* krss; const gfloat* COS; const gfloat* SIN; const gfloat* gk;
    __device__ __forceinline__ void operator()(const f32x4 (&acc)[2][2][4][2], const Unit& u, int wr, int wc, int fr, int fq, LAS unsigned char* lds) const {
        const int row0 = u.pm * BM + wr * 64 + fr, h = u.pn, c8 = wc * 32 + 8 * fq;
        LAS float* xch = (LAS float*)(lds + STAGE_BYTES);
        float sc[2][4]; row_scales(sc, nullptr, rkvp, 4, 1.0f / 128.0f, row0, fq);
#pragma unroll
        for (int ai = 0; ai < 2; ++ai)
#pragma unroll
            for (int m = 0; m < 4; ++m) { const float s = sc[ai][m]; const f32x4 v0 = acc[ai][0][m][0] * s, v1 = acc[ai][0][m][1] * s;
                float q = ((v0[0] * v0[0] + v0[1] * v0[1]) + (v0[2] * v0[2] + v0[3] * v0[3])) + ((v1[0] * v1[0] + v1[1] * v1[1]) + (v1[2] * v1[2] + v1[3] * v1[3]));
                q += __shfl_xor(q, 16); q += __shfl_xor(q, 32);
                if (fq == 0) xch[(ai * HALF + wr * 64 + m * 16 + fr) * 4 + wc] = q; }
        asm volatile("s_waitcnt lgkmcnt(0)" ::: "memory"); __builtin_amdgcn_s_barrier(); asm volatile("" ::: "memory");
        f32x4 g0 = *(const gf32x4*)(gk + c8), g1 = *(const gf32x4*)(gk + c8 + 4);
        const int t = wc * 4 + fq, tp = (t + 8) & 15;
        const f32x4 gr = *(const gf32x4*)(gk + 128 + 4 * t), gp = *(const gf32x4*)(gk + 128 + 4 * tp);
#pragma unroll
        for (int am = 0; am < 4; ++am) { const int ai = am >> 1, m0 = (am & 1) * 2;
            float kq[4]; u32x2 ka[4], kb[4]; f32x4 cs[4], sn[4];
#pragma unroll
            for (int m = m0; m < m0 + 2; ++m) { const int row = u.pm * BM + ai * HALF + wr * 64 + m * 16 + fr, pos = NMETA + (row & (SEQ - 1));
                kq[m] = krss[(size_t)row * 2] + krss[(size_t)row * 2 + 1];
                ka[m] = *(const gu32x2*)(PROJ + (size_t)row * INWP + PC_KR + 4 * t); kb[m] = *(const gu32x2*)(PROJ + (size_t)row * INWP + PC_KR + 4 * tp);
                cs[m] = *(const gf32x4*)(COS + pos * 32 + ((4 * t) & 31)); sn[m] = *(const gf32x4*)(SIN + pos * 32 + ((4 * t) & 31)); }
            __builtin_amdgcn_sched_barrier(0);
#pragma unroll
            for (int m = m0; m < m0 + 2; ++m) { const int rl = ai * HALF + wr * 64 + m * 16 + fr, row = u.pm * BM + rl; const float s = sc[ai][m];
                const f32x4 px = *(const LAS f32x4*)(xch + rl * 4);
                const float r = 1.0f / sqrtf((((px[0] + px[1]) + (px[2] + px[3])) + kq[m]) * (1.0f / 192.0f) + EPS);
                { const f32x4 v0 = acc[ai][0][m][0] * (s * r) * g0, v1 = acc[ai][0][m][1] * (s * r) * g1;
                  u32x4 w; w.x = cvt_pk_bf16(v0[0], v0[1]); w.y = cvt_pk_bf16(v0[2], v0[3]); w.z = cvt_pk_bf16(v1[0], v1[1]); w.w = cvt_pk_bf16(v1[2], v1[3]);
                  *(gu32x4*)(KA + (size_t)row * 768 + h * 192 + c8) = w; }
                { const f32x4 v0 = acc[ai][1][m][0] * s, v1 = acc[ai][1][m][1] * s;
                  u32x4 w; w.x = cvt_pk_bf16(v0[0], v0[1]); w.y = cvt_pk_bf16(v0[2], v0[3]); w.z = cvt_pk_bf16(v1[0], v1[1]); w.w = cvt_pk_bf16(v1[2], v1[3]);
                  *(gu32x4*)(KV + (size_t)row * 1024 + h * 256 + 128 + c8) = w; }
                { const u32x2 a = ka[m], b = kb[m];
                  const f32x4 x = (f32x4){bf2f(a.x & 0xffffu), bf2f(a.x >> 16), bf2f(a.y & 0xffffu), bf2f(a.y >> 16)} * gr;
                  const f32x4 xp = (f32x4){bf2f(b.x & 0xffffu), bf2f(b.x >> 16), bf2f(b.y & 0xffffu), bf2f(b.y >> 16)} * gp;
                  const f32x4 o = (t < 8 ? x * cs[m] - xp * sn[m] : x * cs[m] + xp * sn[m]) * r;
                  *(gu32x2*)(KA + (size_t)row * 768 + h * 192 + 128 + 4 * t) = (u32x2){cvt_pk_bf16(o[0], o[1]), cvt_pk_bf16(o[2], o[3])}; } }
            __builtin_amdgcn_sched_barrier(0); }
    }
};

template <class Sched>
__device__ __forceinline__ void gemm_prefetch(LAS unsigned char* lds, const Gemm g, const Sched& S, bool perm) {
    int tid_ = threadIdx.x; asm volatile("" : "+v"(tid_));
    const int tid = tid_, wid = __builtin_amdgcn_readfirstlane(tid >> 6);
    Unit cur; if (!S.next(0, cur)) return;
    const int K = g.K, lda = g.lda;
    const size_t hstepA = (size_t)HALF * lda * 2, hstepB = (size_t)HALF * K * 2;
    const char* cA = (const char*)(const void*)g.A + (size_t)cur.pm * 2 * hstepA; const char* cB = (const char*)(const void*)g.Bt + (size_t)cur.pn * 2 * hstepB;
    const unsigned ldsw = (unsigned)wid * 1024u;
    unsigned va[2], vb[2];
#pragma unroll
    for (int i = 0; i < 2; ++i) { int R, C; stage_rc(tid * 16 + i * 8192, R, C); const int Rb = perm ? ((R & ~31) + perm32(R & 31)) : R;
        va[i] = (unsigned)(R * lda + C) * 2u; vb[i] = (unsigned)(Rb * K + C) * 2u; }
#pragma unroll
    for (int i = 0; i < 2; ++i) __builtin_amdgcn_global_load_lds((const gunsigned*)(const void*)(cB + vb[i]), (LAS unsigned*)(lds + 4 * HTB + ldsw + i * 8192), 16, 0, 0);
#pragma unroll
    for (int i = 0; i < 2; ++i) __builtin_amdgcn_global_load_lds((const gunsigned*)(const void*)(cB + hstepB + vb[i]), (LAS unsigned*)(lds + 5 * HTB + ldsw + i * 8192), 16, 0, 0);
#pragma unroll
    for (int i = 0; i < 2; ++i) __builtin_amdgcn_global_load_lds((const gunsigned*)(const void*)(cA + va[i]), (LAS unsigned*)(lds + 0 * HTB + ldsw + i * 8192), 16, 0, 0);
#pragma unroll
    for (int i = 0; i < 2; ++i) __builtin_amdgcn_global_load_lds((const gunsigned*)(const void*)(cA + hstepA + va[i]), (LAS unsigned*)(lds + 1 * HTB + ldsw + i * 8192), 16, 0, 0);
}
template <bool PRE, class Epi, class Sched>
__device__ __forceinline__ void gemm_phase(LAS unsigned char* lds, const Gemm g, const Sched& S, const Epi& E) {
    int tid_ = threadIdx.x; asm volatile("" : "+v"(tid_));
    const int tid = tid_, wid = __builtin_amdgcn_readfirstlane(tid >> 6), lane = tid & 63, wr = wid >> 2, wc = wid & 3, fr = lane & 15, fq = lane >> 4;
    const int K = g.K, nt = K / BK, lda = g.lda;
    unsigned voffA[2], voffB[2];
#pragma unroll
    for (int i = 0; i < 2; ++i) { int R, C; stage_rc(tid * 16 + i * 8192, R, C); const int Rb = Epi::PERM ? ((R & ~31) + perm32(R & 31)) : R;
        voffA[i] = (unsigned)(R * lda + C) * 2u; voffB[i] = (unsigned)(Rb * K + C) * 2u; }
    const size_t kstep = (size_t)(BK * 2);
    const size_t hstepA = (size_t)HALF * lda * 2, hstepB = (size_t)HALF * K * 2;
    const size_t tstepA = 2 * hstepA, tstepB = 2 * hstepB;
    const unsigned ldsw = (unsigned)wid * 1024u;
    const int aoff = lds_byte(wr * 64 + fr, fq * 8), boff = lds_byte(wc * 32 + fr, fq * 8);
#define PG8_SA(b, h) (((b) * 2 + (h)) * HTB)
#define PG8_SB(b, h) ((4 + (b) * 2 + (h)) * HTB)
#define PG8_STAGE(bufoff, gbase, voff) do { _Pragma("unroll") for (int _i = 0; _i < 2; ++_i) \
        __builtin_amdgcn_global_load_lds((const gunsigned*)((const gchar*)(gbase) + (voff)[_i]), (LAS unsigned*)(lds + (bufoff) + ldsw + _i * 8192), 16, 0, 0); } while (0)
#define PG8_LDA(dst, b, h) do { _Pragma("unroll") for (int m = 0; m < 4; ++m) _Pragma("unroll") for (int k = 0; k < 2; ++k) dst[m][k] = *(const LAS bf16x8*)(lds + PG8_SA(b, h) + aoff + m * 2048 + k * 1024); } while (0)
#define PG8_LDB(dst, b, h) do { _Pragma("unroll") for (int n = 0; n < 2; ++n) _Pragma("unroll") for (int k = 0; k < 2; ++k) dst[n][k] = *(const LAS bf16x8*)(lds + PG8_SB(b, h) + boff + n * 2048 + k * 1024); } while (0)
#define PG8_MMA(ai, bj, At, Bt) do { __builtin_amdgcn_s_setprio(1); _Pragma("unroll") for (int m = 0; m < 4; ++m) _Pragma("unroll") for (int n = 0; n < 2; ++n) _Pragma("unroll") for (int k = 0; k < 2; ++k) \
        acc[ai][bj][m][n] = __builtin_amdgcn_mfma_f32_16x16x32_bf16(Bt[n][k], At[m][k], acc[ai][bj][m][n], 0, 0, 0); __builtin_amdgcn_s_setprio(0); } while (0)
#define PG8_WAIT_V(n) asm volatile("s_waitcnt vmcnt(" #n ")" ::: "memory")
#define PG8_WAIT_L(n) asm volatile("s_waitcnt lgkmcnt(" #n ")" ::: "memory")
#define PG8_BAR __builtin_amdgcn_s_barrier()
#define PG8_SCHED __builtin_amdgcn_sched_barrier(0)
    Unit cur, nxt; int ui = 0;
    if (!S.next(0, cur)) return;
    f32x4 acc[2][2][4][2];
#pragma unroll
    for (int a = 0; a < 2; ++a)
#pragma unroll
        for (int b = 0; b < 2; ++b)
#pragma unroll
            for (int m = 0; m < 4; ++m)
#pragma unroll
                for (int n = 0; n < 2; ++n) acc[a][b][m][n] = (f32x4){0.f, 0.f, 0.f, 0.f};
    bf16x8 At[4][2], B0[2][2], B1[2][2];
    const gchar* cA = (const gchar*)g.A + (size_t)cur.pm * tstepA; const gchar* cB = (const gchar*)g.Bt + (size_t)cur.pn * tstepB;
    if constexpr (!PRE) { PG8_STAGE(PG8_SB(0, 0), cB, voffB); PG8_STAGE(PG8_SB(0, 1), cB + hstepB, voffB); PG8_STAGE(PG8_SA(0, 0), cA, voffA); PG8_STAGE(PG8_SA(0, 1), cA + hstepA, voffA); }
    if (wr == 1) PG8_BAR;
    PG8_WAIT_V(2); PG8_BAR;
    PG8_STAGE(PG8_SB(1, 0), cB + kstep, voffB); PG8_STAGE(PG8_SA(1, 0), cA + kstep, voffA); PG8_STAGE(PG8_SB(1, 1), cB + hstepB + kstep, voffB);
    PG8_WAIT_V(6); PG8_BAR;
    for (;;) {
        const bool has_next = S.next(ui + 1, nxt);
        const gchar* nA = has_next ? (const gchar*)g.A + (size_t)nxt.pm * tstepA : cA; const gchar* nB = has_next ? (const gchar*)g.Bt + (size_t)nxt.pn * tstepB : cB;
        for (int t = 0; t < nt; t += 2) {
            const bool last = (t == nt - 2);
            const gchar* a1 = cA + (size_t)(t + 1) * kstep;
            const gchar* a2 = last ? nA : cA + (size_t)(t + 2) * kstep; const gchar* b2 = last ? nB : cB + (size_t)(t + 2) * kstep;
            const gchar* a3 = a2 + kstep; const gchar* b3 = b2 + kstep;
            PG8_LDB(B0, 0, 0); PG8_LDB(B1, 0, 1); PG8_SCHED; PG8_LDA(At, 0, 0); PG8_STAGE(PG8_SA(1, 1), a1 + hstepA, voffA);
            PG8_WAIT_V(8); PG8_WAIT_L(0); PG8_BAR; PG8_MMA(0, 0, At, B0); PG8_MMA(0, 1, At, B1); PG8_BAR; PG8_SCHED;
            PG8_LDA(At, 0, 1); PG8_STAGE(PG8_SB(0, 0), b2, voffB); PG8_STAGE(PG8_SB(0, 1), b2 + hstepB, voffB); PG8_STAGE(PG8_SA(0, 0), a2, voffA);
            PG8_WAIT_V(8); PG8_WAIT_L(0); PG8_BAR; PG8_MMA(1, 0, At, B0); PG8_MMA(1, 1, At, B1); PG8_BAR; PG8_SCHED;
            PG8_LDB(B0, 1, 0); PG8_LDB(B1, 1, 1); PG8_SCHED; PG8_LDA(At, 1, 0); PG8_STAGE(PG8_SA(0, 1), a2 + hstepA, voffA);
            PG8_WAIT_V(8); PG8_WAIT_L(0); PG8_BAR; PG8_MMA(0, 0, At, B0); PG8_MMA(0, 1, At, B1); PG8_BAR; PG8_SCHED;
            PG8_LDA(At, 1, 1); PG8_STAGE(PG8_SB(1, 0), b3, voffB); PG8_STAGE(PG8_SB(1, 1), b3 + hstepB, voffB); PG8_STAGE(PG8_SA(1, 0), a3, voffA);
            PG8_WAIT_V(8); PG8_WAIT_L(0); PG8_BAR; PG8_MMA(1, 0, At, B0); PG8_MMA(1, 1, At, B1); PG8_BAR; PG8_SCHED;
        }
        if (wr == 0) PG8_BAR;
        { Unit ue = cur; int fr_ = fr, fq_ = fq; asm volatile("" : "+s"(ue.pm), "+s"(ue.pn), "+v"(fr_), "+v"(fq_));
          E(acc, ue, wr, wc, fr_, fq_, lds); }
        if (!has_next) break;
#pragma unroll
        for (int a = 0; a < 2; ++a)
#pragma unroll
            for (int b = 0; b < 2; ++b)
#pragma unroll
                for (int m = 0; m < 4; ++m)
#pragma unroll
                    for (int n = 0; n < 2; ++n) acc[a][b][m][n] = (f32x4){0.f, 0.f, 0.f, 0.f};
        cur = nxt; cA = nA; cB = nB; ++ui;
        if (wr == 1) PG8_BAR;
    }
    PG8_WAIT_V(0);
    PG8_BAR;
#undef PG8_SA
#undef PG8_SB
#undef PG8_STAGE
#undef PG8_LDA
#undef PG8_LDB
#undef PG8_MMA
#undef PG8_WAIT_V
#undef PG8_WAIT_L
#undef PG8_BAR
#undef PG8_SCHED
}
}

namespace att {
#define SBAR() __builtin_amdgcn_sched_barrier(0)
constexpr int RING_BYTES = 139264, OFF_WS = RING_BYTES, OFF_GQ = OFF_WS + 8 * 64 * 4  , ATT_LDS = OFF_GQ + 192 * 4;
template <int N> __device__ __forceinline__ void wait_vm_lgkm0() { asm volatile("s_waitcnt vmcnt(%0) lgkmcnt(0)" :: "n"(N) : "memory"); }
__device__ __forceinline__ int crow(int r, int hi) { return (r & 3) + 8 * (r >> 2) + 4 * hi; }
__device__ __forceinline__ int v_st(int k, int c) { const int kk = (k & ~0xC) | ((k & 4) << 1) | ((k & 8) >> 1); return ((kk >> 3) * 4 + (c >> 5)) * 512 + ((kk & 7) * 32 + (c & 31)) * 2; }
__device__ __forceinline__ int v_rd_base(int lane) { return ((lane & 3) << 3) | (((lane >> 2) & 3) << 6) | (((lane >> 4) & 1) << 5) | (((lane >> 5) & 1) << 8); }
constexpr int v_rd_off(int d0, int ks, int half) { return d0 * 512 + ks * 4096 + half * 2048; }
template <int OFF> __device__ __forceinline__ s16x4 tr_read(int vb) {
    s16x4 r; asm volatile("ds_read_b64_tr_b16 %0, %1 offset:%2" : "=&v"(r) : "v"(vb), "i"(OFF) : "memory"); return r;
}
template <int OFF> __device__ __forceinline__ bf16x8 lds_read128(int base) {
    bf16x8 r; asm volatile("ds_read_b128 %0, %1 offset:%2" : "=&v"(r) : "v"(base), "i"(OFF) : "memory"); return r;
}
template <int N> __device__ __forceinline__ void wait_lgkm() { asm volatile("s_waitcnt lgkmcnt(%0)" :: "n"(N) : "memory"); }
template <int D0> __device__ __forceinline__ void pv_reads(s16x4 (&lo)[4], s16x4 (&hi)[4], int vb) {
    lo[0] = tr_read<v_rd_off(D0, 0, 0)>(vb); hi[0] = tr_read<v_rd_off(D0, 0, 1)>(vb); lo[1] = tr_read<v_rd_off(D0, 1, 0)>(vb); hi[1] = tr_read<v_rd_off(D0, 1, 1)>(vb);
    lo[2] = tr_read<v_rd_off(D0, 2, 0)>(vb); hi[2] = tr_read<v_rd_off(D0, 2, 1)>(vb); lo[3] = tr_read<v_rd_off(D0, 3, 0)>(vb); hi[3] = tr_read<v_rd_off(D0, 3, 1)>(vb);
}
__device__ __forceinline__ void pv_mma(f32x16& od, const s16x4 (&lo)[4], const s16x4 (&hi)[4], bf16x8 pa0, bf16x8 pa1, bf16x8 pa2, bf16x8 pa3) {
#define PK(L, H) (bf16x8){L[0], L[1], L[2], L[3], H[0], H[1], H[2], H[3]}
    od = __builtin_amdgcn_mfma_f32_32x32x16_bf16(pa0, PK(lo[0], hi[0]), od, 0, 0, 0);
    od = __builtin_amdgcn_mfma_f32_32x32x16_bf16(pa1, PK(lo[1], hi[1]), od, 0, 0, 0);
    od = __builtin_amdgcn_mfma_f32_32x32x16_bf16(pa2, PK(lo[2], hi[2]), od, 0, 0, 0);
    od = __builtin_amdgcn_mfma_f32_32x32x16_bf16(pa3, PK(lo[3], hi[3]), od, 0, 0, 0);
#undef PK
}
__device__ __forceinline__ void pv_all(f32x16 (&o)[4], int vb, bf16x8 pa0, bf16x8 pa1, bf16x8 pa2, bf16x8 pa3) {
    s16x4 la[4], ha[4], lb[4], hb[4];
    pv_reads<0>(la, ha, vb);
    pv_reads<1>(lb, hb, vb); wait_lgkm<8>(); SBAR(); pv_mma(o[0], la, ha, pa0, pa1, pa2, pa3); SBAR();
    pv_reads<2>(la, ha, vb); wait_lgkm<8>(); SBAR(); pv_mma(o[1], lb, hb, pa0, pa1, pa2, pa3); SBAR();
    pv_reads<3>(lb, hb, vb); wait_lgkm<8>(); SBAR(); pv_mma(o[2], la, ha, pa0, pa1, pa2, pa3); SBAR();
    wait_lgkm<0>(); SBAR(); pv_mma(o[3], lb, hb, pa0, pa1, pa2, pa3);
}
template <int C> __device__ __forceinline__ void sm_chunk4(const f32x16& P, float& ps, unsigned (&pw)[16]) {
    constexpr int B = (C & 3) * 4;
    const float e0 = __builtin_amdgcn_exp2f(P[B]), e1 = __builtin_amdgcn_exp2f(P[B + 1]), e2 = __builtin_amdgcn_exp2f(P[B + 2]), e3 = __builtin_amdgcn_exp2f(P[B + 3]);
    ps += (e0 + e1) + (e2 + e3);
    pw[2 * C] = cvt_pk_bf16(e0, e1); pw[2 * C + 1] = cvt_pk_bf16(e2, e3);
}
template <int D0, int KH> __device__ __forceinline__ void pv_reads_h(s16x4 (&lo)[2], s16x4 (&hi)[2], int vb) {
    lo[0] = tr_read<v_rd_off(D0, 2 * KH, 0)>(vb); hi[0] = tr_read<v_rd_off(D0, 2 * KH, 1)>(vb); lo[1] = tr_read<v_rd_off(D0, 2 * KH + 1, 0)>(vb); hi[1] = tr_read<v_rd_off(D0, 2 * KH + 1, 1)>(vb);
}
__device__ __forceinline__ void pv_mma_h(f32x16& od, const s16x4 (&lo)[2], const s16x4 (&hi)[2], bf16x8 a, bf16x8 b) {
#define PK(L, H) (bf16x8){L[0], L[1], L[2], L[3], H[0], H[1], H[2], H[3]}
    od = __builtin_amdgcn_mfma_f32_32x32x16_bf16(a, PK(lo[0], hi[0]), od, 0, 0, 0);
    od = __builtin_amdgcn_mfma_f32_32x32x16_bf16(b, PK(lo[1], hi[1]), od, 0, 0, 0);
#undef PK
}
#define ATT_SGB() do { _Pragma("unroll") for (int i_ = 0; i_ < 2; ++i_) { __builtin_amdgcn_sched_group_barrier(0x008, 1, 0); __builtin_amdgcn_sched_group_barrier(0x402, 5, 0); } } while (0)
__device__ __forceinline__ void pv_sm_all(f32x16 (&o)[4], int vb, bf16x8 pa0, bf16x8 pa1, bf16x8 pa2, bf16x8 pa3, const f32x16& p0, const f32x16& p1, float& ps, unsigned (&pw)[16]) {
    s16x4 la[2], ha[2], lb[2], hb[2];
    pv_reads_h<0, 0>(la, ha, vb);
    pv_reads_h<0, 1>(lb, hb, vb); wait_lgkm<4>(); SBAR(); pv_mma_h(o[0], la, ha, pa0, pa1); sm_chunk4<0>(p0, ps, pw); ATT_SGB(); SBAR();
    pv_reads_h<1, 0>(la, ha, vb); wait_lgkm<4>(); SBAR(); pv_mma_h(o[0], lb, hb, pa2, pa3); sm_chunk4<1>(p0, ps, pw); ATT_SGB(); SBAR();
    pv_reads_h<1, 1>(lb, hb, vb); wait_lgkm<4>(); SBAR(); pv_mma_h(o[1], la, ha, pa0, pa1); sm_chunk4<2>(p0, ps, pw); ATT_SGB(); SBAR();
    pv_reads_h<2, 0>(la, ha, vb); wait_lgkm<4>(); SBAR(); pv_mma_h(o[1], lb, hb, pa2, pa3); sm_chunk4<3>(p0, ps, pw); ATT_SGB(); SBAR();
    pv_reads_h<2, 1>(lb, hb, vb); wait_lgkm<4>(); SBAR(); pv_mma_h(o[2], la, ha, pa0, pa1); sm_chunk4<4>(p1, ps, pw); ATT_SGB(); SBAR();
    pv_reads_h<3, 0>(la, ha, vb); wait_lgkm<4>(); SBAR(); pv_mma_h(o[2], lb, hb, pa2, pa3); sm_chunk4<5>(p1, ps, pw); ATT_SGB(); SBAR();
    pv_reads_h<3, 1>(lb, hb, vb); wait_lgkm<4>(); SBAR(); pv_mma_h(o[3], la, ha, pa0, pa1); sm_chunk4<6>(p1, ps, pw); ATT_SGB(); SBAR();
    wait_lgkm<0>(); SBAR(); pv_mma_h(o[3], lb, hb, pa2, pa3); sm_chunk4<7>(p1, ps, pw); ATT_SGB(); SBAR();
}
template <int NKP> struct DmaCtx { LAS char* kdst; LAS char* vdst; size_t kstride, vstride; bool on; };
template <int DQK> __device__ __forceinline__ constexpr int dma_piece_after(int g) { return DQK == 192 ? (((g & 1) && g < 10) ? (g >> 1) : -1) : (g < 3 ? g : -1); }
template <int NKP, int I> __device__ __forceinline__ void dma_piece(const DmaCtx<NKP>& dc, const gbf16_t* (&kp1)[NKP], const gbf16_t* (&vp1)[2], int wid) {
    if (dc.on) {
        if constexpr (I < NKP) { __builtin_amdgcn_global_load_lds((const gunsigned*)kp1[I], (LAS unsigned*)(dc.kdst + (wid + 8 * I) * 1024), 16, 0, 0); kp1[I] += dc.kstride; }
        else { __builtin_amdgcn_global_load_lds((const gunsigned*)vp1[I - NKP], (LAS unsigned*)(dc.vdst + (wid + 8 * (I - NKP)) * 1024), 16, 0, 0); vp1[I - NKP] += dc.vstride; }
    }
}
template <int DQK, int G, int NKP> __device__ __forceinline__ void qk_step(f32x16& p0, f32x16& p1, bf16x8 (&kf)[2][2], const int (&kb)[4], const bf16x8 (&qr)[DQK / 16],
                                                                           const DmaCtx<NKP>& dc, const gbf16_t* (&kp1)[NKP], const gbf16_t* (&vp1)[2], int wid) {
    constexpr int ND = DQK / 16, RB = DQK * 2;
    if constexpr (G + 1 < ND) { kf[(G + 1) & 1][0] = lds_read128<((G + 1) >> 2) * 128>(kb[(G + 1) & 3]); kf[(G + 1) & 1][1] = lds_read128<((G + 1) >> 2) * 128 + 32 * RB>(kb[(G + 1) & 3]); wait_lgkm<2>(); }
    else { wait_lgkm<0>(); }
    SBAR();
    p0 = __builtin_amdgcn_mfma_f32_32x32x16_bf16(kf[G & 1][0], qr[G], p0, 0, 0, 0); p1 = __builtin_amdgcn_mfma_f32_32x32x16_bf16(kf[G & 1][1], qr[G], p1, 0, 0, 0);
    SBAR();
    if constexpr (dma_piece_after<DQK>(G) >= 0) { dma_piece<NKP, dma_piece_after<DQK>(G)>(dc, kp1, vp1, wid); SBAR(); }
    if constexpr (G + 1 < ND) qk_step<DQK, G + 1, NKP>(p0, p1, kf, kb, qr, dc, kp1, vp1, wid);
}
template <int DQK, int NKP> __device__ __forceinline__ void qkt_tile_n(f32x16& p0, f32x16& p1, const int (&kb)[4], const bf16x8 (&qr)[DQK / 16],
                                                                      const DmaCtx<NKP>& dc, const gbf16_t* (&kp1)[NKP], const gbf16_t* (&vp1)[2], int wid) {
    p0 = f32x16{}; p1 = f32x16{};
    bf16x8 kf[2][2];
    SBAR(); kf[0][0] = lds_read128<0>(kb[0]); kf[0][1] = lds_read128<32 * DQK * 2>(kb[0]);
    qk_step<DQK, 0, NKP>(p0, p1, kf, kb, qr, dc, kp1, vp1, wid);
}
template <int RB, int G> __device__ __forceinline__ void k_reads(bf16x8 (&dst)[4], const int (&kb)[4]) {
    dst[0] = lds_read128<((2 * G) >> 2) * 128>(kb[(2 * G) & 3]);         dst[1] = lds_read128<((2 * G) >> 2) * 128 + 32 * RB>(kb[(2 * G) & 3]);
    dst[2] = lds_read128<((2 * G + 1) >> 2) * 128>(kb[(2 * G + 1) & 3]); dst[3] = lds_read128<((2 * G + 1) >> 2) * 128 + 32 * RB>(kb[(2 * G + 1) & 3]);
}
template <int DQK, int G> __device__ __forceinline__ void qk_group(f32x16& p0, f32x16& p1, bf16x8 (&kf)[2][4], const int (&kb)[4], const bf16x8 (&qr)[DQK / 16]) {
    constexpr int NG = DQK / 32, RB = DQK * 2;
    if constexpr (G + 1 < NG) { k_reads<RB, G + 1>(kf[(G + 1) & 1], kb); wait_lgkm<4>(); } else { wait_lgkm<0>(); }
    SBAR();
    p0 = __builtin_amdgcn_mfma_f32_32x32x16_bf16(kf[G & 1][0], qr[2 * G], p0, 0, 0, 0);     p1 = __builtin_amdgcn_mfma_f32_32x32x16_bf16(kf[G & 1][1], qr[2 * G], p1, 0, 0, 0);
    p0 = __builtin_amdgcn_mfma_f32_32x32x16_bf16(kf[G & 1][2], qr[2 * G + 1], p0, 0, 0, 0); p1 = __builtin_amdgcn_mfma_f32_32x32x16_bf16(kf[G & 1][3], qr[2 * G + 1], p1, 0, 0, 0);
    SBAR();
    if constexpr (G + 1 < NG) qk_group<DQK, G + 1>(p0, p1, kf, kb, qr);
}
template <int DQK> __device__ __forceinline__ void qkt_tile(f32x16& p0, f32x16& p1, const int (&kb)[4], const bf16x8 (&qr)[DQK / 16]) {
    p0 = f32x16{}; p1 = f32x16{};
    if constexpr (false && DQK == 64) {
        bf16x8 kf[4];
        SBAR(); k_reads<128, 0>(kf, kb); wait_lgkm<0>(); SBAR();
        p0 = __builtin_amdgcn_mfma_f32_32x32x16_bf16(kf[0], qr[0], p0, 0, 0, 0); p1 = __builtin_amdgcn_mfma_f32_32x32x16_bf16(kf[1], qr[0], p1, 0, 0, 0);
        p0 = __builtin_amdgcn_mfma_f32_32x32x16_bf16(kf[2], qr[1], p0, 0, 0, 0); p1 = __builtin_amdgcn_mfma_f32_32x32x16_bf16(kf[3], qr[1], p1, 0, 0, 0);
        SBAR(); k_reads<128, 1>(kf, kb); wait_lgkm<0>(); SBAR();
        p0 = __builtin_amdgcn_mfma_f32_32x32x16_bf16(kf[0], qr[2], p0, 0, 0, 0); p1 = __builtin_amdgcn_mfma_f32_32x32x16_bf16(kf[1], qr[2], p1, 0, 0, 0);
        p0 = __builtin_amdgcn_mfma_f32_32x32x16_bf16(kf[2], qr[3], p0, 0, 0, 0); p1 = __builtin_amdgcn_mfma_f32_32x32x16_bf16(kf[3], qr[3], p1, 0, 0, 0);
        SBAR();
    } else {
        bf16x8 kf[2][4];
        SBAR(); k_reads<DQK * 2, 0>(kf[0], kb);
        qk_group<DQK, 0>(p0, p1, kf, kb, qr);
    }
}
__device__ __forceinline__ int key_row(int b, int p) { p = p < LSEQ ? p : LSEQ - 1; return p < NMETA ? NREAL + p : b * SEQ + p - NMETA; }

constexpr float THR = 6.0f;
constexpr float SCORE_BOUND_OK = 64.0f;
template <int DQK, bool QXF = false, bool NOMAX = false>
__device__ __forceinline__ void attn_map(const gbf16_t* __restrict__ Qp, int ldq, const gbf16_t* __restrict__ Kp, int ldk, const gbf16_t* __restrict__ Vp, int ldv,
                                         int b, int qpos0, int NT, f32x16 (&o)[4], float& l_out, LAS char* lds, void* probe_ptr = nullptr,
                                         const gfloat* gq = nullptr, const gfloat* COS = nullptr, const gfloat* SIN = nullptr) {
    constexpr int RB = DQK * 2, ND = DQK / 16, NKP = (64 * RB / 1024) / 8;
    constexpr int KSLOT = 64 * RB, DEPTH_ = DQK == 192 ? 2 : 4, NKS = DEPTH_ + 1, NVS = DEPTH_ + 2, NP = NKP + 2, OFF_K = 0, OFF_V = NKS * KSLOT;
    static_assert(OFF_V + NVS * 16384 <= RING_BYTES, "attention rings");
    int tid_ = threadIdx.x; asm volatile("" : "+v"(tid_));
    const int tid = tid_, wid = __builtin_amdgcn_readfirstlane(tid >> 6), lane = tid & 63, r32 = lane & 31, hi = lane >> 5;
    LAS char* K_lds = lds + OFF_K; LAS char* V_lds = lds + OFF_V; LAS float* al_l = (LAS float*)(lds + OFF_WS) + wid * 64;
    bf16x8 qr[ND];
    const int qpos = qpos0 + wid * 32 + r32, wq_min = qpos0 + wid * 32, wq_max = wq_min + 31;
    if constexpr (!QXF) {
        const gbf16_t* Qw = Qp + (size_t)(wid * 32 + r32) * ldq + hi * 8;
#pragma unroll
        for (int d0 = 0; d0 < ND; ++d0) qr[d0] = *(const gbf16x8*)(Qw + d0 * 16);
    } else {
        static_assert(DQK == 192, "QXF is the MLA q transform");
        f32x4 cv[2][2], sv[2][2];
        { const gbf16_t* Qw = Qp + (size_t)(wid * 32 + r32) * ldq + hi * 8;
#pragma unroll
          for (int d0 = 0; d0 < ND; ++d0) qr[d0] = *(const gbf16x8*)(Qw + d0 * 16);
#pragma unroll
          for (int p = 0; p < 2; ++p) { cv[p][0] = *(const gf32x4*)(COS + qpos * 32 + 16 * p + 8 * hi); cv[p][1] = *(const gf32x4*)(COS + qpos * 32 + 16 * p + 8 * hi + 4);
              sv[p][0] = *(const gf32x4*)(SIN + qpos * 32 + 16 * p + 8 * hi); sv[p][1] = *(const gf32x4*)(SIN + qpos * 32 + 16 * p + 8 * hi + 4); } }
        SBAR();
        const LAS float* gl = (const LAS float*)(lds + OFF_GQ) + 8 * hi;
        float ssq = 0.f;
#pragma unroll
        for (int d0 = 0; d0 < ND; ++d0)
#pragma unroll
            for (int e = 0; e < 8; ++e) { const float x = bf2f((unsigned)(unsigned short)qr[d0][e]); ssq += x * x; }
        { auto rr = __builtin_amdgcn_permlane32_swap(__float_as_uint(ssq), __float_as_uint(ssq), false, false); ssq = __uint_as_float(rr[0]) + __uint_as_float(rr[1]); }
        const float r = CA / sqrtf(ssq * (1.0f / 192.0f) + EPS);
#pragma unroll
        for (int d0 = 0; d0 < 8; ++d0) { const f32x4 ga = *(const LAS f32x4*)(gl + 16 * d0), gb = *(const LAS f32x4*)(gl + 16 * d0 + 4);
            const u32x4 w = {cvt_pk_bf16(bf2f((unsigned)(unsigned short)qr[d0][0]) * r * ga[0], bf2f((unsigned)(unsigned short)qr[d0][1]) * r * ga[1]), cvt_pk_bf16(bf2f((unsigned)(unsigned short)qr[d0][2]) * r * ga[2], bf2f((unsigned)(unsigned short)qr[d0][3]) * r * ga[3]),
                             cvt_pk_bf16(bf2f((unsigned)(unsigned short)qr[d0][4]) * r * gb[0], bf2f((unsigned)(unsigned short)qr[d0][5]) * r * gb[1]), cvt_pk_bf16(bf2f((unsigned)(unsigned short)qr[d0][6]) * r * gb[2], bf2f((unsigned)(unsigned short)qr[d0][7]) * r * gb[3])};
            qr[d0] = __builtin_bit_cast(bf16x8, w); }
#pragma unroll
        for (int p = 0; p < 2; ++p) {
            const int da = 8 + p, db = 10 + p; float ya[8], yb[8], cs[8], sn[8];
            { const f32x4 ga = *(const LAS f32x4*)(gl + 16 * da), gb = *(const LAS f32x4*)(gl + 16 * da + 4), gc = *(const LAS f32x4*)(gl + 16 * db), gd = *(const LAS f32x4*)(gl + 16 * db + 4);
#pragma unroll
              for (int e = 0; e < 4; ++e) { ya[e] = bf2f((unsigned)(unsigned short)qr[da][e]) * r * ga[e]; ya[4 + e] = bf2f((unsigned)(unsigned short)qr[da][4 + e]) * r * gb[e];
                  yb[e] = bf2f((unsigned)(unsigned short)qr[db][e]) * r * gc[e]; yb[4 + e] = bf2f((unsigned)(unsigned short)qr[db][4 + e]) * r * gd[e];
                  cs[e] = cv[p][0][e]; cs[4 + e] = cv[p][1][e]; sn[e] = sv[p][0][e]; sn[4 + e] = sv[p][1][e]; } }
            u32x4 wa, wb;
#pragma unroll
            for (int e = 0; e < 4; ++e) { wa[e] = cvt_pk_bf16(ya[2 * e] * cs[2 * e] - yb[2 * e] * sn[2 * e], ya[2 * e + 1] * cs[2 * e + 1] - yb[2 * e + 1] * sn[2 * e + 1]);
                wb[e] = cvt_pk_bf16(yb[2 * e] * cs[2 * e] + ya[2 * e] * sn[2 * e], yb[2 * e + 1] * cs[2 * e + 1] + ya[2 * e + 1] * sn[2 * e + 1]); }
            qr[da] = __builtin_bit_cast(bf16x8, wa); qr[db] = __builtin_bit_cast(bf16x8, wb); }
    }
    float m_reg = -1e30f, l_reg = 0.f;
#pragma unroll
    for (int d = 0; d < 4; ++d) o[d] = f32x16{};
    const int vb0 = (int)(unsigned)(uintptr_t)V_lds + v_rd_base(lane);
    int NTw = wq_max / 64 + 1; NTw = NTw < NT ? NTw : NT;
    const int jb = wq_min / 64;
    int kb4[4];
#pragma unroll
    for (int i = 0; i < 4; ++i) kb4[i] = r32 * RB + (((i * 2 + hi) ^ ((r32 >> 1) & 7)) << 4);
    const gbf16_t* kp1[NKP]; const gbf16_t* vp1[2]; const gbf16_t* kp0[NKP]; const gbf16_t* vp0[2];
#pragma unroll
    for (int i = 0; i < NKP; ++i) { const int L = (wid + 8 * i) * 1024 + 16 * lane, row = L / RB, within = L % RB, col = ((within ^ (((row >> 1) & 7) << 4)) >> 4) * 8;
        kp0[i] = Kp + (size_t)key_row(b, row) * ldk + col; kp1[i] = Kp + (size_t)(b * SEQ + 64 - NMETA + row) * ldk + col; }
#pragma unroll
    for (int i = 0; i < 2; ++i) { const int L = (wid + 8 * i) * 1024 + 16 * lane, sub = L >> 9, rem = L & 511, kk = (sub >> 2) * 8 + (rem >> 6);
        const int k = kk, col = (sub & 3) * 32 + ((rem & 63) >> 1);
        vp0[i] = Vp + (size_t)key_row(b, k) * ldv + col; vp1[i] = Vp + (size_t)(b * SEQ + 64 - NMETA + k) * ldv + col; }
    const size_t kstride = (size_t)64 * ldk, vstride = (size_t)64 * ldv;
#define ATT_DMA0() do { \
        _Pragma("unroll") for (int i_ = 0; i_ < NKP; ++i_) __builtin_amdgcn_global_load_lds((const gunsigned*)kp0[i_], (LAS unsigned*)(K_lds + (wid + 8 * i_) * 1024), 16, 0, 0); \
        _Pragma("unroll") for (int i_ = 0; i_ < 2; ++i_) __builtin_amdgcn_global_load_lds((const gunsigned*)vp0[i_], (LAS unsigned*)(V_lds + (wid + 8 * i_) * 1024), 16, 0, 0); } while (0)
#define ATT_DMA(j) do { const int ks_ = ((j) % NKS) * KSLOT, vs_ = ((j) % NVS) * 16384; \
        _Pragma("unroll") for (int i_ = 0; i_ < NKP; ++i_) { __builtin_amdgcn_global_load_lds((const gunsigned*)kp1[i_], (LAS unsigned*)(K_lds + ks_ + (wid + 8 * i_) * 1024), 16, 0, 0); kp1[i_] += kstride; } \
        _Pragma("unroll") for (int i_ = 0; i_ < 2; ++i_) { __builtin_amdgcn_global_load_lds((const gunsigned*)vp1[i_], (LAS unsigned*)(V_lds + vs_ + (wid + 8 * i_) * 1024), 16, 0, 0); vp1[i_] += vstride; } } while (0)
#define ATT_BAR(j) do { int c_ = ((j) + DEPTH_ - 1 < NT - 1 ? (j) + DEPTH_ - 1 : NT - 1) - (j); c_ = c_ < 0 ? 0 : c_; \
        if (c_ == 0) wait_vm_lgkm0<0>(); else if (c_ == 1) wait_vm_lgkm0<NP>(); else if (c_ == 2) wait_vm_lgkm0<2 * NP>(); else wait_vm_lgkm0<3 * NP>(); \
        __builtin_amdgcn_s_barrier(); asm volatile("" ::: "memory"); } while (0)
#define ATT_QKT(P0, P1, j) do { const int ko_ = (int)(unsigned)(uintptr_t)K_lds + ((j) % NKS) * KSLOT; int kbs_[4]; \
        _Pragma("unroll") for (int i_ = 0; i_ < 4; ++i_) kbs_[i_] = ko_ + kb4[i_]; \
        qkt_tile<DQK>(P0, P1, kbs_, qr); } while (0)
#define ATT_PARTIAL(P0, P1, AL, j, MASK) do { \
        if (MASK) { const int d_ = qpos - 64 * (j) - 4 * hi; _Pragma("unroll") for (int r = 0; r < 16; ++r) { if ((r & 3) + 8 * (r >> 2) > d_) P0[r] = -1e30f; if ((r & 3) + 8 * (r >> 2) + 32 > d_) P1[r] = -1e30f; } } \
        float pmax = P0[0]; _Pragma("unroll") for (int r = 1; r < 16; ++r) pmax = fmaxf(pmax, P0[r]); _Pragma("unroll") for (int r = 0; r < 16; ++r) pmax = fmaxf(pmax, P1[r]); \
        { auto rr = __builtin_amdgcn_permlane32_swap(__float_as_uint(pmax), __float_as_uint(pmax), false, false); pmax = fmaxf(__uint_as_float(rr[0]), __uint_as_float(rr[1])); } \
        if (__builtin_expect(__all(pmax - m_reg <= THR), 1)) { AL = 1.f; } else { const float mn = fmaxf(m_reg, pmax); AL = __builtin_amdgcn_exp2f(m_reg - mn); m_reg = mn; } \
        _Pragma("unroll") for (int r = 0; r < 16; ++r) { P0[r] = __builtin_amdgcn_exp2f(P0[r] - m_reg); P1[r] = P1[r] - m_reg; } } while (0)
#define ATT_RESC(AL) do { if (__any((AL) < 1.f)) { if (hi == 0) al_l[r32] = (AL); LDS_WAIT(); \
        _Pragma("unroll") for (int r = 0; r < 16; ++r) { const float a_ = al_l[crow(r, hi)]; _Pragma("unroll") for (int d = 0; d < 4; ++d) o[d][r] *= a_; } } } while (0)
#define ATT_PK4(P, BASE, OUT) do { u32x4 w = {cvt_pk_bf16(P[BASE + 0], P[BASE + 1]), cvt_pk_bf16(P[BASE + 2], P[BASE + 3]), cvt_pk_bf16(P[BASE + 4], P[BASE + 5]), cvt_pk_bf16(P[BASE + 6], P[BASE + 7])}; \
        OUT = __builtin_bit_cast(bf16x8, w); } while (0)
#define ATT_FINISH(P0, P1, AL) do { _Pragma("unroll") for (int r = 0; r < 16; ++r) P1[r] = __builtin_amdgcn_exp2f(P1[r]); \
        float ps = 0.f; _Pragma("unroll") for (int r = 0; r < 16; ++r) ps += P0[r] + P1[r]; \
        { auto rr = __builtin_amdgcn_permlane32_swap(__float_as_uint(ps), __float_as_uint(ps), false, false); ps = __uint_as_float(rr[0]) + __uint_as_float(rr[1]); } \
        l_reg = l_reg * (AL) + ps; ATT_PK4(P0, 0, pa0); ATT_PK4(P0, 8, pa1); ATT_PK4(P1, 0, pa2); ATT_PK4(P1, 8, pa3); } while (0)
#define ATT_PV(j) do { const int vb_ = vb0 + ((j) % NVS) * 16384; pv_all(o, vb_, pa0, pa1, pa2, pa3); } while (0)
    f32x16 p0 = f32x16{}, p1 = f32x16{}; float al = 1.f; bf16x8 pa0, pa1, pa2, pa3;
#define ATT_MASKONLY(P0, P1, j) do { const int d_ = qpos - 64 * (j) - 4 * hi; _Pragma("unroll") for (int r = 0; r < 16; ++r) { if ((r & 3) + 8 * (r >> 2) > d_) P0[r] = -1e30f; if ((r & 3) + 8 * (r >> 2) + 32 > d_) P1[r] = -1e30f; } } while (0)
#define ATT_SMPV(jj) do { if constexpr (NOMAX) { if ((jj) >= jb) ATT_MASKONLY(p0, p1, jj); \
            _Pragma("unroll") for (int r = 0; r < 16; ++r) p0[r] = __builtin_amdgcn_exp2f(p0[r]); ATT_FINISH(p0, p1, 1.0f); } \
        else { if ((jj) >= jb) { ATT_PARTIAL(p0, p1, al, jj, true); } else { ATT_PARTIAL(p0, p1, al, jj, false); } ATT_RESC(al); ATT_FINISH(p0, p1, al); } \
        SBAR(); ATT_PV(jj); } while (0)
    const bool groupA = wid < 4;
    __syncthreads();
    ATT_DMA0();
#pragma unroll
    for (int t = 1; t < DEPTH_; ++t) if (t < NT) ATT_DMA(t);
#if defined(PROBE_T)
    const bool prb = (blockIdx.x == PROBE_BLK) && (wid == PROBE_WAVE);
    unsigned long long tb = 0, tq = 0, ts = 0, t0_ = __builtin_amdgcn_s_memtime();
#define PT_BEG() unsigned long long t1_ = 0; if (prb) { __builtin_amdgcn_sched_barrier(0); t1_ = __builtin_amdgcn_s_memtime(); __builtin_amdgcn_sched_barrier(0); }
#define PT_END(acc) if (prb) { __builtin_amdgcn_sched_barrier(0); asm volatile("s_waitcnt lgkmcnt(0)" ::: "memory"); acc += __builtin_amdgcn_s_memtime() - t1_; __builtin_amdgcn_sched_barrier(0); }
#else
#define PT_BEG()
#define PT_END(acc)
#endif
    if constexpr (NOMAX) {
        unsigned pw[16];
        static_assert(NP == (DQK == 192 ? 5 : 3), "dma_piece_after() places exactly NP pieces");
#define ATT_QKT_N(j) do { const int ko_ = (int)(unsigned)(uintptr_t)K_lds + ((j) % NKS) * KSLOT; int kbs_[4]; \
        _Pragma("unroll") for (int i_ = 0; i_ < 4; ++i_) kbs_[i_] = ko_ + kb4[i_]; \
        DmaCtx<NKP> dc_; dc_.kdst = K_lds + (((j) + DEPTH_) % NKS) * KSLOT; dc_.vdst = V_lds + (((j) + DEPTH_) % NVS) * 16384; dc_.kstride = kstride; dc_.vstride = vstride; dc_.on = (j) + DEPTH_ < NT; \
        qkt_tile_n<DQK, NKP>(p0, p1, kbs_, qr, dc_, kp1, vp1, wid); } while (0)
#define ATT_PW2PA() do { pa0 = __builtin_bit_cast(bf16x8, (u32x4){pw[0], pw[1], pw[2], pw[3]}); pa1 = __builtin_bit_cast(bf16x8, (u32x4){pw[4], pw[5], pw[6], pw[7]}); \
        pa2 = __builtin_bit_cast(bf16x8, (u32x4){pw[8], pw[9], pw[10], pw[11]}); pa3 = __builtin_bit_cast(bf16x8, (u32x4){pw[12], pw[13], pw[14], pw[15]}); } while (0)
#define ATT_LSUM(ps_) do { auto rr = __builtin_amdgcn_permlane32_swap(__float_as_uint(ps_), __float_as_uint(ps_), false, false); ps_ = __uint_as_float(rr[0]) + __uint_as_float(rr[1]); } while (0)
        {
            ATT_BAR(0);
            ATT_QKT_N(0);
            if (0 >= jb) ATT_MASKONLY(p0, p1, 0);
            float ps = 0.f;
            sm_chunk4<0>(p0, ps, pw); sm_chunk4<1>(p0, ps, pw); sm_chunk4<2>(p0, ps, pw); sm_chunk4<3>(p0, ps, pw); sm_chunk4<4>(p1, ps, pw); sm_chunk4<5>(p1, ps, pw); sm_chunk4<6>(p1, ps, pw); sm_chunk4<7>(p1, ps, pw);
            ATT_LSUM(ps); l_reg = ps; ATT_PW2PA();
        }
        for (int j = 1; j < NT; ++j) {
            ATT_BAR(j);
            if (j >= NTw && j + DEPTH_ < NT) ATT_DMA(j + DEPTH_);
            if (j <= NTw) {
                if (j < NTw) { ATT_QKT_N(j); if (j >= jb) ATT_MASKONLY(p0, p1, j); }
                float ps = 0.f;
                { const int vb_ = vb0 + ((j - 1) % NVS) * 16384; pv_sm_all(o, vb_, pa0, pa1, pa2, pa3, p0, p1, ps, pw); }
                ATT_LSUM(ps); l_reg += (j < NTw) ? ps : 0.f; ATT_PW2PA();
            }
        }
        if (NTw == NT) { SBAR(); ATT_PV(NT - 1); }
#undef ATT_QKT_N
#undef ATT_PW2PA
#undef ATT_LSUM
    } else {
    for (int j = 0; j < NT; ++j) {
        if (groupA) { { PT_BEG(); ATT_BAR(j); PT_END(tb); } if (j + DEPTH_ < NT) ATT_DMA(j + DEPTH_); }
        if (j >= 1 && j - 1 < NTw) { PT_BEG(); ATT_SMPV(j - 1); PT_END(ts); }
        if (!groupA) { { PT_BEG(); ATT_BAR(j); PT_END(tb); } if (j + DEPTH_ < NT) ATT_DMA(j + DEPTH_); }
        if (j < NTw) { PT_BEG(); ATT_QKT(p0, p1, j); PT_END(tq); }
    }
#if defined(PROBE_T)
    if (prb && lane == 0) { unsigned long long* pt = (unsigned long long*)(probe_ptr); pt[0] += __builtin_amdgcn_s_memtime() - t0_; pt[1] += tb; pt[2] += tq; pt[3] += ts; }
#endif
    if (NTw == NT) ATT_SMPV(NT - 1);
    }
#undef ATT_SMPV
#undef ATT_MASKONLY
#undef ATT_DMA
#undef ATT_DMA0
#undef ATT_BAR
#undef ATT_QKT
#undef ATT_PARTIAL
#undef ATT_RESC
#undef ATT_PK4
#undef ATT_FINISH
#undef ATT_PV
    l_out = l_reg;
}
__device__ __forceinline__ void row_recip(float l, float (&rli)[16], LAS char* lds, int wid, int r32, int hi) {
    LAS float* li_l = (LAS float*)(lds + OFF_WS) + wid * 64 + 32;
    if (hi == 0) li_l[r32] = l;
    LDS_WAIT();
#pragma unroll
    for (int r = 0; r < 16; ++r) rli[r] = __builtin_amdgcn_rcpf(li_l[crow(r, hi)]);
    LDS_WAIT();
}
#undef SBAR
}


#define XB_TMO      128
#define XB_XCNT(j)  (256  + 64 * (j))
#define XB_XSUB(j)  (1280 + 64 * (j))
#define XB_XGEN(j)  (2304 + 64 * (j))
#define XB_TOP      3328
#define XB_TOPGEN   3392
#define XCD_BAR_WORDS 3456
#define XB_SPIN_CAP (1u << 18)
__device__ __forceinline__ unsigned xb_ld(unsigned* p)              { return __hip_atomic_load(p, __ATOMIC_RELAXED, __HIP_MEMORY_SCOPE_AGENT); }
__device__ __forceinline__ unsigned xb_add(unsigned* p, unsigned v) { return __hip_atomic_fetch_add(p, v, __ATOMIC_RELAXED, __HIP_MEMORY_SCOPE_AGENT); }
__device__ __forceinline__ unsigned xb_xcc_id() { return (unsigned)__builtin_amdgcn_s_getreg((3 << 11) | 20) & 0xFu; }
#define XB_SPIN(cond, bar) do { unsigned _sp = 0; while (cond) { __builtin_amdgcn_s_sleep(1); \
    if ((++_sp & 255u) == 0u) { if (xb_ld(&(bar)[XB_TMO])) break; if (_sp > XB_SPIN_CAP) { atomicAdd(&(bar)[XB_TMO], 1u); break; } } } } while (0)
struct XcdBarrier { unsigned* bar; unsigned x; volatile LAS unsigned* st; };
__device__ __forceinline__ XcdBarrier xcd_barrier_post(unsigned* bar, volatile LAS unsigned* st) {
    XcdBarrier b; b.bar = bar; b.x = xb_xcc_id(); b.st = st;
    if (threadIdx.x == 0) (void)xb_add(&bar[XB_XCNT(b.x)], 1u);
    return b;
}
__device__ __forceinline__ void xcd_barrier_complete(unsigned* bar, unsigned x, unsigned& nloc, unsigned& nx) {
    const unsigned G = gridDim.x * gridDim.y * gridDim.z;
    unsigned sum, cnt, mine, sp = 0u;
    for (;;) {
        sum = 0u; cnt = 0u; mine = 0u;
#pragma unroll
        for (unsigned j = 0; j < 16; ++j) { const unsigned c = xb_ld(&bar[XB_XCNT(j)]); sum += c; cnt += (c > 0u) ? 1u : 0u; mine = (j == x) ? c : mine; }
        if (sum == G) break;
        __builtin_amdgcn_s_sleep(1);
        if ((++sp & 255u) == 0u) { if (xb_ld(&bar[XB_TMO])) break; if (sp > XB_SPIN_CAP) { atomicAdd(&bar[XB_TMO], 1u); break; } }
    }
    nloc = mine > 0u ? mine : 1u; nx = cnt > 0u ? cnt : 1u;
}
__device__ __forceinline__ void xcd_barrier(const XcdBarrier& b) {
    asm volatile("s_waitcnt vmcnt(0)" ::: "memory");
    __syncthreads();
    if (threadIdx.x == 0) {
        unsigned* bar = b.bar;
        __builtin_amdgcn_s_waitcnt(0);
        unsigned nloc = b.st[0], nx = b.st[1];
        if (nloc == 0u) { xcd_barrier_complete(bar, b.x, nloc, nx); b.st[0] = nloc; b.st[1] = nx; }
        const unsigned old = xb_add(&bar[XB_XSUB(b.x)], 1u);
        const unsigned gen = old / nloc;
        if (old + 1u == (gen + 1u) * nloc) {
            __builtin_amdgcn_fence(__ATOMIC_RELEASE, "agent");
            asm volatile("s_waitcnt vmcnt(0)" ::: "memory");
            const unsigned og = xb_add(&bar[XB_TOP], 1u);
            const unsigned tg = og / nx;
            if (og + 1u == (tg + 1u) * nx) xb_add(&bar[XB_TOPGEN], 1u);
            else XB_SPIN(xb_ld(&bar[XB_TOPGEN]) == tg, bar);
            __builtin_amdgcn_fence(__ATOMIC_ACQUIRE, "agent");
            xb_add(&bar[XB_XGEN(b.x)], 1u);
            asm volatile("s_waitcnt vmcnt(0)" ::: "memory");
        } else {
            XB_SPIN(xb_ld(&bar[XB_XGEN(b.x)]) == gen, bar);
            __builtin_amdgcn_fence(__ATOMIC_ACQUIRE, "agent");
            asm volatile("s_waitcnt vmcnt(0)" ::: "memory");
        }
    }
    __syncthreads();
}

struct Params { const float* in[21]; float* out; unsigned char* ws; int s_lo, s_hi; };
struct DParams { const gfloat* in[21]; gfloat* out; guchar* ws; int s_lo, s_hi; };
enum { I_X = 0, I_META, I_ATTN_NORM, I_W_IN, I_QA_NORM, I_W_Q_UP, I_KVA_NORM, I_W_KV_UP, I_Q_NORM, I_K_NORM, I_DQ_NORM, I_DK_NORM, I_LQ1, I_LK1, I_LQ2, I_LK2, I_SUBLN, I_W_O, I_FFN_NORM,
       I_W_GU, I_W_D };
constexpr int LDS_BYTES = 149504;
constexpr int NTHREADS = 512, NWAVES = 8;

struct Frame {
    LAS unsigned char* lds; DParams p; int tid, lane, wave, vcu, G, gw, ngw;
};

__device__ __forceinline__ void transpose_item(const gfloat* W, int ldw, int Ksrc, const gfloat* gain, gbf16_t* WT, int Kd, int k0, int sc0, int dr0, LAS float* scr, int lane) {
    const bool zero = (sc0 < 0) || (k0 >= Ksrc);
    const int c = lane & 7;
    if (zero) {
#pragma unroll
        for (int j = 0; j < 4; ++j) { const int n = (lane >> 3) + 8 * j; *(gu32x4*)(WT + (size_t)(dr0 + n) * Kd + k0 + 8 * c) = (u32x4){0u, 0u, 0u, 0u}; }
        return;
    }
    f32x4 wv[8]; const int kr_ = lane >> 3, nq_ = (lane & 7) * 4;
#pragma unroll
    for (int i = 0; i < 8; ++i) wv[i] = __builtin_nontemporal_load((const gf32x4*)(W + (size_t)(k0 + 8 * i + kr_) * ldw + sc0 + nq_));
    if (gain) {
#pragma unroll
        for (int i = 0; i < 8; ++i) wv[i] = wv[i] * gain[k0 + 8 * i + kr_]; }
#pragma unroll
    for (int i = 0; i < 8; ++i) { LAS float* d = scr + (8 * i + kr_) * 33 + nq_; d[0] = wv[i][0]; d[1] = wv[i][1]; d[2] = wv[i][2]; d[3] = wv[i][3]; }
    LDS_WAIT(); asm volatile("" ::: "memory");
#pragma unroll
    for (int j = 0; j < 4; ++j) { const int n = (lane >> 3) + 8 * j; const LAS float* s = scr + (8 * c) * 33 + n;
        u32x4 o; o.x = pk2(s[0 * 33], s[1 * 33]); o.y = pk2(s[2 * 33], s[3 * 33]); o.z = pk2(s[4 * 33], s[5 * 33]); o.w = pk2(s[6 * 33], s[7 * 33]);
        *(gu32x4*)(WT + (size_t)(dr0 + n) * Kd + k0 + 8 * c) = o; }
    LDS_WAIT(); asm volatile("" ::: "memory");
}
constexpr int IT_IN = 16 * 64, IT_Q = 4 * 32, IT_KV = 4 * 32, IT_O = 16 * 32, IT_GU = 16 * 176, IT_D = 44 * 32, IT_L = IT_IN + IT_Q + IT_KV + IT_O + IT_GU + IT_D;
__device__ __forceinline__ void prep_transpose(Frame& F, int it, LAS float* scr) {
    const DParams& P = F.p;
        const int l = it / IT_L; int r = it % IT_L;
        gbf16_t* wb = (gbf16_t*)(P.ws + WS_W + (size_t)l * W_LAYER);
        if (r < IT_IN) { const int kb = r / 64, g = r % 64; int sc0;
            if (g < 14) sc0 = 32 * g;
            else if (g < 16) sc0 = -1;
            else if (g < 48) { const int tile = g >> 3, p32 = g & 7, bj = p32 >> 2, wcc = p32 & 3;
                sc0 = (tile < 4 ? SRC_DQ + (tile - 2) * 256 : SRC_DK + (tile - 4) * 256) + 64 * wcc + 32 * bj; }
            else sc0 = SRC_DV + 32 * (g - 48);
            transpose_item(P.in[I_W_IN] + (size_t)l * DM * INW, INW, DM, P.in[I_ATTN_NORM] + l * DM, (gbf16_t*)((gchar*)wb + W_IN), DM, kb * 64, sc0, 32 * g, scr, F.lane); return; }
        r -= IT_IN;
        if (r < IT_Q) { const int kb = r / 32, g = r % 32, h = g >> 3, d0 = (g & 7) * 32;
            transpose_item(P.in[I_W_Q_UP] + (size_t)l * 256 * 768, 768, 256, P.in[I_QA_NORM] + l * 256, (gbf16_t*)((gchar*)wb + W_Q), 256, kb * 64, d0 < 192 ? h * 192 + d0 : -1, 32 * g, scr, F.lane); return; }
        r -= IT_Q;
        if (r < IT_KV) { const int kb = r / 32, g = r % 32;
            transpose_item(P.in[I_W_KV_UP] + (size_t)l * 128 * 1024, 1024, 128, P.in[I_KVA_NORM] + l * 128, (gbf16_t*)((gchar*)wb + W_KV), 256, kb * 64, 32 * g, 32 * g, scr, F.lane); return; }
        r -= IT_KV;
        if (r < IT_O) { const int kb = r / 32, g = r % 32;
            transpose_item(P.in[I_W_O] + (size_t)l * DM * DM, DM, DM, nullptr, (gbf16_t*)((gchar*)wb + W_O), DM, kb * 64, 32 * g, 32 * g, scr, F.lane); return; }
        r -= IT_O;
        if (r < IT_GU) { const int kb = r / 176, g = r % 176, pn = g >> 3, half = (g & 7) >> 2, i0 = (g & 3) * 32;
            transpose_item(P.in[I_W_GU] + (size_t)l * DM * 2 * DFF, 2 * DFF, DM, P.in[I_FFN_NORM] + l * DM, (gbf16_t*)((gchar*)wb + W_GU), DM, kb * 64, half * DFF + pn * 128 + i0, 32 * g, scr, F.lane); return; }
        r -= IT_GU;
        { const int kb = r / 32, g = r % 32;
          transpose_item(P.in[I_W_D] + (size_t)l * DFF * DM, DM, DFF, nullptr, (gbf16_t*)((gchar*)wb + W_D), DFF, kb * 64, 32 * g, 32 * g, scr, F.lane); }
}
__device__ __forceinline__ void stage_prep(Frame& F) {
    LAS float* scr = (LAS float*)(F.lds + F.wave * 16384);
    const DParams& P = F.p;
    constexpr int N_C = NROWS / 4, N_ALL = N_C + 2 * IT_L;
    static_assert(NROWS % 4 == 0, "cast items are 4 rows");
    unsigned* ctr = (unsigned*)(P.ws + WS_CTL + 1024);
    gbf16_t* XN = (gbf16_t*)(P.ws + WS_HBA); gfloat* SSQ = (gfloat*)(P.ws + WS_SSQH); gfloat* MSSQ = (gfloat*)(P.ws + WS_MSSQ);
    volatile LAS int* slot = (volatile LAS int*)(F.lds + LDS_BYTES - 256 + 128);
    if (F.tid == 0) slot[0] = (int)__hip_atomic_fetch_add(ctr, 8u, __ATOMIC_RELAXED, __HIP_MEMORY_SCOPE_AGENT);
    __syncthreads();
    int base = slot[0], par = 0;
    while (base < N_ALL) {
        unsigned nb = 0; if (F.tid == 0) nb = __hip_atomic_fetch_add(ctr, 8u, __ATOMIC_RELAXED, __HIP_MEMORY_SCOPE_AGENT);
        const int item = base + F.wave;
        if (item < N_C) {
            f32x4 v[4][4];
#pragma unroll
            for (int q = 0; q < 4; ++q) { const int r_ = 4 * item + q; const gfloat* hr_ = r_ < NREAL ? P.in[I_X] + (size_t)r_ * DM : P.in[I_META] + (size_t)(r_ - NREAL) * DM;
#pragma unroll
                for (int j = 0; j < 4; ++j) v[q][j] = __builtin_nontemporal_load((const gf32x4*)hr_ + F.lane + 64 * j); }
#pragma unroll
            for (int q = 0; q < 4; ++q) { const int row = 4 * item + q;
                float sq = 0.f;
#pragma unroll
                for (int j = 0; j < 4; ++j) sq += (v[q][j].x * v[q][j].x + v[q][j].y * v[q][j].y) + (v[q][j].z * v[q][j].z + v[q][j].w * v[q][j].w);
                sq = wave_sum(sq);
                if (row < NREAL) { if (F.lane < 16) SSQ[(size_t)row * 16 + F.lane] = F.lane == 0 ? sq : 0.f; }
                else MSSQ[(row - NREAL) * 64 + F.lane] = F.lane == 0 ? sq : 0.f;
                gu32x2* o8 = (gu32x2*)(XN + (size_t)row * DM) + F.lane;
#pragma unroll
                for (int j = 0; j < 4; ++j) o8[64 * j] = (u32x2){pk2(v[q][j].x, v[q][j].y), pk2(v[q][j].z, v[q][j].w)}; }
        } else if (item < N_ALL) prep_transpose(F, item - N_C, scr);
        if (F.tid == 0) slot[par ^ 1] = (int)nb;
        __syncthreads();
        par ^= 1; base = slot[par];
    }
    __syncthreads();
    gfloat* COS = (gfloat*)(P.ws + WS_COS); gfloat* SIN = (gfloat*)(P.ws + WS_SIN);
    for (int i = blockIdx.x * NTHREADS + F.tid; i < LSEQ * 32; i += F.G * NTHREADS) {
        const int pos = i >> 5, m = i & 31;
        const float inv = 1.0f / powf(10000.0f, (float)(2 * m) / 64.0f), ang = (float)pos * inv;
        COS[i] = cosf(ang); SIN[i] = sinf(ang);
    }
    if (blockIdx.x == 0 && F.wave == 0) {
        const int ln = F.lane;
#pragma unroll 1
        for (int l = 0; l < DEPTH; ++l) {
            float a = P.in[I_LQ1][l * 64 + ln] * P.in[I_LK1][l * 64 + ln], b = P.in[I_LQ2][l * 64 + ln] * P.in[I_LK2][l * 64 + ln];
            float mq = fmaxf(fmaxf(fabsf(P.in[I_Q_NORM][l * 192 + ln]), fabsf(P.in[I_Q_NORM][l * 192 + 64 + ln])), fabsf(P.in[I_Q_NORM][l * 192 + 128 + ln]));
            float mk = fmaxf(fmaxf(fabsf(P.in[I_K_NORM][l * 192 + ln]), fabsf(P.in[I_K_NORM][l * 192 + 64 + ln])), fabsf(P.in[I_K_NORM][l * 192 + 128 + ln]));
            float dq = fabsf(P.in[I_DQ_NORM][l * 64 + ln]), dk = fabsf(P.in[I_DK_NORM][l * 64 + ln]);
            a = wave_sum(a); b = wave_sum(b);
#pragma unroll
            for (int off = 1; off < 64; off <<= 1) { mq = fmaxf(mq, __shfl_xor(mq, off)); mk = fmaxf(mk, __shfl_xor(mk, off)); dq = fmaxf(dq, __shfl_xor(dq, off)); dk = fmaxf(dk, __shfl_xor(dk, off)); }
            if (ln == 0) {
                const float lam_init = 0.8f - 0.6f * expf(-0.3f * (float)l);
                ((gfloat*)(P.ws + WS_LAM))[l] = expf(a) - expf(b) + lam_init;
                ((gfloat*)(P.ws + WS_LAM))[8 + 2 * l] = mq * mk * 192.0f * CA; ((gfloat*)(P.ws + WS_LAM))[9 + 2 * l] = dq * dk * 64.0f * CD; }
        }
    }
}

__device__ __forceinline__ void meta_postproj(Frame& F, int l) {
    if (blockIdx.x < 254) return;
    const DParams& P = F.p; const int lane = F.lane, ri = (blockIdx.x - 254) * NWAVES + F.wave, row = NREAL + ri;
    gbf16_t* pr = (gbf16_t*)(P.ws + WS_PROJ) + (size_t)row * INWP;
    const float cs = ((const gfloat*)(P.ws + WS_COS))[ri * 32 + (lane & 31)], sn = ((const gfloat*)(P.ws + WS_SIN))[ri * 32 + (lane & 31)];
    const float gq = P.in[I_DQ_NORM][l * 64 + lane], gk = P.in[I_DK_NORM][l * 64 + lane];
    float x[16];
#pragma unroll
    for (int seg = 0; seg < 16; ++seg) x[seg] = bf2f(pr[PC_DQ + seg * 64 + lane]);
#pragma unroll
    for (int seg = 0; seg < 16; ++seg) {
        const float r = 1.0f / sqrtf(wave_sum(x[seg] * x[seg]) * (1.0f / 64.0f) + EPS);
        const float y = x[seg] * r * (seg < 8 ? gq : gk), pt = __shfl_xor(y, 32);
        const float o = lane < 32 ? y * cs - pt * sn : y * cs + pt * sn;
        pr[PC_DQ + seg * 64 + lane] = (bf16_t)f2bf(seg < 8 ? o * CD : o);
    }
    asm volatile("s_waitcnt vmcnt(0)" ::: "memory");
}

__device__ __forceinline__ void att_store(Frame& F, const f32x16 (&o)[4], int qrow0, int colbase, int nvalid, int lane_) {
    __syncthreads();
    const int r32 = lane_ & 31, hi = lane_ >> 5;
    LAS char* stg = (LAS char*)F.lds + F.wave * 8192;
#pragma unroll
    for (int r = 0; r < 16; ++r) { const int row = att::crow(r, hi);
#pragma unroll
        for (int d0 = 0; d0 < 4; ++d0) *(LAS unsigned short*)(stg + row * 256 + (d0 * 32 + r32) * 2) = (unsigned short)f2bf(o[d0][r]); }
    LDS_WAIT();
    gbf16_t* AO = (gbf16_t*)(F.p.ws + WS_AO);
    const int ch = lane_ & 15, rq = lane_ >> 4;
#pragma unroll
    for (int i = 0; i < 8; ++i) { const int row = rq + 4 * i, lr = F.wave * 32 + row; const u32x4 v = *(const LAS u32x4*)(stg + row * 256 + ch * 16);
        if (lr < nvalid) *(gu32x4*)(AO + (size_t)(qrow0 + lr) * DM + colbase + ch * 8) = v; }
}
template <bool NOMAX> __device__ __forceinline__ void attn_unit_mla(Frame& F, int l_idx, int b, int h, int qrow0, int qpos0, int NT, int nvalid) {
    const DParams& P = F.p;
    const gbf16_t* QRAW = (const gbf16_t*)(P.ws + WS_QRAW); const gbf16_t* KA = (const gbf16_t*)(P.ws + WS_KA); const gbf16_t* KVRAW = (const gbf16_t*)(P.ws + WS_KVRAW);
    f32x16 o[4]; float l;
    att::attn_map<192, true, NOMAX>(QRAW + (size_t)qrow0 * 768 + h * 192, 768, KA + h * 192, 768, KVRAW + h * 256 + 128, 1024, b, qpos0, NT, o, l, (LAS char*)F.lds, (void*)((unsigned char*)P.ws + WS_CTL + 32768),
                             P.in[I_Q_NORM] + l_idx * 192, (const gfloat*)(P.ws + WS_COS), (const gfloat*)(P.ws + WS_SIN));
    int lane_ = F.lane; asm volatile("" : "+v"(lane_));
    float rli[16]; att::row_recip(l, rli, (LAS char*)F.lds, F.wave, lane_ & 31, lane_ >> 5);
#pragma unroll
    for (int r = 0; r < 16; ++r)
#pragma unroll
        for (int d0 = 0; d0 < 4; ++d0) o[d0][r] *= rli[r];
    att_store(F, o, qrow0, h * 128, nvalid, lane_);
}
template <bool NOMAX> __device__ __forceinline__ void attn_unit_diff(Frame& F, int l_idx, int b, int h, int qrow0, int qpos0, int NT, int nvalid) {
    const DParams& P = F.p;
    const gbf16_t* PROJ = (const gbf16_t*)(P.ws + WS_PROJ);
    const float lam = ((const gfloat*)(P.ws + WS_LAM))[l_idx];
    const float lam_init = 0.8f - 0.6f * expf(-0.3f * (float)l_idx);
    f32x16 o[4]; unsigned oa[4][8]; float lsum; float rli[16];
#pragma unroll 1
    for (int c = 0; c < 2; ++c) {
        att::attn_map<64, false, NOMAX>(PROJ + (size_t)qrow0 * INWP + PC_DQ + h * 128 + c * 64, INWP, PROJ + PC_DK + h * 128 + c * 64, INWP, PROJ + PC_DV + h * 128, INWP, b, qpos0, NT, o, lsum, (LAS char*)F.lds, (void*)((unsigned char*)P.ws + WS_CTL + 32768 + 64));
        int tid_ = F.tid; asm volatile("" : "+v"(tid_));
        att::row_recip(lsum, rli, (LAS char*)F.lds, F.wave, tid_ & 31, (tid_ >> 5) & 1);
        if (c == 0) {
            if constexpr (NOMAX) {
#pragma unroll
                for (int d = 0; d < 4; ++d)
#pragma unroll
                    for (int r = 0; r < 8; ++r) oa[d][r] = cvt_pk_bf16(o[d][2 * r] * rli[2 * r], o[d][2 * r + 1] * rli[2 * r + 1]);
            } else {
                gf32x4* tmp = (gf32x4*)(P.ws + WS_TMP) + (size_t)blockIdx.x * (16 * 512) + tid_;
#pragma unroll
                for (int d = 0; d < 4; ++d)
#pragma unroll
                    for (int q = 0; q < 4; ++q) tmp[(d * 4 + q) * 512] = (f32x4){o[d][4 * q] * rli[4 * q], o[d][4 * q + 1] * rli[4 * q + 1], o[d][4 * q + 2] * rli[4 * q + 2], o[d][4 * q + 3] * rli[4 * q + 3]};
            }
        }
    }
    int tid_ = F.tid; asm volatile("" : "+v"(tid_));
    const int lane_ = tid_ & 63, r32 = lane_ & 31;
    const gf32x4* tmp = (const gf32x4*)(P.ws + WS_TMP) + (size_t)blockIdx.x * (16 * 512) + tid_;
    float ss[16];
#pragma unroll
    for (int r = 0; r < 16; ++r) ss[r] = 0.f;
    if constexpr (NOMAX) {
#pragma unroll
        for (int d = 0; d < 4; ++d)
#pragma unroll
            for (int r = 0; r < 16; ++r) { const float a0 = (r & 1) ? bf2f(oa[d][r >> 1] >> 16) : bf2f(oa[d][r >> 1] & 0xffffu); const float v = a0 - lam * rli[r] * o[d][r]; o[d][r] = v; ss[r] += v * v; }
    } else {
#pragma unroll
    for (int d = 0; d < 4; ++d) {
#pragma unroll
        for (int q = 0; q < 4; ++q) { const f32x4 t = tmp[(d * 4 + q) * 512];
#pragma unroll
            for (int e = 0; e < 4; ++e) { const int r = 4 * q + e; const float v = t[e] - lam * rli[r] * o[d][r]; o[d][r] = v; ss[r] += v * v; } }
        asm volatile("" ::: "memory"); }
    }
#pragma unroll
    for (int off = 1; off < 32; off <<= 1) { float t[16];
#pragma unroll
        for (int r = 0; r < 16; ++r) t[r] = __shfl_xor(ss[r], off);
#pragma unroll
        for (int r = 0; r < 16; ++r) ss[r] += t[r]; }
    const gfloat* gs = P.in[I_SUBLN] + l_idx * 128; const float post = 1.0f - lam_init;
    float gcol[4];
#pragma unroll
    for (int d = 0; d < 4; ++d) gcol[d] = gs[d * 32 + r32] * post;
#pragma unroll
    for (int r = 0; r < 16; ++r) { const float rn = 1.0f / sqrtf(ss[r] * (1.0f / 128.0f) + EPS);
#pragma unroll
        for (int d0 = 0; d0 < 4; ++d0) o[d0][r] *= rn * gcol[d0]; }
    att_store(F, o, qrow0, 512 + h * 128, nvalid, lane_);
}
template <bool NOMAX> __device__ __forceinline__ void stage_attention(Frame& F, int l) {
    const int v = F.vcu, bh = v >> 2, s = v & 3, b = bh >> 2, h = bh & 3;
    if (F.tid < 192) ((LAS float*)((LAS char*)F.lds + att::OFF_GQ))[F.tid] = F.p.in[I_Q_NORM][l * 192 + F.tid];
    __syncthreads();
#pragma unroll 1
    for (int u = 0; u < 5; ++u) {
        int type, b_, h_, qrow0, qpos0, NT, nvalid;
        if (u < 4) { const int qb = (u & 1) ? 7 - s : s; type = u >> 1; b_ = b; h_ = h; qrow0 = b * SEQ + qb * 256; qpos0 = NMETA + qb * 256; NT = 4 * qb + 5; nvalid = 256; }
        else { if (v >= 8 || l == DEPTH - 1) break; type = v >> 2; b_ = 0; h_ = v & 3; qrow0 = NREAL; qpos0 = 0; NT = 1; nvalid = NMETA; }
        if (type == 0) attn_unit_mla<NOMAX>(F, l, b_, h_, qrow0, qpos0, NT, nvalid);
        else attn_unit_diff<NOMAX>(F, l, b_, h_, qrow0, qpos0, NT, nvalid);
    }
    __syncthreads();
}

__device__ __forceinline__ f32x4 meta_dot(const gbf16_t* arow, const gbf16_t* wrow, int K) {
    f32x4 acc = {0.f, 0.f, 0.f, 0.f};
#pragma unroll 8
    for (int k = 0; k < K; k += 32) { const bf16x8 a = *(const gbf16x8*)(arow + k); const bf16x8 w = *(const gbf16x8*)(wrow + k);
        acc = __builtin_amdgcn_mfma_f32_16x16x32_bf16(w, a, acc, 0, 0, 0); }
    return acc;
}
__device__ __forceinline__ float meta_rh(const gfloat* mssq, int tr) {
    f32x4 v[16];
#pragma unroll
    for (int i = 0; i < 16; ++i) v[i] = *(const gf32x4*)(mssq + tr * 64 + 4 * i);
    __builtin_amdgcn_sched_barrier(0);
    float s = 0.f;
#pragma unroll
    for (int i = 0; i < 16; ++i) s += (v[i][0] + v[i][1]) + (v[i][2] + v[i][3]);
    return 1.0f / sqrtf(s * (1.0f / DM) + EPS);
}
__device__ __forceinline__ void meta_tasks(Frame& F, int kind, const pg8::Gemm& g, gbf16_t* eo, int eld, const gfloat* ers, const gbf16_t* src_meta, gbf16_t* xn) {
    const int tr = F.lane & 15, q = F.lane >> 4, row = NREAL + tr;
    const int kc = g.K >> 3, k0 = F.wave * kc;
    const gbf16_t* arow = g.A + (size_t)row * g.lda + 8 * q + k0;
    gfloat* mssq = (gfloat*)(F.p.ws + WS_MSSQ);
    LAS f32x4* red = (LAS f32x4*)(F.lds + pg8::STAGE_BYTES);
    const int ntasks = (kind == 1 ? DFF : g.N) / 16;
    if ((int)blockIdx.x >= ntasks) return;
    float sc = 1.0f;
    if (kind != 2) {
        if (ers) {
            const gbf16_t* cq = (const gbf16_t*)ers + (size_t)tr * INWP + 64 * q; u32x4 cv[8]; float s = 0.f;
#pragma unroll
            for (int i = 0; i < 8; ++i) cv[i] = *(const gu32x4*)(cq + 8 * i);
#pragma unroll
            for (int i = 0; i < 8; ++i) { float x[8]; unpack8(cv[i], x); s += ssq8(x); }
            s += __shfl_xor(s, 16); s += __shfl_xor(s, 32); sc = 1.0f / sqrtf(s * (1.0f / 256.0f) + EPS);
        } else sc = meta_rh(mssq, tr);
    }
    for (int t = blockIdx.x; t < ntasks; t += F.G) {
        int wr0 = 16 * t + tr, wr1 = 0;
        if (kind == 1) { const int c0 = 16 * t, pn = c0 >> 7, i0 = c0 & 127; wr0 = pn * 256 + i0 + tr; wr1 = wr0 + 128; }
        const f32x4 p0 = meta_dot(arow, g.Bt + (size_t)wr0 * g.K + 8 * q + k0, kc);
        red[F.wave * 64 + F.lane] = p0;
        if (kind == 1) { const f32x4 p1 = meta_dot(arow, g.Bt + (size_t)wr1 * g.K + 8 * q + k0, kc); red[512 + F.wave * 64 + F.lane] = p1; }
        __syncthreads();
        if (F.wave == 0) {
            f32x4 acc = red[F.lane];
#pragma unroll
            for (int w = 1; w < 8; ++w) acc += red[w * 64 + F.lane];
            if (kind == 0) {
                int col = 16 * t + 4 * q; bool keep = true;
                if (ers) { const int hh = col >> 8, wi = col & 255; keep = wi < 192; col = hh * 192 + wi; }
                else if (col >= PC_DQ && col < PC_DV) { const int p = col & 255; col = (col & ~255) + 64 * ((p >> 5) & 3) + 32 * (p >> 7) + (p & 31); }
                if (keep) *(gu32x2*)(eo + (size_t)row * eld + col) = (u32x2){cvt_pk_bf16(acc[0] * sc, acc[1] * sc), cvt_pk_bf16(acc[2] * sc, acc[3] * sc)};
            } else if (kind == 1) {
                f32x4 au = red[512 + F.lane];
#pragma unroll
                for (int w = 1; w < 8; ++w) au += red[512 + w * 64 + F.lane];
                *(gu32x2*)(eo + (size_t)row * eld + 16 * t + 4 * q) = (u32x2){cvt_pk_bf16(pg8::silu_mul(acc[0] * sc, au[0] * sc), pg8::silu_mul(acc[1] * sc, au[1] * sc)),
                                                                           cvt_pk_bf16(pg8::silu_mul(acc[2] * sc, au[2] * sc), pg8::silu_mul(acc[3] * sc, au[3] * sc))};
            } else {
                const int c = 16 * t + 4 * q;
                const u32x2 sv = *(const gu32x2*)(src_meta + (size_t)row * DM + c);
                const f32x4 h = (f32x4){bf2f(sv.x & 0xffffu), bf2f(sv.x >> 16), bf2f(sv.y & 0xffffu), bf2f(sv.y >> 16)} + acc;
                *(gu32x2*)(xn + (size_t)row * DM + c) = (u32x2){cvt_pk_bf16(h[0], h[1]), cvt_pk_bf16(h[2], h[3])};
                float s = (h[0] * h[0] + h[1] * h[1]) + (h[2] * h[2] + h[3] * h[3]);
                s += __shfl_xor(s, 16); s += __shfl_xor(s, 32);
                if (q == 0) mssq[tr * 64 + t] = s;
            }
        }
        __syncthreads();
    }
    asm volatile("s_waitcnt vmcnt(0)" ::: "memory");
}

__device__ __forceinline__ void meta_kv_heads(Frame& F, int l, const gbf16_t* Wkv) {
    if (blockIdx.x >= 4) return;
    const DParams& P = F.p; const int h = blockIdx.x, tr = F.lane & 15, q = F.lane >> 4;
    const gbf16_t* PROJ = (const gbf16_t*)(P.ws + WS_PROJ); gbf16_t* KA = (gbf16_t*)(P.ws + WS_KA); gbf16_t* KV = (gbf16_t*)(P.ws + WS_KVRAW);
    const gfloat* COS = (const gfloat*)(P.ws + WS_COS); const gfloat* SIN = (const gfloat*)(P.ws + WS_SIN); const gfloat* gk = P.in[I_K_NORM] + l * 192;
    LAS float* L = (LAS float*)(F.lds + pg8::STAGE_BYTES);
#pragma unroll 1
    for (int i = 0; i < 2; ++i) { const int t = 2 * F.wave + i;
        const f32x4 acc = meta_dot(PROJ + (size_t)(NREAL + tr) * INWP + PC_CKV + 8 * q, Wkv + (size_t)(h * 256 + 16 * t + tr) * 256 + 8 * q, 256);
#pragma unroll
        for (int e = 0; e < 4; ++e) L[tr * 256 + 16 * t + 4 * q + e] = acc[e]; }
    __syncthreads();
#pragma unroll 1
    for (int i = 0; i < 2; ++i) { const int ri = 2 * F.wave + i, row = NREAL + ri, lane = F.lane;
        const gbf16_t* pr = PROJ + (size_t)row * INWP;
        float rkv; { const unsigned v = *(const gunsigned*)(pr + PC_CKV + 2 * lane); const float a = bf2f(v & 0xffffu), c = bf2f(v >> 16); rkv = 1.0f / sqrtf(wave_sum(a * a + c * c) * (1.0f / 128.0f) + EPS); }
        const float x0 = L[ri * 256 + lane] * rkv, x1 = L[ri * 256 + 64 + lane] * rkv, x2 = bf2f(pr[PC_KR + lane]);
        const float r = 1.0f / sqrtf(wave_sum(x0 * x0 + x1 * x1 + x2 * x2) * (1.0f / 192.0f) + EPS);
        const float cs = COS[ri * 32 + (lane & 31)], sn = SIN[ri * 32 + (lane & 31)];
        const float y0 = x0 * r * gk[lane], y1 = x1 * r * gk[64 + lane], y2 = x2 * r * gk[128 + lane], pt = __shfl_xor(y2, 32);
        const float y2r = lane < 32 ? y2 * cs - pt * sn : y2 * cs + pt * sn;
        gbf16_t* ko = KA + (size_t)row * 768 + h * 192;
        ko[lane] = (bf16_t)f2bf(y0); ko[64 + lane] = (bf16_t)f2bf(y1); ko[128 + lane] = (bf16_t)f2bf(y2r);
        gbf16_t* vo = KV + (size_t)row * 1024 + h * 256 + 128;
        vo[lane] = (bf16_t)f2bf(L[ri * 256 + 128 + lane] * rkv); vo[64 + lane] = (bf16_t)f2bf(L[ri * 256 + 192 + lane] * rkv); }
    __syncthreads();
    asm volatile("s_waitcnt vmcnt(0)" ::: "memory");
}

constexpr int SPL = 7, NSTAGES = 1 + SPL * DEPTH;
__device__ __forceinline__ bool stage_needs_sync(int st) { return !(st >= 1 && (st - 1) % SPL == 2); }
__device__ __forceinline__ void run_stage(const Params& p, LAS unsigned char* ldsp, int st) {
    Frame F;
    F.lds = ldsp;
    { int t = threadIdx.x; asm volatile("" : "+v"(t)); F.tid = t; }
    { unsigned char* w = p.ws; asm volatile("" : "+s"(w)); F.p.ws = (guchar*)w; }
#pragma unroll
    for (int i = 0; i < 21; ++i) F.p.in[i] = (const gfloat*)p.in[i];
    F.p.out = (gfloat*)p.out; F.p.s_lo = p.s_lo; F.p.s_hi = p.s_hi;
    F.lane = F.tid & 63; F.wave = __builtin_amdgcn_readfirstlane(F.tid >> 6);
    F.G = gridDim.x; { const int bx = blockIdx.x; F.vcu = (F.G % 8 == 0) ? (bx % 8) * (F.G / 8) + bx / 8 : bx; }
    F.gw = blockIdx.x * NWAVES + F.wave; F.ngw = F.G * NWAVES;
    const DParams& P = F.p;
    guchar* ws = P.ws;
    if (st == 0) { stage_prep(F); return; }
    const int l = (st - 1) / SPL, s = (st - 1) % SPL;
    const gchar* wb = (const gchar*)(ws + WS_W + (size_t)l * W_LAYER);
    gbf16_t* HBA = (gbf16_t*)(ws + WS_HBA); gbf16_t* HBB = (gbf16_t*)(ws + WS_HBB);
    const bool last_layer = l == DEPTH - 1;
    int kind = -1; pg8::Gemm g{nullptr, nullptr, NREAL, 0, 0, 0};
    gbf16_t* eo = nullptr; int eld = 0;
    const gbf16_t* hsrc = nullptr; gbf16_t* hdst = nullptr;
    switch (s) {
    case 0: kind = 0; g.A = HBA; g.Bt = (const gbf16_t*)(wb + W_IN); g.N = INWP; g.K = DM; g.lda = DM; eo = (gbf16_t*)(ws + WS_PROJ); eld = INWP; break;
    case 1: kind = 5; g.A = (const gbf16_t*)(ws + WS_PROJ) + PC_CQ; g.Bt = (const gbf16_t*)(wb + W_Q); g.N = 1024; g.K = 256; g.lda = INWP; eo = (gbf16_t*)(ws + WS_QRAW); eld = 768; break;
    case 2: kind = 4; g.A = (const gbf16_t*)(ws + WS_PROJ) + PC_CKV; g.Bt = (const gbf16_t*)(wb + W_KV); g.N = 1024; g.K = 256; g.lda = INWP; break;
    case 3: { const gfloat* bnd = (const gfloat*)(ws + WS_LAM) + 8 + 2 * l;
        if (bnd[0] < att::SCORE_BOUND_OK && bnd[1] < att::SCORE_BOUND_OK) stage_attention<true>(F, l); else stage_attention<false>(F, l); } break;
    case 4: kind = 2; g.A = (const gbf16_t*)(ws + WS_AO); g.Bt = (const gbf16_t*)(wb + W_O); g.N = DM; g.K = DM; g.lda = DM; hsrc = HBA; hdst = HBB; break;
    case 5: kind = 1; g.A = HBB; g.Bt = (const gbf16_t*)(wb + W_GU); g.N = 2 * DFF; g.K = DM; g.lda = DM; eo = (gbf16_t*)(ws + WS_ACT); eld = DFF; break;
    case 6: kind = last_layer ? 3 : 2; g.A = (const gbf16_t*)(ws + WS_ACT); g.Bt = (const gbf16_t*)(wb + W_D); g.N = DM; g.K = DFF; g.lda = DFF; hsrc = HBB; hdst = HBA; break;
    }
    if (kind >= 0) {
        gfloat* rqp = (gfloat*)(ws + WS_RQP); gfloat* rkvp = (gfloat*)(ws + WS_RKVP); gfloat* krss = (gfloat*)(ws + WS_KRSS); const gfloat* ssqh = (const gfloat*)(ws + WS_SSQH);
        const gfloat* COS = (const gfloat*)(ws + WS_COS); const gfloat* SIN = (const gfloat*)(ws + WS_SIN);
        pg8::StaticOrder S; S.init(NREAL, g.N, F.G, (int)blockIdx.x);
        pg8::gemm_prefetch(F.lds, g, S, true);
        if (kind == 4) meta_kv_heads(F, l, g.Bt);
        else if (kind == 5) { meta_postproj(F, l); meta_tasks(F, 0, g, eo, eld, (const gfloat*)((const gbf16_t*)(ws + WS_PROJ) + (size_t)NREAL * INWP + PC_CQ), nullptr, nullptr); }
        else if (!(last_layer && s >= 4)) meta_tasks(F, kind, g, eo, eld, nullptr, hsrc, hdst);
        if (kind == 0) { pg8::EpiInProj E{eo, ssqh, rqp, rkvp, krss, COS, SIN, P.in[I_DQ_NORM] + l * 64, P.in[I_DK_NORM] + l * 64}; pg8::gemm_phase<true>(F.lds, g, S, E); }
        else if (kind == 5) { pg8::EpiScaleBf16 E{eo, eld, rqp, 4, 1.0f / 256.0f, 192, 192}; pg8::gemm_phase<true>(F.lds, g, S, E); }
        else if (kind == 4) { pg8::EpiKV E{(gbf16_t*)(ws + WS_KA), (gbf16_t*)(ws + WS_KVRAW), (const gbf16_t*)(ws + WS_PROJ), rkvp, krss, COS, SIN, P.in[I_K_NORM] + l * 192};
                              pg8::gemm_phase<true>(F.lds, g, S, E); }
        else if (kind == 1) { pg8::EpiSwiglu E{eo, eld, nullptr, ssqh}; pg8::gemm_phase<true>(F.lds, g, S, E); }
        else if (kind == 2) { pg8::EpiResidual<false> E{hsrc, hdst, (gfloat*)(ws + WS_SSQH), nullptr}; pg8::gemm_phase<true>(F.lds, g, S, E); }
        else { pg8::EpiResidual<true> E{hsrc, nullptr, nullptr, P.out}; pg8::gemm_phase<true>(F.lds, g, S, E); }
    }
}

constexpr int LDS_MISC_OFF = LDS_BYTES - 256;
constexpr size_t CTL_BAR_OFF = 16384;
__global__ void __launch_bounds__(NTHREADS, 2) mega_kernel(Params p) {
    extern __shared__ __attribute__((aligned(16))) unsigned char lds[];
    cg::grid_group grid = cg::this_grid();
    volatile LAS unsigned* misc = (volatile LAS unsigned*)((LAS unsigned char*)lds + LDS_MISC_OFF);
    if (threadIdx.x < 4) misc[threadIdx.x] = 0u;
    __syncthreads();
    const XcdBarrier bar = xcd_barrier_post((unsigned*)(p.ws + WS_CTL + CTL_BAR_OFF), misc);
#pragma unroll 1
    for (int st = p.s_lo; st < p.s_hi; ++st) {
        if (st > p.s_lo && stage_needs_sync(st)) { if (st == 1) grid.sync(); else xcd_barrier(bar); }
#if defined(PROBE_SUM)
        const unsigned long long q0_ = __builtin_amdgcn_s_memrealtime();
#endif
#if defined(PROBE_CLK)
        unsigned long long c0_ = 0, r0_ = 0;
        if (st == PROBE_CLK) { c0_ = __builtin_amdgcn_s_memtime(); r0_ = __builtin_amdgcn_s_memrealtime(); }
#endif
        run_stage(p, (LAS unsigned char*)lds, st);
#if defined(PROBE_SUM)
        if (blockIdx.x == 9 && threadIdx.x == 0) ((unsigned long long*)(p.ws + WS_CTL + 49152))[st] = __builtin_amdgcn_s_memrealtime() - q0_;
        if (st == p.s_hi - 1) { xcd_barrier(bar);
            if (blockIdx.x == 0 && threadIdx.x == 0) { const unsigned long long* bt = (const unsigned long long*)(p.ws + WS_CTL + 49152); unsigned long long sum = 0;
                for (int i = 0; i < NSTAGES; ++i) if ((PROBE_SUM >> i) & 1) sum += bt[i];
                p.out[0] += 0.1f + 1e-5f * (float)sum; } }
#endif
#if defined(PROBE_CLK)
        if (st == PROBE_CLK && threadIdx.x == 0) { const unsigned long long c1_ = __builtin_amdgcn_s_memtime(), r1_ = __builtin_amdgcn_s_memrealtime();
            unsigned long long* pt = (unsigned long long*)(p.ws + WS_CTL + 32768 + 128); if (blockIdx.x == 9) { pt[0] = c1_ - c0_; pt[1] = r1_ - r0_; }
            ((unsigned long long*)(p.ws + WS_CTL + 40960))[blockIdx.x] = r1_ - r0_; }
        if (st == p.s_hi - 1) { xcd_barrier(bar);
            if (blockIdx.x == 0 && threadIdx.x == 0) { const unsigned long long* pt = (const unsigned long long*)(p.ws + WS_CTL + 32768 + 128);
#if PROBE_CLK_WHAT == 0
                p.out[0] += 0.1f + 0.01f * (float)((double)pt[0] / (double)pt[1]);
#elif PROBE_CLK_WHAT >= 2
                { const unsigned long long* bt = (const unsigned long long*)(p.ws + WS_CTL + 40960); unsigned long long mx = 0, mn = ~0ull, sum = 0; int cnt_slow = 0;
                  for (int i = 0; i < 256; ++i) { mx = bt[i] > mx ? bt[i] : mx; mn = bt[i] < mn ? bt[i] : mn; sum += bt[i]; }
                  for (int i = 0; i < 256; ++i) if (bt[i] * 10 > mx * 9) ++cnt_slow;
                  p.out[0] += 0.1f + (PROBE_CLK_WHAT == 2 ? 1e-5f * (float)mx : PROBE_CLK_WHAT == 3 ? 1e-5f * (float)mn : PROBE_CLK_WHAT == 4 ? 1e-5f * (float)(sum / 256) : 0.002f * (float)cnt_slow); }
#else
                p.out[0] += 0.1f + 1e-5f * (float)pt[1];
#endif
            } }
#endif
#if defined(PROBE_T)
        if (st == p.s_hi - 1) { xcd_barrier(bar);
            if (blockIdx.x == 0 && threadIdx.x == 0) { const unsigned long long* pt = (const unsigned long long*)(p.ws + WS_CTL + 32768 + (PROBE_DIFF ? 64 : 0));
                const float frac = (float)((double)pt[PROBE_Q] / (double)pt[0]); p.out[0] += 0.1f + (PROBE_Q == 0 ? (float)((double)pt[0] * 1e-6) : frac); } }
#endif
#if defined(PROBE_DUP)
        if ((st == 0 && (PROBE_DUP & 0x8000)) || (st >= 1 && ((PROBE_DUP >> ((st - 1) % SPL)) & 1))) { xcd_barrier(bar); run_stage(p, (LAS unsigned char*)lds, st); }
#endif
    }
}

extern "C" void kernel_launch(void* const* d_in, const int* in_sizes, int n_in, void* d_out, int out_size, void* d_ws, size_t ws_size, hipStream_t stream) {
    static int state = 0;
    if (state == 0) {
        if (n_in != 21 || in_sizes[0] != NREAL * DM || out_size != NREAL * DM || ws_size < WS_END) {
            fprintf(stderr, "kernel_launch: unexpected shapes: n_in %d in0 %d out %d ws %zu (need %zu)\n", n_in, n_in > 0 ? in_sizes[0] : -1, out_size, ws_size, (size_t)WS_END); state = -1; return; }
        int dev = 0, cus = 0;
        hipGetDevice(&dev); hipDeviceGetAttribute(&cus, hipDeviceAttributeMultiprocessorCount, dev);
        if (hipFuncSetAttribute((const void*)mega_kernel, hipFuncAttributeMaxDynamicSharedMemorySize, LDS_BYTES) != hipSuccess) { fprintf(stderr, "kernel_launch: hipFuncSetAttribute failed\n"); state = -1; return; }
        int per_cu = 0;
        hipOccupancyMaxActiveBlocksPerMultiprocessor(&per_cu, (const void*)mega_kernel, NTHREADS, LDS_BYTES);
        (void)hipGetLastError();
        if (cus != 256 || per_cu < 1) { fprintf(stderr, "kernel_launch: needs a 256-CU device with one resident workgroup per CU (cus %d, per_cu %d)\n", cus, per_cu); state = -1; return; }
        state = 1;
    }
    if (state < 0) return;
    Params p{};
    for (int i = 0; i < 21; ++i) p.in[i] = (const float*)d_in[i];
    p.out = (float*)d_out; p.ws = (unsigned char*)d_ws;
    p.s_lo = 0; p.s_hi = NSTAGES;
    if (hipMemsetAsync((char*)d_ws + WS_CTL, 0, 65536, stream) != hipSuccess) { fprintf(stderr, "kernel_launch: hipMemsetAsync failed\n"); return; }
    void* args[] = {&p};
    hipError_t e = hipLaunchCooperativeKernel((const void*)mega_kernel, dim3(256), dim3(NTHREADS), args, LDS_BYTES, stream);
    if (e != hipSuccess) fprintf(stderr, "kernel_launch: cooperative launch failed: %s\n", hipGetErrorString(e));
}
```

```cpp
#include <hip/hip_runtime.h>
#include <hip/hip_cooperative_groups.h>
#include <cstdio>
#include <cstdint>
namespace cg = cooperative_groups;


constexpr int DM = 1024, BATCH = 16, SEQ = 2048, NMETA = 16, DEPTH = 2;
constexpr int NREAL = BATCH * SEQ;
constexpr int NROWS = NREAL + NMETA;
constexpr int MP = 33024;
constexpr int LSEQ = SEQ + NMETA;
constexpr int INW = 1984, INWP = 2048, DFF = 2816;
constexpr float EPS = 1e-6f;
constexpr float LOG2E = 1.4426950408889634f;
constexpr float CA = 0.07216878364870322f * LOG2E;
constexpr float CD = 0.125f * LOG2E;
constexpr int PC_CQ = 0, PC_CKV = 256, PC_KR = 384, PC_DQ = 512, PC_DK = 1024, PC_DV = 1536;
constexpr int SRC_DQ = 448, SRC_DK = 960, SRC_DV = 1472;

constexpr size_t MiB = 1u << 20;
constexpr size_t WS_CTL = 0;
constexpr size_t WS_RH = 1 * MiB;
constexpr size_t WS_RQ = WS_RH + 256 * 1024;
constexpr size_t WS_RKV = WS_RQ + 256 * 1024;
constexpr size_t WS_HM = WS_RKV + 256 * 1024;
constexpr size_t WS_LAM = WS_HM + 64 * 1024;
constexpr size_t WS_MSSQ = WS_LAM + 1024;
constexpr size_t WS_RQP = 3 * MiB;
constexpr size_t WS_RKVP = WS_RQP + 512 * 1024;
constexpr size_t WS_KRSS = WS_RH;
constexpr size_t WS_COS = 2 * MiB;
constexpr size_t WS_SIN = WS_COS + 512 * 1024;
constexpr size_t WS_W = 4 * MiB;
constexpr size_t W_IN = 0, W_Q = W_IN + (size_t)INWP * DM * 2, W_KV = W_Q + (size_t)1024 * 256 * 2, W_O = W_KV + (size_t)1024 * 256 * 2,
                 W_GU = W_O + (size_t)DM * DM * 2, W_D = W_GU + (size_t)2 * DFF * DM * 2, W_LAYER = W_D + (size_t)DM * DFF * 2;
static_assert(WS_W + 2 * W_LAYER <= 52 * MiB, "weights");
constexpr size_t WS_PROJ = 52 * MiB;
constexpr size_t WS_KVRAW = WS_PROJ + (size_t)MP * INWP * 2;
constexpr size_t WS_QA = WS_KVRAW + (size_t)MP * 1024 * 2;
constexpr size_t WS_KA = WS_QA + (size_t)MP * 768 * 2;
constexpr size_t WS_HBA = WS_KA + (size_t)MP * 768 * 2;
constexpr size_t WS_AO = WS_HBA + (size_t)MP * 1024 * 2;
constexpr size_t WS_TMP = WS_AO + (size_t)MP * 1024 * 2;
constexpr size_t WS_SSQH = WS_TMP + (size_t)256 * 64 * 512 * 4;
constexpr size_t WS_END = WS_SSQH + (size_t)NREAL * 16 * 4;
constexpr size_t WS_QRAW = WS_QA;
constexpr size_t WS_QRAW_OLD_UNUSED = WS_AO;
constexpr size_t WS_HBB = WS_QA;
constexpr size_t WS_ACT = WS_PROJ;
static_assert(WS_ACT + (size_t)MP * DFF * 2 <= WS_QA, "ACT overlay");

#define LAS __attribute__((address_space(3)))
typedef unsigned short bf16_t;
typedef short bf16x8 __attribute__((ext_vector_type(8)));
typedef short s16x4 __attribute__((ext_vector_type(4)));
typedef float f32x4 __attribute__((ext_vector_type(4)));
typedef float f32x16 __attribute__((ext_vector_type(16)));
typedef unsigned u32x4 __attribute__((ext_vector_type(4)));
typedef unsigned u32x2 __attribute__((ext_vector_type(2)));
#define GAS __attribute__((address_space(1)))
typedef GAS bf16_t gbf16_t; typedef GAS float gfloat; typedef GAS unsigned char guchar; typedef GAS char gchar; typedef GAS unsigned gunsigned;
typedef GAS u32x4 gu32x4; typedef GAS u32x2 gu32x2; typedef GAS f32x4 gf32x4; typedef GAS bf16x8 gbf16x8;

__device__ __forceinline__ unsigned f2bf(float f) { unsigned u = __builtin_bit_cast(unsigned, f); return (u + 0x7fffu + ((u >> 16) & 1u)) >> 16; }
__device__ __forceinline__ unsigned pk2(float lo, float hi) { return f2bf(lo) | (f2bf(hi) << 16); }
__device__ __forceinline__ float bf2f(unsigned b) { return __builtin_bit_cast(float, b << 16); }
__device__ __forceinline__ unsigned cvt_pk_bf16(float lo, float hi) { unsigned r; asm volatile("v_cvt_pk_bf16_f32 %0, %1, %2" : "=v"(r) : "v"(lo), "v"(hi)); return r; }
__device__ __forceinline__ float wave_sum(float v) {
#pragma unroll
    for (int o = 1; o < 64; o <<= 1) v += __shfl_xor(v, o);
    return v;
}
#define LDS_WAIT() asm volatile("s_waitcnt lgkmcnt(0)" ::: "memory")

__device__ __forceinline__ void unpack8(const u32x4 v, float (&x)[8]) {
    x[0] = bf2f(v.x & 0xffffu); x[1] = bf2f(v.x >> 16); x[2] = bf2f(v.y & 0xffffu); x[3] = bf2f(v.y >> 16);
    x[4] = bf2f(v.z & 0xffffu); x[5] = bf2f(v.z >> 16); x[6] = bf2f(v.w & 0xffffu); x[7] = bf2f(v.w >> 16);
}
__device__ __forceinline__ u32x4 pack8(const float (&x)[8]) { return (u32x4){pk2(x[0], x[1]), pk2(x[2], x[3]), pk2(x[4], x[5]), pk2(x[6], x[7])}; }
__device__ __forceinline__ float ssq8(const float (&x)[8]) { return ((x[0] * x[0] + x[1] * x[1]) + (x[2] * x[2] + x[3] * x[3])) + ((x[4] * x[4] + x[5] * x[5]) + (x[6] * x[6] + x[7] * x[7])); }
__device__ __forceinline__ void norm_rope8(float (&x)[8], float r, const float (&g)[8], const float (&cs)[8], const float (&sn)[8], bool upper, float post) {
#pragma unroll
    for (int e = 0; e < 8; ++e) { const float y = x[e] * r * g[e], pt = __shfl_xor(y, 4); x[e] = (upper ? y * cs[e] + pt * sn[e] : y * cs[e] - pt * sn[e]) * post; }
}
__device__ __forceinline__ void load8f(float (&d)[8], const gfloat* p) { const f32x4 a = *(const gf32x4*)p, b = *(const gf32x4*)(p + 4); d[0] = a[0]; d[1] = a[1]; d[2] = a[2]; d[3] = a[3]; d[4] = b[0]; d[5] = b[1]; d[6] = b[2]; d[7] = b[3]; }


namespace pg8 {
constexpr int BM = 256, BK = 64, HALF = 128, HTB = HALF * BK * 2, STAGE_BYTES = 8 * HTB, NXCD = 8, WGM = 8;
__host__ __device__ __forceinline__ int lds_byte(int r, int c) { const int st = (r >> 4) * 2 + (c >> 5), rr = r & 15, cc = c & 31, ob = rr * 64 + cc * 2; return st * 1024 + (ob ^ (((ob >> 9) & 1) << 5)); }
__host__ __device__ __forceinline__ void stage_rc(int b, int& R, int& C) { const int st = b / 1024, sb = b % 1024, swz = sb ^ (((sb >> 9) & 1) << 5); R = (st >> 1) * 16 + swz / 64; C = (st & 1) * 32 + (swz % 64) / 2; }
__host__ __device__ __forceinline__ int perm32(int rho) { const int n = rho >> 4, i = rho & 15; return 8 * (i >> 2) + 4 * n + (i & 3); }

struct Unit { int pm, pn; };
struct Gemm { const gbf16_t* A; const gbf16_t* Bt; int M, N, K, lda; };

struct StaticOrder {
    int nM, nN, nwg, G, c;
    __device__ void init(int M, int N, int G_, int c_) { nM = M / BM; nN = N / BM; nwg = nM * nN; G = G_; c = c_; }
    __device__ bool next(int i, Unit& u) const {
        const long L = (long)i * G + c; if (L >= nwg) return false;
        int wgid = (int)L; { const int q = nwg / NXCD, r = nwg % NXCD, xcd = wgid % NXCD, off = wgid / NXCD; wgid = (xcd < r ? xcd * (q + 1) : r * (q + 1) + (xcd - r) * q) + off; }
        const int nig = WGM * nN, gid = wgid / nig, fm = gid * WGM, gsz = (nM - fm) < WGM ? (nM - fm) : WGM;
        u.pm = fm + ((wgid % nig) % gsz); u.pn = (wgid % nig) / gsz; return true;
    }
};

__device__ __forceinline__ void row_scales(float (&sc)[2][4], const gfloat* rs, const gfloat* part, int npart, float inv_div, int row0, int fq) {
    if (!part) {
#pragma unroll
        for (int ai = 0; ai < 2; ++ai)
#pragma unroll
            for (int m = 0; m < 4; ++m) sc[ai][m] = rs[row0 + ai * HALF + m * 16];
        return;
    }
    f32x4 v[8];
#pragma unroll
    for (int i = 0; i < 8; ++i) { const int row = row0 + (i >> 2) * HALF + (i & 3) * 16; v[i] = npart == 16 ? *(const gf32x4*)(part + (size_t)row * 16 + 4 * fq) : *(const gf32x4*)(part + (size_t)row * 4); }
    __builtin_amdgcn_sched_barrier(0);
    float s[8];
#pragma unroll
    for (int i = 0; i < 8; ++i) s[i] = (v[i][0] + v[i][1]) + (v[i][2] + v[i][3]);
    if (npart == 16) { float t[8];
#pragma unroll
        for (int i = 0; i < 8; ++i) t[i] = __shfl_xor(s[i], 16);
#pragma unroll
        for (int i = 0; i < 8; ++i) s[i] += t[i];
#pragma unroll
        for (int i = 0; i < 8; ++i) t[i] = __shfl_xor(s[i], 32);
#pragma unroll
        for (int i = 0; i < 8; ++i) s[i] += t[i]; }
#pragma unroll
    for (int i = 0; i < 8; ++i) sc[i >> 2][i & 3] = 1.0f / sqrtf(s[i] * inv_div + EPS);
}
struct EpiScaleBf16 {
    static constexpr bool PERM = true;
    gbf16_t* O; int ldc; const gfloat* part; int npart; float inv_div; int tstride, tvalid;
    __device__ __forceinline__ void operator()(const f32x4 (&acc)[2][2][4][2], const Unit& u, int wr, int wc, int fr, int fq, LAS unsigned char*) const {
        const int row0 = u.pm * BM + wr * 64 + fr, cin = wc * 32 + 8 * fq, col0 = u.pn * tstride + cin;
        float sc[2][4]; row_scales(sc, nullptr, part, npart, inv_div, row0, fq);
#pragma unroll
        for (int ai = 0; ai < 2; ++ai)
#pragma unroll
            for (int m = 0; m < 4; ++m) { const int row = row0 + ai * HALF + m * 16; const float s = sc[ai][m]; gbf16_t* rowp = O + (size_t)row * ldc + col0;
#pragma unroll
                for (int bj = 0; bj < 2; ++bj) { const f32x4 v0 = acc[ai][bj][m][0] * s, v1 = acc[ai][bj][m][1] * s;
                    u32x4 w; w.x = cvt_pk_bf16(v0[0], v0[1]); w.y = cvt_pk_bf16(v0[2], v0[3]); w.z = cvt_pk_bf16(v1[0], v1[1]); w.w = cvt_pk_bf16(v1[2], v1[3]);
                    if (cin + bj * HALF < tvalid) *(gu32x4*)(rowp + bj * HALF) = w; } }
    }
};
struct EpiInProj {
    static constexpr bool PERM = true;
    gbf16_t* O; const gfloat* part; gfloat* rqp; gfloat* rkvp; gfloat* krss; const gfloat* COS; const gfloat* SIN; const gfloat* gdq; const gfloat* gdk;
    __device__ __forceinline__ void operator()(const f32x4 (&acc)[2][2][4][2], const Unit& u, int wr, int wc, int fr, int fq, LAS unsigned char*) const {
        const int row0 = u.pm * BM + wr * 64 + fr, cin = wc * 32 + 8 * fq;
        float sc[2][4]; row_scales(sc, nullptr, part, 16, 1.0f / DM, row0, fq);
        if (u.pn >= 2 && u.pn < 6) {
            const gfloat* gp = (u.pn < 4 ? gdq : gdk) + 8 * fq; const float post = u.pn < 4 ? CD : 1.0f;
            const f32x4 gl0 = *(const gf32x4*)gp, gl1 = *(const gf32x4*)(gp + 4), gh0 = *(const gf32x4*)(gp + 32), gh1 = *(const gf32x4*)(gp + 36);
#pragma unroll
            for (int ai = 0; ai < 2; ++ai)
#pragma unroll
                for (int m = 0; m < 4; ++m) { const int row = row0 + ai * HALF + m * 16, pos = NMETA + (row & (SEQ - 1)); const float s = sc[ai][m];
                    f32x4 l0 = acc[ai][0][m][0] * s, l1 = acc[ai][0][m][1] * s, h0 = acc[ai][1][m][0] * s, h1 = acc[ai][1][m][1] * s;
                    float q = (((l0[0] * l0[0] + l0[1] * l0[1]) + (l0[2] * l0[2] + l0[3] * l0[3])) + ((l1[0] * l1[0] + l1[1] * l1[1]) + (l1[2] * l1[2] + l1[3] * l1[3])))
                            + (((h0[0] * h0[0] + h0[1] * h0[1]) + (h0[2] * h0[2] + h0[3] * h0[3])) + ((h1[0] * h1[0] + h1[1] * h1[1]) + (h1[2] * h1[2] + h1[3] * h1[3])));
                    q += __shfl_xor(q, 16); q += __shfl_xor(q, 32);
                    const float r = 1.0f / sqrtf(q * (1.0f / 64.0f) + EPS);
                    const f32x4 c0 = *(const gf32x4*)(COS + pos * 32 + 8 * fq), c1 = *(const gf32x4*)(COS + pos * 32 + 8 * fq + 4), s0 = *(const gf32x4*)(SIN + pos * 32 + 8 * fq), s1 = *(const gf32x4*)(SIN + pos * 32 + 8 * fq + 4);
                    l0 = l0 * r * gl0; l1 = l1 * r * gl1; h0 = h0 * r * gh0; h1 = h1 * r * gh1;
                    const f32x4 ol0 = (l0 * c0 - h0 * s0) * post, ol1 = (l1 * c1 - h1 * s1) * post, oh0 = (h0 * c0 + l0 * s0) * post, oh1 = (h1 * c1 + l1 * s1) * post;
                    gbf16_t* rowp = O + (size_t)row * INWP + u.pn * BM + 64 * wc + 8 * fq;
                    u32x4 w; w.x = cvt_pk_bf16(ol0[0], ol0[1]); w.y = cvt_pk_bf16(ol0[2], ol0[3]); w.z = cvt_pk_bf16(ol1[0], ol1[1]); w.w = cvt_pk_bf16(ol1[2], ol1[3]);
                    *(gu32x4*)rowp = w;
                    w.x = cvt_pk_bf16(oh0[0], oh0[1]); w.y = cvt_pk_bf16(oh0[2], oh0[3]); w.z = cvt_pk_bf16(oh1[0], oh1[1]); w.w = cvt_pk_bf16(oh1[2], oh1[3]);
                    *(gu32x4*)(rowp + 32) = w;
                    asm volatile("" ::: "memory"); }
            return;
        }
#pragma unroll
        for (int ai = 0; ai < 2; ++ai)
#pragma unroll
            for (int m = 0; m < 4; ++m) { const int row = row0 + ai * HALF + m * 16; const float s = sc[ai][m]; gbf16_t* rowp = O + (size_t)row * INWP + u.pn * BM + cin; float q[2];
#pragma unroll
                for (int bj = 0; bj < 2; ++bj) { const f32x4 v0 = acc[ai][bj][m][0] * s, v1 = acc[ai][bj][m][1] * s;
                    u32x4 w; w.x = cvt_pk_bf16(v0[0], v0[1]); w.y = cvt_pk_bf16(v0[2], v0[3]); w.z = cvt_pk_bf16(v1[0], v1[1]); w.w = cvt_pk_bf16(v1[2], v1[3]);
                    *(gu32x4*)(rowp + bj * HALF) = w;
                    q[bj] = ((v0[0] * v0[0] + v0[1] * v0[1]) + (v0[2] * v0[2] + v0[3] * v0[3])) + ((v1[0] * v1[0] + v1[1] * v1[1]) + (v1[2] * v1[2] + v1[3] * v1[3])); }
                if (u.pn < 2) {
                    q[0] += __shfl_xor(q[0], 16); q[0] += __shfl_xor(q[0], 32); q[1] += __shfl_xor(q[1], 16); q[1] += __shfl_xor(q[1], 32);
                    if (fq == 0) { if (u.pn == 0) rqp[(size_t)row * 4 + wc] = q[0] + q[1];
                                   else { rkvp[(size_t)row * 4 + wc] = q[0]; if (wc < 2) krss[(size_t)row * 2 + wc] = q[1]; } } } }
    }
};
__device__ __forceinline__ float silu_mul(float g, float u) { const float e = __builtin_amdgcn_exp2f(-g * LOG2E); return g * __builtin_amdgcn_rcpf(1.0f + e) * u; }
typedef float f32x2 __attribute__((ext_vector_type(2)));
__device__ __forceinline__ f32x2 swiglu_pk(f32x2 g, f32x2 u, float ks, float s2) {
    const f32x2 a = g * ks; f32x2 e; e.x = __builtin_amdgcn_exp2f(a.x); e.y = __builtin_amdgcn_exp2f(a.y);
    const f32x2 d = e + 1.0f; f32x2 r; r.x = __builtin_amdgcn_rcpf(d.x); r.y = __builtin_amdgcn_rcpf(d.y);
    return (g * u) * (r * s2);
}
struct EpiSwiglu {
    static constexpr bool PERM = true;
    gbf16_t* O; int ldc; const gfloat* rs; const gfloat* part;
    __device__ __forceinline__ void operator()(const f32x4 (&acc)[2][2][4][2], const Unit& u, int wr, int wc, int fr, int fq, LAS unsigned char*) const {
        const int row0 = u.pm * BM + wr * 64 + fr, col0 = u.pn * HALF + wc * 32 + 8 * fq;
        float sc[2][4]; row_scales(sc, rs, part, 16, 1.0f / DM, row0, fq);
#pragma unroll
        for (int ai = 0; ai < 2; ++ai)
#pragma unroll
            for (int m = 0; m < 4; ++m) { const int row = row0 + ai * HALF + m * 16; const float s = sc[ai][m], ks = -s * LOG2E, s2 = s * s;
                u32x4 w;
#pragma unroll
                for (int n = 0; n < 2; ++n) { const f32x4 g = acc[ai][0][m][n], uu = acc[ai][1][m][n];
                    const f32x2 o0 = swiglu_pk((f32x2){g[0], g[1]}, (f32x2){uu[0], uu[1]}, ks, s2), o1 = swiglu_pk((f32x2){g[2], g[3]}, (f32x2){uu[2], uu[3]}, ks, s2);
                    w[2 * n] = cvt_pk_bf16(o0.x, o0.y); w[2 * n + 1] = cvt_pk_bf16(o1.x, o1.y); }
                *(gu32x4*)(O + (size_t)row * ldc + col0) = w; }
    }
};
template <bool LAST> struct EpiResidual {
    static constexpr bool PERM = true;
    const gbf16_t* hsrc; gbf16_t* hdst; gfloat* part; gfloat* out;
    __device__ __forceinline__ void operator()(const f32x4 (&acc)[2][2][4][2], const Unit& u, int wr, int wc, int fr, int fq, LAS unsigned char*) const {
        const int row0 = u.pm * BM + wr * 64 + fr, col0 = u.pn * BM + wc * 32 + 8 * fq;
#pragma unroll
        for (int ai = 0; ai < 2; ++ai) {
            u32x4 hv[4][2];
#pragma unroll
            for (int m = 0; m < 4; ++m)
#pragma unroll
                for (int bj = 0; bj < 2; ++bj) hv[m][bj] = *(const gu32x4*)(hsrc + (size_t)(row0 + ai * HALF + m * 16) * DM + col0 + bj * HALF);
            __builtin_amdgcn_sched_barrier(0);
#pragma unroll
            for (int m = 0; m < 4; ++m) { const int row = row0 + ai * HALF + m * 16;
                float q = 0.f;
#pragma unroll
                for (int bj = 0; bj < 2; ++bj) { float x[8]; unpack8(hv[m][bj], x);
                    const f32x4 h0 = (f32x4){x[0], x[1], x[2], x[3]} + acc[ai][bj][m][0], h1 = (f32x4){x[4], x[5], x[6], x[7]} + acc[ai][bj][m][1];
                    if (LAST) { gfloat* o = out + (size_t)row * DM + col0 + bj * HALF; *(gf32x4*)o = h0; *(gf32x4*)(o + 4) = h1; }
                    else { u32x4 w; w.x = cvt_pk_bf16(h0[0], h0[1]); w.y = cvt_pk_bf16(h0[2], h0[3]); w.z = cvt_pk_bf16(h1[0], h1[1]); w.w = cvt_pk_bf16(h1[2], h1[3]);
                           *(gu32x4*)(hdst + (size_t)row * DM + col0 + bj * HALF) = w;
                           q += ((h0[0] * h0[0] + h0[1] * h0[1]) + (h0[2] * h0[2] + h0[3] * h0[3])) + ((h1[0] * h1[0] + h1[1] * h1[1]) + (h1[2] * h1[2] + h1[3] * h1[3])); } }
                if (!LAST) { q += __shfl_xor(q, 16); q += __shfl_xor(q, 32);
                    if (fq == 0) part[(size_t)row * 16 + u.pn * 4 + wc] = q; } }
            __builtin_amdgcn_sched_barrier(0); }
    }
};

struct EpiKV {
    static constexpr bool PERM = true;
    gbf16_t* KA; gbf16_t* KV; const gbf16_t* PROJ; const gfloat* rkvp; const gfloat* krss; const gfloat* COS; const gfloat* SIN; const gfloat* gk;
    __device__ __forceinline__ void operator()(const f32x4 (&acc)[2][2][4][2], const Unit& u, int wr, int wc, int fr, int fq, LAS unsigned char* lds) const {
        const int row0 = u.pm * BM + wr * 64 + fr, h = u.pn, c8 = wc * 32 + 8 * fq;
        LAS float* xch = (LAS float*)(lds + STAGE_BYTES);
        float sc[2][4]; row_scales(sc, nullptr, rkvp, 4, 1.0f / 128.0f, row0, fq);
#pragma unroll
        for (int ai = 0; ai < 2; ++ai)
#pragma unroll
            for (int m = 0; m < 4; ++m) { const float s = sc[ai][m]; const f32x4 v0 = acc[ai][0][m][0] * s, v1 = acc[ai][0][m][1] * s;
                float q = ((v0[0] * v0[0] + v0[1] * v0[1]) + (v0[2] * v0[2] + v0[3] * v0[3])) + ((v1[0] * v1[0] + v1[1] * v1[1]) + (v1[2] * v1[2] + v1[3] * v1[3]));
                q += __shfl_xor(q, 16); q += __shfl_xor(q, 32);
                if (fq == 0) xch[(ai * HALF + wr * 64 + m * 16 + fr) * 4 + wc] = q; }
        asm volatile("s_waitcnt lgkmcnt(0)" ::: "memory"); __builtin_amdgcn_s_barrier(); asm volatile("" ::: "memory");
        f32x4 g0 = *(const gf32x4*)(gk + c8), g1 = *(const gf32x4*)(gk + c8 + 4);
        const int t = wc * 4 + fq, tp = (t + 8) & 15;
        const f32x4 gr = *(const gf32x4*)(gk + 128 + 4 * t), gp = *(const gf32x4*)(gk + 128 + 4 * tp);
#pragma unroll
        for (int am = 0; am < 4; ++am) { const int ai = am >> 1, m0 = (am & 1) * 2;
            float kq[4]; u32x2 ka[4], kb[4]; f32x4 cs[4], sn[4];
#pragma unroll
            for (int m = m0; m < m0 + 2; ++m) { const int row = u.pm * BM + ai * HALF + wr * 64 + m * 16 + fr, pos = NMETA + (row & (SEQ - 1));
                kq[m] = krss[(size_t)row * 2] + krss[(size_t)row * 2 + 1];
                ka[m] = *(const gu32x2*)(PROJ + (size_t)row * INWP + PC_KR + 4 * t); kb[m] = *(const gu32x2*)(PROJ + (size_t)row * INWP + PC_KR + 4 * tp);
                cs[m] = *(const gf32x4*)(COS + pos * 32 + ((4 * t) & 31)); sn[m] = *(const gf32x4*)(SIN + pos * 32 + ((4 * t) & 31)); }
            __builtin_amdgcn_sched_barrier(0);
#pragma unroll
            for (int m = m0; m < m0 + 2; ++m) { const int rl = ai * HALF + wr * 64 + m * 16 + fr, row = u.pm * BM + rl; const float s = sc[ai][m];
                const f32x4 px = *(const LAS f32x4*)(xch + rl * 4);
                const float r = 1.0f / sqrtf((((px[0] + px[1]) + (px[2] + px[3])) + kq[m]) * (1.0f / 192.0f) + EPS);
                { const f32x4 v0 = acc[ai][0][m][0] * (s * r) * g0, v1 = acc[ai][0][m][1] * (s * r) * g1;
                  u32x4 w; w.x = cvt_pk_bf16(v0[0], v0[1]); w.y = cvt_pk_bf16(v0[2], v0[3]); w.z = cvt_pk_bf16(v1[0], v1[1]); w.w = cvt_pk_bf16(v1[2], v1[3]);
                  *(gu32x4*)(KA + (size_t)row * 768 + h * 192 + c8) = w; }
                { const f32x4 v0 = acc[ai][1][m][0] * s, v1 = acc[ai][1][m][1] * s;
                  u32x4 w; w.x = cvt_pk_bf16(v0[0], v0[1]); w.y = cvt_pk_bf16(v0[2], v0[3]); w.z = cvt_pk_bf16(v1[0], v1[1]); w.w = cvt_pk_bf16(v1[2], v1[3]);
                  *(gu32x4*)(KV + (size_t)row * 1024 + h * 256 + 128 + c8) = w; }
                { const u32x2 a = ka[m], b = kb[m];
                  const f32x4 x = (f32x4){bf2f(a.x & 0xffffu), bf2f(a.x >> 16), bf2f(a.y & 0xffffu), bf2f(a.y >> 16)} * gr;
                  const f32x4 xp = (f32x4){bf2f(b.x & 0xffffu), bf2f(b.x >> 16), bf2f(b.y & 0xffffu), bf2f(b.y >> 16)} * gp;
                  const f32x4 o = (t < 8 ? x * cs[m] - xp * sn[m] : x * cs[m] + xp * sn[m]) * r;
                  *(gu32x2*)(KA + (size_t)row * 768 + h * 192 + 128 + 4 * t) = (u32x2){cvt_pk_bf16(o[0], o[1]), cvt_pk_bf16(o[2], o[3])}; } }
            __builtin_amdgcn_sched_barrier(0); }
    }
};

template <class Sched>
__device__ __forceinline__ void gemm_prefetch(LAS unsigned char* lds, const Gemm g, const Sched& S, bool perm) {
    int tid_ = threadIdx.x; asm volatile("" : "+v"(tid_));
    const int tid = tid_, wid = __builtin_amdgcn_readfirstlane(tid >> 6);
    Unit cur; if (!S.next(0, cur)) return;
    const int K = g.K, lda = g.lda;
    const size_t hstepA = (size_t)HALF * lda * 2, hstepB = (size_t)HALF * K * 2;
    const char* cA = (const char*)(const void*)g.A + (size_t)cur.pm * 2 * hstepA; const char* cB = (const char*)(const void*)g.Bt + (size_t)cur.pn * 2 * hstepB;
    const unsigned ldsw = (unsigned)wid * 1024u;
    unsigned va[2], vb[2];
#pragma unroll
    for (int i = 0; i < 2; ++i) { int R, C; stage_rc(tid * 16 + i * 8192, R, C); const int Rb = perm ? ((R & ~31) + perm32(R & 31)) : R;
        va[i] = (unsigned)(R * lda + C) * 2u; vb[i] = (unsigned)(Rb * K + C) * 2u; }
#pragma unroll
    for (int i = 0; i < 2; ++i) __builtin_amdgcn_global_load_lds((const gunsigned*)(const void*)(cB + vb[i]), (LAS unsigned*)(lds + 4 * HTB + ldsw + i * 8192), 16, 0, 0);
#pragma unroll
    for (int i = 0; i < 2; ++i) __builtin_amdgcn_global_load_lds((const gunsigned*)(const void*)(cB + hstepB + vb[i]), (LAS unsigned*)(lds + 5 * HTB + ldsw + i * 8192), 16, 0, 0);
#pragma unroll
    for (int i = 0; i < 2; ++i) __builtin_amdgcn_global_load_lds((const gunsigned*)(const void*)(cA + va[i]), (LAS unsigned*)(lds + 0 * HTB + ldsw + i * 8192), 16, 0, 0);
#pragma unroll
    for (int i = 0; i < 2; ++i) __builtin_amdgcn_global_load_lds((const gunsigned*)(const void*)(cA + hstepA + va[i]), (LAS unsigned*)(lds + 1 * HTB + ldsw + i * 8192), 16, 0, 0);
}
template <bool PRE, class Epi, class Sched>
__device__ __forceinline__ void gemm_phase(LAS unsigned char* lds, const Gemm g, const Sched& S, const Epi& E) {
    int tid_ = threadIdx.x; asm volatile("" : "+v"(tid_));
    const int tid = tid_, wid = __builtin_amdgcn_readfirstlane(tid >> 6), lane = tid & 63, wr = wid >> 2, wc = wid & 3, fr = lane & 15, fq = lane >> 4;
    const int K = g.K, nt = K / BK, lda = g.lda;
    unsigned voffA[2], voffB[2];
#pragma unroll
    for (int i = 0; i < 2; ++i) { int R, C; stage_rc(tid * 16 + i * 8192, R, C); const int Rb = Epi::PERM ? ((R & ~31) + perm32(R & 31)) : R;
        voffA[i] = (unsigned)(R * lda + C) * 2u; voffB[i] = (unsigned)(Rb * K + C) * 2u; }
    const size_t kstep = (size_t)(BK * 2);
    const size_t hstepA = (size_t)HALF * lda * 2, hstepB = (size_t)HALF * K * 2;
    const size_t tstepA = 2 * hstepA, tstepB = 2 * hstepB;
    const unsigned ldsw = (unsigned)wid * 1024u;
    const int aoff = lds_byte(wr * 64 + fr, fq * 8), boff = lds_byte(wc * 32 + fr, fq * 8);
#define PG8_SA(b, h) (((b) * 2 + (h)) * HTB)
#define PG8_SB(b, h) ((4 + (b) * 2 + (h)) * HTB)
#define PG8_STAGE(bufoff, gbase, voff) do { _Pragma("unroll") for (int _i = 0; _i < 2; ++_i) \
        __builtin_amdgcn_global_load_lds((const gunsigned*)((const gchar*)(gbase) + (voff)[_i]), (LAS unsigned*)(lds + (bufoff) + ldsw + _i * 8192), 16, 0, 0); } while (0)
#define PG8_LDA(dst, b, h) do { _Pragma("unroll") for (int m = 0; m < 4; ++m) _Pragma("unroll") for (int k = 0; k < 2; ++k) dst[m][k] = *(const LAS bf16x8*)(lds + PG8_SA(b, h) + aoff + m * 2048 + k * 1024); } while (0)
#define PG8_LDB(dst, b, h) do { _Pragma("unroll") for (int n = 0; n < 2; ++n) _Pragma("unroll") for (int k = 0; k < 2; ++k) dst[n][k] = *(const LAS bf16x8*)(lds + PG8_SB(b, h) + boff + n * 2048 + k * 1024); } while (0)
#define PG8_MMA(ai, bj, At, Bt) do { __builtin_amdgcn_s_setprio(1); _Pragma("unroll") for (int m = 0; m < 4; ++m) _Pragma("unroll") for (int n = 0; n < 2; ++n) _Pragma("unroll") for (int k = 0; k < 2; ++k) \
        acc[ai][bj][m][n] = __builtin_amdgcn_mfma_f32_16x16x32_bf16(Bt[n][k], At[m][k], acc[ai][bj][m][n], 0, 0, 0); __builtin_amdgcn_s_setprio(0); } while (0)
#define PG8_WAIT_V(n) asm volatile("s_waitcnt vmcnt(" #n ")" ::: "memory")
#define PG8_WAIT_L(n) asm volatile("s_waitcnt lgkmcnt(" #n ")" ::: "memory")
#define PG8_BAR __builtin_amdgcn_s_barrier()
#define PG8_SCHED __builtin_amdgcn_sched_barrier(0)
    Unit cur, nxt; int ui = 0;
    if (!S.next(0, cur)) return;
    f32x4 acc[2][2][4][2];
#pragma unroll
    for (int a = 0; a < 2; ++a)
#pragma unroll
        for (int b = 0; b < 2; ++b)
#pragma unroll
            for (int m = 0; m < 4; ++m)
#pragma unroll
                for (int n = 0; n < 2; ++n) acc[a][b][m][n] = (f32x4){0.f, 0.f, 0.f, 0.f};
    bf16x8 At[4][2], B0[2][2], B1[2][2];
    const gchar* cA = (const gchar*)g.A + (size_t)cur.pm * tstepA; const gchar* cB = (const gchar*)g.Bt + (size_t)cur.pn * tstepB;
    if constexpr (!PRE) { PG8_STAGE(PG8_SB(0, 0), cB, voffB); PG8_STAGE(PG8_SB(0, 1), cB + hstepB, voffB); PG8_STAGE(PG8_SA(0, 0), cA, voffA); PG8_STAGE(PG8_SA(0, 1), cA + hstepA, voffA); }
    if (wr == 1) PG8_BAR;
    PG8_WAIT_V(2); PG8_BAR;
    PG8_STAGE(PG8_SB(1, 0), cB + kstep, voffB); PG8_STAGE(PG8_SA(1, 0), cA + kstep, voffA); PG8_STAGE(PG8_SB(1, 1), cB + hstepB + kstep, voffB);
    PG8_WAIT_V(6); PG8_BAR;
    for (;;) {
        const bool has_next = S.next(ui + 1, nxt);
        const gchar* nA = has_next ? (const gchar*)g.A + (size_t)nxt.pm * tstepA : cA; const gchar* nB = has_next ? (const gchar*)g.Bt + (size_t)nxt.pn * tstepB : cB;
        for (int t = 0; t < nt; t += 2) {
            const bool last = (t == nt - 2);
            const gchar* a1 = cA + (size_t)(t + 1) * kstep;
            const gchar* a2 = last ? nA : cA + (size_t)(t + 2) * kstep; const gchar* b2 = last ? nB : cB + (size_t)(t + 2) * kstep;
            const gchar* a3 = a2 + kstep; const gchar* b3 = b2 + kstep;
            PG8_LDB(B0, 0, 0); PG8_LDB(B1, 0, 1); PG8_SCHED; PG8_LDA(At, 0, 0); PG8_STAGE(PG8_SA(1, 1), a1 + hstepA, voffA);
            PG8_WAIT_V(8); PG8_WAIT_L(0); PG8_BAR; PG8_MMA(0, 0, At, B0); PG8_MMA(0, 1, At, B1); PG8_BAR; PG8_SCHED;
            PG8_LDA(At, 0, 1); PG8_STAGE(PG8_SB(0, 0), b2, voffB); PG8_STAGE(PG8_SB(0, 1), b2 + hstepB, voffB); PG8_STAGE(PG8_SA(0, 0), a2, voffA);
            PG8_WAIT_V(8); PG8_WAIT_L(0); PG8_BAR; PG8_MMA(1, 0, At, B0); PG8_MMA(1, 1, At, B1); PG8_BAR; PG8_SCHED;
            PG8_LDB(B0, 1, 0); PG8_LDB(B1, 1, 1); PG8_SCHED; PG8_LDA(At, 1, 0); PG8_STAGE(PG8_SA(0, 1), a2 + hstepA, voffA);
            PG8_WAIT_V(8); PG8_WAIT_L(0); PG8_BAR; PG8_MMA(0, 0, At, B0); PG8_MMA(0, 1, At, B1); PG8_BAR; PG8_SCHED;
            PG8_LDA(At, 1, 1); PG8_STAGE(PG8_SB(1, 0), b3, voffB); PG8_STAGE(PG8_SB(1, 1), b3 + hstepB, voffB); PG8_STAGE(PG8_SA(1, 0), a3, voffA);
            PG8_WAIT_V(8); PG8_WAIT_L(0); PG8_BAR; PG8_MMA(1, 0, At, B0); PG8_MMA(1, 1, At, B1); PG8_BAR; PG8_SCHED;
        }
        if (wr == 0) PG8_BAR;
        { Unit ue = cur; int fr_ = fr, fq_ = fq; asm volatile("" : "+s"(ue.pm), "+s"(ue.pn), "+v"(fr_), "+v"(fq_));
          E(acc, ue, wr, wc, fr_, fq_, lds); }
        if (!has_next) break;
#pragma unroll
        for (int a = 0; a < 2; ++a)
#pragma unroll
            for (int b = 0; b < 2; ++b)
#pragma unroll
                for (int m = 0; m < 4; ++m)
#pragma unroll
                    for (int n = 0; n < 2; ++n) acc[a][b][m][n] = (f32x4){0.f, 0.f, 0.f, 0.f};
        cur = nxt; cA = nA; cB = nB; ++ui;
        if (wr == 1) PG8_BAR;
    }
    PG8_WAIT_V(0);
    PG8_BAR;
#undef PG8_SA
#undef PG8_SB
#undef PG8_STAGE
#undef PG8_LDA
#undef PG8_LDB
#undef PG8_MMA
#undef PG8_WAIT_V
#undef PG8_WAIT_L
#undef PG8_BAR
#undef PG8_SCHED
}
}

namespace att {
#define SBAR() __builtin_amdgcn_sched_barrier(0)
constexpr int RING_BYTES = 139264, OFF_WS = RING_BYTES, OFF_GQ = OFF_WS + 8 * 64 * 4  , ATT_LDS = OFF_GQ + 192 * 4;
template <int N> __device__ __forceinline__ void wait_vm_lgkm0() { asm volatile("s_waitcnt vmcnt(%0) lgkmcnt(0)" :: "n"(N) : "memory"); }
__device__ __forceinline__ int crow(int r, int hi) { return (r & 3) + 8 * (r >> 2) + 4 * hi; }
__device__ __forceinline__ int v_st(int k, int c) { const int kk = (k & ~0xC) | ((k & 4) << 1) | ((k & 8) >> 1); return ((kk >> 3) * 4 + (c >> 5)) * 512 + ((kk & 7) * 32 + (c & 31)) * 2; }
__device__ __forceinline__ int v_rd_base(int lane) { return ((lane & 3) << 3) | (((lane >> 2) & 3) << 6) | (((lane >> 4) & 1) << 5) | (((lane >> 5) & 1) << 8); }
constexpr int v_rd_off(int d0, int ks, int half) { return d0 * 512 + ks * 4096 + half * 2048; }
template <int OFF> __device__ __forceinline__ s16x4 tr_read(int vb) {
    s16x4 r; asm volatile("ds_read_b64_tr_b16 %0, %1 offset:%2" : "=&v"(r) : "v"(vb), "i"(OFF) : "memory"); return r;
}
template <int OFF> __device__ __forceinline__ bf16x8 lds_read128(int base) {
    bf16x8 r; asm volatile("ds_read_b128 %0, %1 offset:%2" : "=&v"(r) : "v"(base), "i"(OFF) : "memory"); return r;
}
template <int N> __device__ __forceinline__ void wait_lgkm() { asm volatile("s_waitcnt lgkmcnt(%0)" :: "n"(N) : "memory"); }
template <int D0> __device__ __forceinline__ void pv_reads(s16x4 (&lo)[4], s16x4 (&hi)[4], int vb) {
    lo[0] = tr_read<v_rd_off(D0, 0, 0)>(vb); hi[0] = tr_read<v_rd_off(D0, 0, 1)>(vb); lo[1] = tr_read<v_rd_off(D0, 1, 0)>(vb); hi[1] = tr_read<v_rd_off(D0, 1, 1)>(vb);
    lo[2] = tr_read<v_rd_off(D0, 2, 0)>(vb); hi[2] = tr_read<v_rd_off(D0, 2, 1)>(vb); lo[3] = tr_read<v_rd_off(D0, 3, 0)>(vb); hi[3] = tr_read<v_rd_off(D0, 3, 1)>(vb);
}
__device__ __forceinline__ void pv_mma(f32x16& od, const s16x4 (&lo)[4], const s16x4 (&hi)[4], bf16x8 pa0, bf16x8 pa1, bf16x8 pa2, bf16x8 pa3) {
#define PK(L, H) (bf16x8){L[0], L[1], L[2], L[3], H[0], H[1], H[2], H[3]}
    od = __builtin_amdgcn_mfma_f32_32x32x16_bf16(pa0, PK(lo[0], hi[0]), od, 0, 0, 0);
    od = __builtin_amdgcn_mfma_f32_32x32x16_bf16(pa1, PK(lo[1], hi[1]), od, 0, 0, 0);
    od = __builtin_amdgcn_mfma_f32_32x32x16_bf16(pa2, PK(lo[2], hi[2]), od, 0, 0, 0);
    od = __builtin_amdgcn_mfma_f32_32x32x16_bf16(pa3, PK(lo[3], hi[3]), od, 0, 0, 0);
#undef PK
}
__device__ __forceinline__ void pv_all(f32x16 (&o)[4], int vb, bf16x8 pa0, bf16x8 pa1, bf16x8 pa2, bf16x8 pa3) {
    s16x4 la[4], ha[4], lb[4], hb[4];
    pv_reads<0>(la, ha, vb);
    pv_reads<1>(lb, hb, vb); wait_lgkm<8>(); SBAR(); pv_mma(o[0], la, ha, pa0, pa1, pa2, pa3); SBAR();
    pv_reads<2>(la, ha, vb); wait_lgkm<8>(); SBAR(); pv_mma(o[1], lb, hb, pa0, pa1, pa2, pa3); SBAR();
    pv_reads<3>(lb, hb, vb); wait_lgkm<8>(); SBAR(); pv_mma(o[2], la, ha, pa0, pa1, pa2, pa3); SBAR();
    wait_lgkm<0>(); SBAR(); pv_mma(o[3], lb, hb, pa0, pa1, pa2, pa3);
}
template <int C> __device__ __forceinline__ void sm_chunk4(const f32x16& P, float& ps, unsigned (&pw)[16]) {
    constexpr int B = (C & 3) * 4;
    const float e0 = __builtin_amdgcn_exp2f(P[B]), e1 = __builtin_amdgcn_exp2f(P[B + 1]), e2 = __builtin_amdgcn_exp2f(P[B + 2]), e3 = __builtin_amdgcn_exp2f(P[B + 3]);
    ps += (e0 + e1) + (e2 + e3);
    pw[2 * C] = cvt_pk_bf16(e0, e1); pw[2 * C + 1] = cvt_pk_bf16(e2, e3);
}
template <int D0, int KH> __device__ __forceinline__ void pv_reads_h(s16x4 (&lo)[2], s16x4 (&hi)[2], int vb) {
    lo[0] = tr_read<v_rd_off(D0, 2 * KH, 0)>(vb); hi[0] = tr_read<v_rd_off(D0, 2 * KH, 1)>(vb); lo[1] = tr_read<v_rd_off(D0, 2 * KH + 1, 0)>(vb); hi[1] = tr_read<v_rd_off(D0, 2 * KH + 1, 1)>(vb);
}
__device__ __forceinline__ void pv_mma_h(f32x16& od, const s16x4 (&lo)[2], const s16x4 (&hi)[2], bf16x8 a, bf16x8 b) {
#define PK(L, H) (bf16x8){L[0], L[1], L[2], L[3], H[0], H[1], H[2], H[3]}
    od = __builtin_amdgcn_mfma_f32_32x32x16_bf16(a, PK(lo[0], hi[0]), od, 0, 0, 0);
    od = __builtin_amdgcn_mfma_f32_32x32x16_bf16(b, PK(lo[1], hi[1]), od, 0, 0, 0);
#undef PK
}
#define ATT_SGB() do { _Pragma("unroll") for (int i_ = 0; i_ < 2; ++i_) { __builtin_amdgcn_sched_group_barrier(0x008, 1, 0); __builtin_amdgcn_sched_group_barrier(0x402, 5, 0); } } while (0)
__device__ __forceinline__ void pv_sm_all(f32x16 (&o)[4], int vb, bf16x8 pa0, bf16x8 pa1, bf16x8 pa2, bf16x8 pa3, const f32x16& p0, const f32x16& p1, float& ps, unsigned (&pw)[16]) {
    s16x4 la[2], ha[2], lb[2], hb[2];
    pv_reads_h<0, 0>(la, ha, vb);
    pv_reads_h<0, 1>(lb, hb, vb); wait_lgkm<4>(); SBAR(); pv_mma_h(o[0], la, ha, pa0, pa1); sm_chunk4<0>(p0, ps, pw); ATT_SGB(); SBAR();
    pv_reads_h<1, 0>(la, ha, vb); wait_lgkm<4>(); SBAR(); pv_mma_h(o[0], lb, hb, pa2, pa3); sm_chunk4<1>(p0, ps, pw); ATT_SGB(); SBAR();
    pv_reads_h<1, 1>(lb, hb, vb); wait_lgkm<4>(); SBAR(); pv_mma_h(o[1], la, ha, pa0, pa1); sm_chunk4<2>(p0, ps, pw); ATT_SGB(); SBAR();
    pv_reads_h<2, 0>(la, ha, vb); wait_lgkm<4>(); SBAR(); pv_mma_h(o[1], lb, hb, pa2, pa3); sm_chunk4<3>(p0, ps, pw); ATT_SGB(); SBAR();
    pv_reads_h<2, 1>(lb, hb, vb); wait_lgkm<4>(); SBAR(); pv_mma_h(o[2], la, ha, pa0, pa1); sm_chunk4<4>(p1, ps, pw); ATT_SGB(); SBAR();
    pv_reads_h<3, 0>(la, ha, vb); wait_lgkm<4>(); SBAR(); pv_mma_h(o[2], lb, hb, pa2, pa3); sm_chunk4<5>(p1, ps, pw); ATT_SGB(); SBAR();
    pv_reads_h<3, 1>(lb, hb, vb); wait_lgkm<4>(); SBAR(); pv_mma_h(o[3], la, ha, pa0, pa1); sm_chunk4<6>(p1, ps, pw); ATT_SGB(); SBAR();
    wait_lgkm<0>(); SBAR(); pv_mma_h(o[3], lb, hb, pa2, pa3); sm_chunk4<7>(p1, ps, pw); ATT_SGB(); SBAR();
}
template <int NKP> struct DmaCtx { LAS char* kdst; LAS char* vdst; size_t kstride, vstride; bool on; };
template <int DQK> __device__ __forceinline__ constexpr int dma_piece_after(int g) { return DQK == 192 ? (((g & 1) && g < 10) ? (g >> 1) : -1) : (g < 3 ? g : -1); }
template <int NKP, int I> __device__ __forceinline__ void dma_piece(const DmaCtx<NKP>& dc, const gbf16_t* (&kp1)[NKP], const gbf16_t* (&vp1)[2], int wid) {
    if (dc.on) {
        if constexpr (I < NKP) { __builtin_amdgcn_global_load_lds((const gunsigned*)kp1[I], (LAS unsigned*)(dc.kdst + (wid + 8 * I) * 1024), 16, 0, 0); kp1[I] += dc.kstride; }
        else { __builtin_amdgcn_global_load_lds((const gunsigned*)vp1[I - NKP], (LAS unsigned*)(dc.vdst + (wid + 8 * (I - NKP)) * 1024), 16, 0, 0); vp1[I - NKP] += dc.vstride; }
    }
}
template <int DQK, int G, int NKP> __device__ __forceinline__ void qk_step(f32x16& p0, f32x16& p1, bf16x8 (&kf)[2][2], const int (&kb)[4], const bf16x8 (&qr)[DQK / 16],
                                                                           const DmaCtx<NKP>& dc, const gbf16_t* (&kp1)[NKP], const gbf16_t* (&vp1)[2], int wid) {
    constexpr int ND = DQK / 16, RB = DQK * 2;
    if constexpr (G + 1 < ND) { kf[(G + 1) & 1][0] = lds_read128<((G + 1) >> 2) * 128>(kb[(G + 1) & 3]); kf[(G + 1) & 1][1] = lds_read128<((G + 1) >> 2) * 128 + 32 * RB>(kb[(G + 1) & 3]); wait_lgkm<2>(); }
    else { wait_lgkm<0>(); }
    SBAR();
    p0 = __builtin_amdgcn_mfma_f32_32x32x16_bf16(kf[G & 1][0], qr[G], p0, 0, 0, 0); p1 = __builtin_amdgcn_mfma_f32_32x32x16_bf16(kf[G & 1][1], qr[G], p1, 0, 0, 0);
    SBAR();
    if constexpr (dma_piece_after<DQK>(G) >= 0) { dma_piece<NKP, dma_piece_after<DQK>(G)>(dc, kp1, vp1, wid); SBAR(); }
    if constexpr (G + 1 < ND) qk_step<DQK, G + 1, NKP>(p0, p1, kf, kb, qr, dc, kp1, vp1, wid);
}
template <int DQK, int NKP> __device__ __forceinline__ void qkt_tile_n(f32x16& p0, f32x16& p1, const int (&kb)[4], const bf16x8 (&qr)[DQK / 16],
                                                                      const DmaCtx<NKP>& dc, const gbf16_t* (&kp1)[NKP], const gbf16_t* (&vp1)[2], int wid) {
    p0 = f32x16{}; p1 = f32x16{};
    bf16x8 kf[2][2];
    SBAR(); kf[0][0] = lds_read128<0>(kb[0]); kf[0][1] = lds_read128<32 * DQK * 2>(kb[0]);
    qk_step<DQK, 0, NKP>(p0, p1, kf, kb, qr, dc, kp1, vp1, wid);
}
template <int RB, int G> __device__ __forceinline__ void k_reads(bf16x8 (&dst)[4], const int (&kb)[4]) {
    dst[0] = lds_read128<((2 * G) >> 2) * 128>(kb[(2 * G) & 3]);         dst[1] = lds_read128<((2 * G) >> 2) * 128 + 32 * RB>(kb[(2 * G) & 3]);
    dst[2] = lds_read128<((2 * G + 1) >> 2) * 128>(kb[(2 * G + 1) & 3]); dst[3] = lds_read128<((2 * G + 1) >> 2) * 128 + 32 * RB>(kb[(2 * G + 1) & 3]);
}
template <int DQK, int G> __device__ __forceinline__ void qk_group(f32x16& p0, f32x16& p1, bf16x8 (&kf)[2][4], const int (&kb)[4], const bf16x8 (&qr)[DQK / 16]) {
    constexpr int NG = DQK / 32, RB = DQK * 2;
    if constexpr (G + 1 < NG) { k_reads<RB, G + 1>(kf[(G + 1) & 1], kb); wait_lgkm<4>(); } else { wait_lgkm<0>(); }
    SBAR();
    p0 = __builtin_amdgcn_mfma_f32_32x32x16_bf16(kf[G & 1][0], qr[2 * G], p0, 0, 0, 0);     p1 = __builtin_amdgcn_mfma_f32_32x32x16_bf16(kf[G & 1][1], qr[2 * G], p1, 0, 0, 0);
    p0 = __builtin_amdgcn_mfma_f32_32x32x16_bf16(kf[G & 1][2], qr[2 * G + 1], p0, 0, 0, 0); p1 = __builtin_amdgcn_mfma_f32_32x32x16_bf16(kf[G & 1][3], qr[2 * G + 1], p1, 0, 0, 0);
    SBAR();
    if constexpr (G + 1 < NG) qk_group<DQK, G + 1>(p0, p1, kf, kb, qr);
}
template <int DQK> __device__ __forceinline__ void qkt_tile(f32x16& p0, f32x16& p1, const int (&kb)[4], const bf16x8 (&qr)[DQK / 16]) {
    p0 = f32x16{}; p1 = f32x16{};
    if constexpr (false && DQK == 64) {
        bf16x8 kf[4];
        SBAR(); k_reads<128, 0>(kf, kb); wait_lgkm<0>(); SBAR();
        p0 = __builtin_amdgcn_mfma_f32_32x32x16_bf16(kf[0], qr[0], p0, 0, 0, 0); p1 = __builtin_amdgcn_mfma_f32_32x32x16_bf16(kf[1], qr[0], p1, 0, 0, 0);
        p0 = __builtin_amdgcn_mfma_f32_32x32x16_bf16(kf[2], qr[1], p0, 0, 0, 0); p1 = __builtin_amdgcn_mfma_f32_32x32x16_bf16(kf[3], qr[1], p1, 0, 0, 0);
        SBAR(); k_reads<128, 1>(kf, kb); wait_lgkm<0>(); SBAR();
        p0 = __builtin_amdgcn_mfma_f32_32x32x16_bf16(kf[0], qr[2], p0, 0, 0, 0); p1 = __builtin_amdgcn_mfma_f32_32x32x16_bf16(kf[1], qr[2], p1, 0, 0, 0);
        p0 = __builtin_amdgcn_mfma_f32_32x32x16_bf16(kf[2], qr[3], p0, 0, 0, 0); p1 = __builtin_amdgcn_mfma_f32_32x32x16_bf16(kf[3], qr[3], p1, 0, 0, 0);
        SBAR();
    } else {
        bf16x8 kf[2][4];
        SBAR(); k_reads<DQK * 2, 0>(kf[0], kb);
        qk_group<DQK, 0>(p0, p1, kf, kb, qr);
    }
}
__device__ __forceinline__ int key_row(int b, int p) { p = p < LSEQ ? p : LSEQ - 1; return p < NMETA ? NREAL + p : b * SEQ + p - NMETA; }

constexpr float THR = 6.0f;
constexpr float SCORE_BOUND_OK = 64.0f;
template <int DQK, bool QXF = false, bool NOMAX = false>
__device__ __forceinline__ void attn_map(const gbf16_t* __restrict__ Qp, int ldq, const gbf16_t* __restrict__ Kp, int ldk, const gbf16_t* __restrict__ Vp, int ldv,
                                         int b, int qpos0, int NT, f32x16 (&o)[4], float& l_out, LAS char* lds, void* probe_ptr = nullptr,
                                         const gfloat* gq = nullptr, const gfloat* COS = nullptr, const gfloat* SIN = nullptr) {
    constexpr int RB = DQK * 2, ND = DQK / 16, NKP = (64 * RB / 1024) / 8;
    constexpr int KSLOT = 64 * RB, DEPTH_ = DQK == 192 ? 2 : 4, NKS = DEPTH_ + 1, NVS = DEPTH_ + 2, NP = NKP + 2, OFF_K = 0, OFF_V = NKS * KSLOT;
    static_assert(OFF_V + NVS * 16384 <= RING_BYTES, "attention rings");
    int tid_ = threadIdx.x; asm volatile("" : "+v"(tid_));
    const int tid = tid_, wid = __builtin_amdgcn_readfirstlane(tid >> 6), lane = tid & 63, r32 = lane & 31, hi = lane >> 5;
    LAS char* K_lds = lds + OFF_K; LAS char* V_lds = lds + OFF_V; LAS float* al_l = (LAS float*)(lds + OFF_WS) + wid * 64;
    bf16x8 qr[ND];
    const int qpos = qpos0 + wid * 32 + r32, wq_min = qpos0 + wid * 32, wq_max = wq_min + 31;
    if constexpr (!QXF) {
        const gbf16_t* Qw = Qp + (size_t)(wid * 32 + r32) * ldq + hi * 8;
#pragma unroll
        for (int d0 = 0; d0 < ND; ++d0) qr[d0] = *(const gbf16x8*)(Qw + d0 * 16);
    } else {
        static_assert(DQK == 192, "QXF is the MLA q transform");
        f32x4 cv[2][2], sv[2][2];
        { const gbf16_t* Qw = Qp + (size_t)(wid * 32 + r32) * ldq + hi * 8;
#pragma unroll
          for (int d0 = 0; d0 < ND; ++d0) qr[d0] = *(const gbf16x8*)(Qw + d0 * 16);
#pragma unroll
          for (int p = 0; p < 2; ++p) { cv[p][0] = *(const gf32x4*)(COS + qpos * 32 + 16 * p + 8 * hi); cv[p][1] = *(const gf32x4*)(COS + qpos * 32 + 16 * p + 8 * hi + 4);
              sv[p][0] = *(const gf32x4*)(SIN + qpos * 32 + 16 * p + 8 * hi); sv[p][1] = *(const gf32x4*)(SIN + qpos * 32 + 16 * p + 8 * hi + 4); } }
        SBAR();
        const LAS float* gl = (const LAS float*)(lds + OFF_GQ) + 8 * hi;
        float ssq = 0.f;
#pragma unroll
        for (int d0 = 0; d0 < ND; ++d0)
#pragma unroll
            for (int e = 0; e < 8; ++e) { const float x = bf2f((unsigned)(unsigned short)qr[d0][e]); ssq += x * x; }
        { auto rr = __builtin_amdgcn_permlane32_swap(__float_as_uint(ssq), __float_as_uint(ssq), false, false); ssq = __uint_as_float(rr[0]) + __uint_as_float(rr[1]); }
        const float r = CA / sqrtf(ssq * (1.0f / 192.0f) + EPS);
#pragma unroll
        for (int d0 = 0; d0 < 8; ++d0) { const f32x4 ga = *(const LAS f32x4*)(gl + 16 * d0), gb = *(const LAS f32x4*)(gl + 16 * d0 + 4);
            const u32x4 w = {cvt_pk_bf16(bf2f((unsigned)(unsigned short)qr[d0][0]) * r * ga[0], bf2f((unsigned)(unsigned short)qr[d0][1]) * r * ga[1]), cvt_pk_bf16(bf2f((unsigned)(unsigned short)qr[d0][2]) * r * ga[2], bf2f((unsigned)(unsigned short)qr[d0][3]) * r * ga[3]),
                             cvt_pk_bf16(bf2f((unsigned)(unsigned short)qr[d0][4]) * r * gb[0], bf2f((unsigned)(unsigned short)qr[d0][5]) * r * gb[1]), cvt_pk_bf16(bf2f((unsigned)(unsigned short)qr[d0][6]) * r * gb[2], bf2f((unsigned)(unsigned short)qr[d0][7]) * r * gb[3])};
            qr[d0] = __builtin_bit_cast(bf16x8, w); }
#pragma unroll
        for (int p = 0; p < 2; ++p) {
            const int da = 8 + p, db = 10 + p; float ya[8], yb[8], cs[8], sn[8];
            { const f32x4 ga = *(const LAS f32x4*)(gl + 16 * da), gb = *(const LAS f32x4*)(gl + 16 * da + 4), gc = *(const LAS f32x4*)(gl + 16 * db), gd = *(const LAS f32x4*)(gl + 16 * db + 4);
#pragma unroll
              for (int e = 0; e < 4; ++e) { ya[e] = bf2f((unsigned)(unsigned short)qr[da][e]) * r * ga[e]; ya[4 + e] = bf2f((unsigned)(unsigned short)qr[da][4 + e]) * r * gb[e];
                  yb[e] = bf2f((unsigned)(unsigned short)qr[db][e]) * r * gc[e]; yb[4 + e] = bf2f((unsigned)(unsigned short)qr[db][4 + e]) * r * gd[e];
                  cs[e] = cv[p][0][e]; cs[4 + e] = cv[p][1][e]; sn[e] = sv[p][0][e]; sn[4 + e] = sv[p][1][e]; } }
            u32x4 wa, wb;
#pragma unroll
            for (int e = 0; e < 4; ++e) { wa[e] = cvt_pk_bf16(ya[2 * e] * cs[2 * e] - yb[2 * e] * sn[2 * e], ya[2 * e + 1] * cs[2 * e + 1] - yb[2 * e + 1] * sn[2 * e + 1]);
                wb[e] = cvt_pk_bf16(yb[2 * e] * cs[2 * e] + ya[2 * e] * sn[2 * e], yb[2 * e + 1] * cs[2 * e + 1] + ya[2 * e + 1] * sn[2 * e + 1]); }
            qr[da] = __builtin_bit_cast(bf16x8, wa); qr[db] = __builtin_bit_cast(bf16x8, wb); }
    }
    float m_reg = -1e30f, l_reg = 0.f;
#pragma unroll
    for (int d = 0; d < 4; ++d) o[d] = f32x16{};
    const int vb0 = (int)(unsigned)(uintptr_t)V_lds + v_rd_base(lane);
    int NTw = wq_max / 64 + 1; NTw = NTw < NT ? NTw : NT;
    const int jb = wq_min / 64;
    int kb4[4];
#pragma unroll
    for (int i = 0; i < 4; ++i) kb4[i] = r32 * RB + (((i * 2 + hi) ^ ((r32 >> 1) & 7)) << 4);
    const gbf16_t* kp1[NKP]; const gbf16_t* vp1[2]; const gbf16_t* kp0[NKP]; const gbf16_t* vp0[2];
#pragma unroll
    for (int i = 0; i < NKP; ++i) { const int L = (wid + 8 * i) * 1024 + 16 * lane, row = L / RB, within = L % RB, col = ((within ^ (((row >> 1) & 7) << 4)) >> 4) * 8;
        kp0[i] = Kp + (size_t)key_row(b, row) * ldk + col; kp1[i] = Kp + (size_t)(b * SEQ + 64 - NMETA + row) * ldk + col; }
#pragma unroll
    for (int i = 0; i < 2; ++i) { const int L = (wid + 8 * i) * 1024 + 16 * lane, sub = L >> 9, rem = L & 511, kk = (sub >> 2) * 8 + (rem >> 6);
        const int k = kk, col = (sub & 3) * 32 + ((rem & 63) >> 1);
        vp0[i] = Vp + (size_t)key_row(b, k) * ldv + col; vp1[i] = Vp + (size_t)(b * SEQ + 64 - NMETA + k) * ldv + col; }
    const size_t kstride = (size_t)64 * ldk, vstride = (size_t)64 * ldv;
#define ATT_DMA0() do { \
        _Pragma("unroll") for (int i_ = 0; i_ < NKP; ++i_) __builtin_amdgcn_global_load_lds((const gunsigned*)kp0[i_], (LAS unsigned*)(K_lds + (wid + 8 * i_) * 1024), 16, 0, 0); \
        _Pragma("unroll") for (int i_ = 0; i_ < 2; ++i_) __builtin_amdgcn_global_load_lds((const gunsigned*)vp0[i_], (LAS unsigned*)(V_lds + (wid + 8 * i_) * 1024), 16, 0, 0); } while (0)
#define ATT_DMA(j) do { const int ks_ = ((j) % NKS) * KSLOT, vs_ = ((j) % NVS) * 16384; \
        _Pragma("unroll") for (int i_ = 0; i_ < NKP; ++i_) { __builtin_amdgcn_global_load_lds((const gunsigned*)kp1[i_], (LAS unsigned*)(K_lds + ks_ + (wid + 8 * i_) * 1024), 16, 0, 0); kp1[i_] += kstride; } \
        _Pragma("unroll") for (int i_ = 0; i_ < 2; ++i_) { __builtin_amdgcn_global_load_lds((const gunsigned*)vp1[i_], (LAS unsigned*)(V_lds + vs_ + (wid + 8 * i_) * 1024), 16, 0, 0); vp1[i_] += vstride; } } while (0)
#define ATT_BAR(j) do { int c_ = ((j) + DEPTH_ - 1 < NT - 1 ? (j) + DEPTH_ - 1 : NT - 1) - (j); c_ = c_ < 0 ? 0 : c_; \
        if (c_ == 0) wait_vm_lgkm0<0>(); else if (c_ == 1) wait_vm_lgkm0<NP>(); else if (c_ == 2) wait_vm_lgkm0<2 * NP>(); else wait_vm_lgkm0<3 * NP>(); \
        __builtin_amdgcn_s_barrier(); asm volatile("" ::: "memory"); } while (0)
#define ATT_QKT(P0, P1, j) do { const int ko_ = (int)(unsigned)(uintptr_t)K_lds + ((j) % NKS) * KSLOT; int kbs_[4]; \
        _Pragma("unroll") for (int i_ = 0; i_ < 4; ++i_) kbs_[i_] = ko_ + kb4[i_]; \
        qkt_tile<DQK>(P0, P1, kbs_, qr); } while (0)
#define ATT_PARTIAL(P0, P1, AL, j, MASK) do { \
        if (MASK) { const int d_ = qpos - 64 * (j) - 4 * hi; _Pragma("unroll") for (int r = 0; r < 16; ++r) { if ((r & 3) + 8 * (r >> 2) > d_) P0[r] = -1e30f; if ((r & 3) + 8 * (r >> 2) + 32 > d_) P1[r] = -1e30f; } } \
        float pmax = P0[0]; _Pragma("unroll") for (int r = 1; r < 16; ++r) pmax = fmaxf(pmax, P0[r]); _Pragma("unroll") for (int r = 0; r < 16; ++r) pmax = fmaxf(pmax, P1[r]); \
        { auto rr = __builtin_amdgcn_permlane32_swap(__float_as_uint(pmax), __float_as_uint(pmax), false, false); pmax = fmaxf(__uint_as_float(rr[0]), __uint_as_float(rr[1])); } \
        if (__builtin_expect(__all(pmax - m_reg <= THR), 1)) { AL = 1.f; } else { const float mn = fmaxf(m_reg, pmax); AL = __builtin_amdgcn_exp2f(m_reg - mn); m_reg = mn; } \
        _Pragma("unroll") for (int r = 0; r < 16; ++r) { P0[r] = __builtin_amdgcn_exp2f(P0[r] - m_reg); P1[r] = P1[r] - m_reg; } } while (0)
#define ATT_RESC(AL) do { if (__any((AL) < 1.f)) { if (hi == 0) al_l[r32] = (AL); LDS_WAIT(); \
        _Pragma("unroll") for (int r = 0; r < 16; ++r) { const float a_ = al_l[crow(r, hi)]; _Pragma("unroll") for (int d = 0; d < 4; ++d) o[d][r] *= a_; } } } while (0)
#define ATT_PK4(P, BASE, OUT) do { u32x4 w = {cvt_pk_bf16(P[BASE + 0], P[BASE + 1]), cvt_pk_bf16(P[BASE + 2], P[BASE + 3]), cvt_pk_bf16(P[BASE + 4], P[BASE + 5]), cvt_pk_bf16(P[BASE + 6], P[BASE + 7])}; \
        OUT = __builtin_bit_cast(bf16x8, w); } while (0)
#define ATT_FINISH(P0, P1, AL) do { _Pragma("unroll") for (int r = 0; r < 16; ++r) P1[r] = __builtin_amdgcn_exp2f(P1[r]); \
        float ps = 0.f; _Pragma("unroll") for (int r = 0; r < 16; ++r) ps += P0[r] + P1[r]; \
        { auto rr = __builtin_amdgcn_permlane32_swap(__float_as_uint(ps), __float_as_uint(ps), false, false); ps = __uint_as_float(rr[0]) + __uint_as_float(rr[1]); } \
        l_reg = l_reg * (AL) + ps; ATT_PK4(P0, 0, pa0); ATT_PK4(P0, 8, pa1); ATT_PK4(P1, 0, pa2); ATT_PK4(P1, 8, pa3); } while (0)
#define ATT_PV(j) do { const int vb_ = vb0 + ((j) % NVS) * 16384; pv_all(o, vb_, pa0, pa1, pa2, pa3); } while (0)
    f32x16 p0 = f32x16{}, p1 = f32x16{}; float al = 1.f; bf16x8 pa0, pa1, pa2, pa3;
#define ATT_MASKONLY(P0, P1, j) do { const int d_ = qpos - 64 * (j) - 4 * hi; _Pragma("unroll") for (int r = 0; r < 16; ++r) { if ((r & 3) + 8 * (r >> 2) > d_) P0[r] = -1e30f; if ((r & 3) + 8 * (r >> 2) + 32 > d_) P1[r] = -1e30f; } } while (0)
#define ATT_SMPV(jj) do { if constexpr (NOMAX) { if ((jj) >= jb) ATT_MASKONLY(p0, p1, jj); \
            _Pragma("unroll") for (int r = 0; r < 16; ++r) p0[r] = __builtin_amdgcn_exp2f(p0[r]); ATT_FINISH(p0, p1, 1.0f); } \
        else { if ((jj) >= jb) { ATT_PARTIAL(p0, p1, al, jj, true); } else { ATT_PARTIAL(p0, p1, al, jj, false); } ATT_RESC(al); ATT_FINISH(p0, p1, al); } \
        SBAR(); ATT_PV(jj); } while (0)
    const bool groupA = wid < 4;
    __syncthreads();
    ATT_DMA0();
#pragma unroll
    for (int t = 1; t < DEPTH_; ++t) if (t < NT) ATT_DMA(t);
#if defined(PROBE_T)
    const bool prb = (blockIdx.x == PROBE_BLK) && (wid == PROBE_WAVE);
    unsigned long long tb = 0, tq = 0, ts = 0, t0_ = __builtin_amdgcn_s_memtime();
#define PT_BEG() unsigned long long t1_ = 0; if (prb) { __builtin_amdgcn_sched_barrier(0); t1_ = __builtin_amdgcn_s_memtime(); __builtin_amdgcn_sched_barrier(0); }
#define PT_END(acc) if (prb) { __builtin_amdgcn_sched_barrier(0); asm volatile("s_waitcnt lgkmcnt(0)" ::: "memory"); acc += __builtin_amdgcn_s_memtime() - t1_; __builtin_amdgcn_sched_barrier(0); }
#else
#define PT_BEG()
#define PT_END(acc)
#endif
    if constexpr (NOMAX) {
        unsigned pw[16];
        static_assert(NP == (DQK == 192 ? 5 : 3), "dma_piece_after() places exactly NP pieces");
#define ATT_QKT_N(j) do { const int ko_ = (int)(unsigned)(uintptr_t)K_lds + ((j) % NKS) * KSLOT; int kbs_[4]; \
        _Pragma("unroll") for (int i_ = 0; i_ < 4; ++i_) kbs_[i_] = ko_ + kb4[i_]; \
        DmaCtx<NKP> dc_; dc_.kdst = K_lds + (((j) + DEPTH_) % NKS) * KSLOT; dc_.vdst = V_lds + (((j) + DEPTH_) % NVS) * 16384; dc_.kstride = kstride; dc_.vstride = vstride; dc_.on = (j) + DEPTH_ < NT; \
        qkt_tile_n<DQK, NKP>(p0, p1, kbs_, qr, dc_, kp1, vp1, wid); } while (0)
#define ATT_PW2PA() do { pa0 = __builtin_bit_cast(bf16x8, (u32x4){pw[0], pw[1], pw[2], pw[3]}); pa1 = __builtin_bit_cast(bf16x8, (u32x4){pw[4], pw[5], pw[6], pw[7]}); \
        pa2 = __builtin_bit_cast(bf16x8, (u32x4){pw[8], pw[9], pw[10], pw[11]}); pa3 = __builtin_bit_cast(bf16x8, (u32x4){pw[12], pw[13], pw[14], pw[15]}); } while (0)
#define ATT_LSUM(ps_) do { auto rr = __builtin_amdgcn_permlane32_swap(__float_as_uint(ps_), __float_as_uint(ps_), false, false); ps_ = __uint_as_float(rr[0]) + __uint_as_float(rr[1]); } while (0)
        {
            ATT_BAR(0);
            ATT_QKT_N(0);
            if (0 >= jb) ATT_MASKONLY(p0, p1, 0);
            float ps = 0.f;
            sm_chunk4<0>(p0, ps, pw); sm_chunk4<1>(p0, ps, pw); sm_chunk4<2>(p0, ps, pw); sm_chunk4<3>(p0, ps, pw); sm_chunk4<4>(p1, ps, pw); sm_chunk4<5>(p1, ps, pw); sm_chunk4<6>(p1, ps, pw); sm_chunk4<7>(p1, ps, pw);
            ATT_LSUM(ps); l_reg = ps; ATT_PW2PA();
        }
        for (int j = 1; j < NT; ++j) {
            ATT_BAR(j);
            if (j >= NTw && j + DEPTH_ < NT) ATT_DMA(j + DEPTH_);
            if (j <= NTw) {
                if (j < NTw) { ATT_QKT_N(j); if (j >= jb) ATT_MASKONLY(p0, p1, j); }
                float ps = 0.f;
                { const int vb_ = vb0 + ((j - 1) % NVS) * 16384; pv_sm_all(o, vb_, pa0, pa1, pa2, pa3, p0, p1, ps, pw); }
                ATT_LSUM(ps); l_reg += (j < NTw) ? ps : 0.f; ATT_PW2PA();
            }
        }
        if (NTw == NT) { SBAR(); ATT_PV(NT - 1); }
#undef ATT_QKT_N
#undef ATT_PW2PA
#undef ATT_LSUM
    } else {
    for (int j = 0; j < NT; ++j) {
        if (groupA) { { PT_BEG(); ATT_BAR(j); PT_END(tb); } if (j + DEPTH_ < NT) ATT_DMA(j + DEPTH_); }
        if (j >= 1 && j - 1 < NTw) { PT_BEG(); ATT_SMPV(j - 1); PT_END(ts); }
        if (!groupA) { { PT_BEG(); ATT_BAR(j); PT_END(tb); } if (j + DEPTH_ < NT) ATT_DMA(j + DEPTH_); }
        if (j < NTw) { PT_BEG(); ATT_QKT(p0, p1, j); PT_END(tq); }
    }
#if defined(PROBE_T)
    if (prb && lane == 0) { unsigned long long* pt = (unsigned long long*)(probe_ptr); pt[0] += __builtin_amdgcn_s_memtime() - t0_; pt[1] += tb; pt[2] += tq; pt[3] += ts; }
#endif
    if (NTw == NT) ATT_SMPV(NT - 1);
    }
#undef ATT_SMPV
#undef ATT_MASKONLY
#undef ATT_DMA
#undef ATT_DMA0
#undef ATT_BAR
#undef ATT_QKT
#undef ATT_PARTIAL
#undef ATT_RESC
#undef ATT_PK4
#undef ATT_FINISH
#undef ATT_PV
    l_out = l_reg;
}
__device__ __forceinline__ void row_recip(float l, float (&rli)[16], LAS char* lds, int wid, int r32, int hi) {
    LAS float* li_l = (LAS float*)(lds + OFF_WS) + wid * 64 + 32;
    if (hi == 0) li_l[r32] = l;
    LDS_WAIT();
#pragma unroll
    for (int r = 0; r < 16; ++r) rli[r] = __builtin_amdgcn_rcpf(li_l[crow(r, hi)]);
    LDS_WAIT();
}
#undef SBAR
}


#define XB_TMO      128
#define XB_XCNT(j)  (256  + 64 * (j))
#define XB_XSUB(j)  (1280 + 64 * (j))
#define XB_XGEN(j)  (2304 + 64 * (j))
#define XB_TOP      3328
#define XB_TOPGEN   3392
#define XCD_BAR_WORDS 3456
#define XB_SPIN_CAP (1u << 18)
__device__ __forceinline__ unsigned xb_ld(unsigned* p)              { return __hip_atomic_load(p, __ATOMIC_RELAXED, __HIP_MEMORY_SCOPE_AGENT); }
__device__ __forceinline__ unsigned xb_add(unsigned* p, unsigned v) { return __hip_atomic_fetch_add(p, v, __ATOMIC_RELAXED, __HIP_MEMORY_SCOPE_AGENT); }
__device__ __forceinline__ unsigned xb_xcc_id() { return (unsigned)__builtin_amdgcn_s_getreg((3 << 11) | 20) & 0xFu; }
#define XB_SPIN(cond, bar) do { unsigned _sp = 0; while (cond) { __builtin_amdgcn_s_sleep(1); \
    if ((++_sp & 255u) == 0u) { if (xb_ld(&(bar)[XB_TMO])) break; if (_sp > XB_SPIN_CAP) { atomicAdd(&(bar)[XB_TMO], 1u); break; } } } } while (0)
struct XcdBarrier { unsigned* bar; unsigned x; volatile LAS unsigned* st; };
__device__ __forceinline__ XcdBarrier xcd_barrier_post(unsigned* bar, volatile LAS unsigned* st) {
    XcdBarrier b; b.bar = bar; b.x = xb_xcc_id(); b.st = st;
    if (threadIdx.x == 0) (void)xb_add(&bar[XB_XCNT(b.x)], 1u);
    return b;
}
__device__ __forceinline__ void xcd_barrier_complete(unsigned* bar, unsigned x, unsigned& nloc, unsigned& nx) {
    const unsigned G = gridDim.x * gridDim.y * gridDim.z;
    unsigned sum, cnt, mine, sp = 0u;
    for (;;) {
        sum = 0u; cnt = 0u; mine = 0u;
#pragma unroll
        for (unsigned j = 0; j < 16; ++j) { const unsigned c = xb_ld(&bar[XB_XCNT(j)]); sum += c; cnt += (c > 0u) ? 1u : 0u; mine = (j == x) ? c : mine; }
        if (sum == G) break;
        __builtin_amdgcn_s_sleep(1);
        if ((++sp & 255u) == 0u) { if (xb_ld(&bar[XB_TMO])) break; if (sp > XB_SPIN_CAP) { atomicAdd(&bar[XB_TMO], 1u); break; } }
    }
    nloc = mine > 0u ? mine : 1u; nx = cnt > 0u ? cnt : 1u;
}
__device__ __forceinline__ void xcd_barrier(const XcdBarrier& b) {
    asm volatile("s_waitcnt vmcnt(0)" ::: "memory");
    __syncthreads();
    if (threadIdx.x == 0) {
        unsigned* bar = b.bar;
        __builtin_amdgcn_s_waitcnt(0);
        unsigned nloc = b.st[0], nx = b.st[1];
        if (nloc == 0u) { xcd_barrier_complete(bar, b.x, nloc, nx); b.st[0] = nloc; b.st[1] = nx; }
        const unsigned old = xb_add(&bar[XB_XSUB(b.x)], 1u);
        const unsigned gen = old / nloc;
        if (old + 1u == (gen + 1u) * nloc) {
            __builtin_amdgcn_fence(__ATOMIC_RELEASE, "agent");
            asm volatile("s_waitcnt vmcnt(0)" ::: "memory");
            const unsigned og = xb_add(&bar[XB_TOP], 1u);
            const unsigned tg = og / nx;
            if (og + 1u == (tg + 1u) * nx) xb_add(&bar[XB_TOPGEN], 1u);
            else XB_SPIN(xb_ld(&bar[XB_TOPGEN]) == tg, bar);
            __builtin_amdgcn_fence(__ATOMIC_ACQUIRE, "agent");
            xb_add(&bar[XB_XGEN(b.x)], 1u);
            asm volatile("s_waitcnt vmcnt(0)" ::: "memory");
        } else {
            XB_SPIN(xb_ld(&bar[XB_XGEN(b.x)]) == gen, bar);
            __builtin_amdgcn_fence(__ATOMIC_ACQUIRE, "agent");
            asm volatile("s_waitcnt vmcnt(0)" ::: "memory");
        }
    }
    __syncthreads();
}

struct Params { const float* in[21]; float* out; unsigned char* ws; int s_lo, s_hi; };
struct DParams { const gfloat* in[21]; gfloat* out; guchar* ws; int s_lo, s_hi; };
enum { I_X = 0, I_META, I_ATTN_NORM, I_W_IN, I_QA_NORM, I_W_Q_UP, I_KVA_NORM, I_W_KV_UP, I_Q_NORM, I_K_NORM, I_DQ_NORM, I_DK_NORM, I_LQ1, I_LK1, I_LQ2, I_LK2, I_SUBLN, I_W_O, I_FFN_NORM,
       I_W_GU, I_W_D };
constexpr int LDS_BYTES = 149504;
constexpr int NTHREADS = 512, NWAVES = 8;

struct Frame {
    LAS unsigned char* lds; DParams p; int tid, lane, wave, vcu, G, gw, ngw;
};

__device__ __forceinline__ void transpose_item(const gfloat* W, int ldw, int Ksrc, const gfloat* gain, gbf16_t* WT, int Kd, int k0, int sc0, int dr0, LAS float* scr, int lane) {
    const bool zero = (sc0 < 0) || (k0 >= Ksrc);
    const int c = lane & 7;
    if (zero) {
#pragma unroll
        for (int j = 0; j < 4; ++j) { const int n = (lane >> 3) + 8 * j; *(gu32x4*)(WT + (size_t)(dr0 + n) * Kd + k0 + 8 * c) = (u32x4){0u, 0u, 0u, 0u}; }
        return;
    }
    f32x4 wv[8]; const int kr_ = lane >> 3, nq_ = (lane & 7) * 4;
#pragma unroll
    for (int i = 0; i < 8; ++i) wv[i] = __builtin_nontemporal_load((const gf32x4*)(W + (size_t)(k0 + 8 * i + kr_) * ldw + sc0 + nq_));
    if (gain) {
#pragma unroll
        for (int i = 0; i < 8; ++i) wv[i] = wv[i] * gain[k0 + 8 * i + kr_]; }
#pragma unroll
    for (int i = 0; i < 8; ++i) { LAS float* d = scr + (8 * i + kr_) * 33 + nq_; d[0] = wv[i][0]; d[1] = wv[i][1]; d[2] = wv[i][2]; d[3] = wv[i][3]; }
    LDS_WAIT(); asm volatile("" ::: "memory");
#pragma unroll
    for (int j = 0; j < 4; ++j) { const int n = (lane >> 3) + 8 * j; const LAS float* s = scr + (8 * c) * 33 + n;
        u32x4 o; o.x = pk2(s[0 * 33], s[1 * 33]); o.y = pk2(s[2 * 33], s[3 * 33]); o.z = pk2(s[4 * 33], s[5 * 33]); o.w = pk2(s[6 * 33], s[7 * 33]);
        *(gu32x4*)(WT + (size_t)(dr0 + n) * Kd + k0 + 8 * c) = o; }
    LDS_WAIT(); asm volatile("" ::: "memory");
}
constexpr int IT_IN = 16 * 64, IT_Q = 4 * 32, IT_KV = 2 * 32, IT_O = 16 * 32, IT_GU = 16 * 176, IT_D = 44 * 32, IT_L = IT_IN + IT_Q + IT_KV + IT_O + IT_GU + IT_D;
__device__ __forceinline__ void prep_transpose(Frame& F, int it, LAS float* scr) {
    const DParams& P = F.p;
        const int l = it / IT_L; int r = it % IT_L;
        gbf16_t* wb = (gbf16_t*)(P.ws + WS_W + (size_t)l * W_LAYER);
        if (r < IT_IN) { const int kb = r / 64, g = r % 64; int sc0;
            if (g < 14) sc0 = 32 * g;
            else if (g < 16) sc0 = -1;
            else if (g < 48) { const int tile = g >> 3, p32 = g & 7, bj = p32 >> 2, wcc = p32 & 3;
                sc0 = (tile < 4 ? SRC_DQ + (tile - 2) * 256 : SRC_DK + (tile - 4) * 256) + 64 * wcc + 32 * bj; }
            else sc0 = SRC_DV + 32 * (g - 48);
            transpose_item(P.in[I_W_IN] + (size_t)l * DM * INW, INW, DM, P.in[I_ATTN_NORM] + l * DM, (gbf16_t*)((gchar*)wb + W_IN), DM, kb * 64, sc0, 32 * g, scr, F.lane); return; }
        r -= IT_IN;
        if (r < IT_Q) { const int kb = r / 32, g = r % 32, h = g >> 3, d0 = (g & 7) * 32;
            transpose_item(P.in[I_W_Q_UP] + (size_t)l * 256 * 768, 768, 256, P.in[I_QA_NORM] + l * 256, (gbf16_t*)((gchar*)wb + W_Q), 256, kb * 64, d0 < 192 ? h * 192 + d0 : -1, 32 * g, scr, F.lane); return; }
        r -= IT_Q;
        if (r < IT_KV) { const int kb = r / 32, g = r % 32;
            transpose_item(P.in[I_W_KV_UP] + (size_t)l * 128 * 1024, 1024, 128, P.in[I_KVA_NORM] + l * 128, (gbf16_t*)((gchar*)wb + W_KV), 128, kb * 64, 32 * g, 32 * g, scr, F.lane); return; }
        r -= IT_KV;
        if (r < IT_O) { const int kb = r / 32, g = r % 32;
            transpose_item(P.in[I_W_O] + (size_t)l * DM * DM, DM, DM, nullptr, (gbf16_t*)((gchar*)wb + W_O), DM, kb * 64, 32 * g, 32 * g, scr, F.lane); return; }
        r -= IT_O;
        if (r < IT_GU) { const int kb = r / 176, g = r % 176, pn = g >> 3, half = (g & 7) >> 2, i0 = (g & 3) * 32;
            transpose_item(P.in[I_W_GU] + (size_t)l * DM * 2 * DFF, 2 * DFF, DM, P.in[I_FFN_NORM] + l * DM, (gbf16_t*)((gchar*)wb + W_GU), DM, kb * 64, half * DFF + pn * 128 + i0, 32 * g, scr, F.lane); return; }
        r -= IT_GU;
        { const int kb = r / 32, g = r % 32;
          transpose_item(P.in[I_W_D] + (size_t)l * DFF * DM, DM, DFF, nullptr, (gbf16_t*)((gchar*)wb + W_D), DFF, kb * 64, 32 * g, 32 * g, scr, F.lane); }
}
__device__ __forceinline__ void stage_prep(Frame& F) {
    LAS float* scr = (LAS float*)(F.lds + F.wave * 16384);
    const DParams& P = F.p;
    constexpr int N_C = NROWS / 4, N_ALL = N_C + 2 * IT_L;
    static_assert(NROWS % 4 == 0, "cast items are 4 rows");
    unsigned* ctr = (unsigned*)(P.ws + WS_CTL + 1024);
    gbf16_t* XN = (gbf16_t*)(P.ws + WS_HBA); gfloat* SSQ = (gfloat*)(P.ws + WS_SSQH); gfloat* MSSQ = (gfloat*)(P.ws + WS_MSSQ);
    volatile LAS int* slot = (volatile LAS int*)(F.lds + LDS_BYTES - 256 + 128);
    if (F.tid == 0) slot[0] = (int)__hip_atomic_fetch_add(ctr, 8u, __ATOMIC_RELAXED, __HIP_MEMORY_SCOPE_AGENT);
    __syncthreads();
    int base = slot[0], par = 0;
    while (base < N_ALL) {
        unsigned nb = 0; if (F.tid == 0) nb = __hip_atomic_fetch_add(ctr, 8u, __ATOMIC_RELAXED, __HIP_MEMORY_SCOPE_AGENT);
        const int item = base + F.wave;
        if (item < N_C) {
            f32x4 v[4][4];
#pragma unroll
            for (int q = 0; q < 4; ++q) { const int r_ = 4 * item + q; const gfloat* hr_ = r_ < NREAL ? P.in[I_X] + (size_t)r_ * DM : P.in[I_META] + (size_t)(r_ - NREAL) * DM;
#pragma unroll
                for (int j = 0; j < 4; ++j) v[q][j] = __builtin_nontemporal_load((const gf32x4*)hr_ + F.lane + 64 * j); }
#pragma unroll
            for (int q = 0; q < 4; ++q) { const int row = 4 * item + q;
                float sq = 0.f;
#pragma unroll
                for (int j = 0; j < 4; ++j) sq += (v[q][j].x * v[q][j].x + v[q][j].y * v[q][j].y) + (v[q][j].z * v[q][j].z + v[q][j].w * v[q][j].w);
                sq = wave_sum(sq);
                if (row < NREAL) { if (F.lane < 16) SSQ[(size_t)row * 16 + F.lane] = F.lane == 0 ? sq : 0.f; }
                else MSSQ[(row - NREAL) * 64 + F.lane] = F.lane == 0 ? sq : 0.f;
                gu32x2* o8 = (gu32x2*)(XN + (size_t)row * DM) + F.lane;
#pragma unroll
                for (int j = 0; j < 4; ++j) o8[64 * j] = (u32x2){pk2(v[q][j].x, v[q][j].y), pk2(v[q][j].z, v[q][j].w)}; }
        } else if (item < N_ALL) prep_transpose(F, item - N_C, scr);
        if (F.tid == 0) slot[par ^ 1] = (int)nb;
        __syncthreads();
        par ^= 1; base = slot[par];
    }
    __syncthreads();
    gfloat* COS = (gfloat*)(P.ws + WS_COS); gfloat* SIN = (gfloat*)(P.ws + WS_SIN);
    for (int i = blockIdx.x * NTHREADS + F.tid; i < LSEQ * 32; i += F.G * NTHREADS) {
        const int pos = i >> 5, m = i & 31;
        const float inv = 1.0f / powf(10000.0f, (float)(2 * m) / 64.0f), ang = (float)pos * inv;
        COS[i] = cosf(ang); SIN[i] = sinf(ang);
    }
    if (blockIdx.x == 0 && F.wave == 0) {
        const int ln = F.lane;
#pragma unroll 1
        for (int l = 0; l < DEPTH; ++l) {
            float a = P.in[I_LQ1][l * 64 + ln] * P.in[I_LK1][l * 64 + ln], b = P.in[I_LQ2][l * 64 + ln] * P.in[I_LK2][l * 64 + ln];
            float mq = fmaxf(fmaxf(fabsf(P.in[I_Q_NORM][l * 192 + ln]), fabsf(P.in[I_Q_NORM][l * 192 + 64 + ln])), fabsf(P.in[I_Q_NORM][l * 192 + 128 + ln]));
            float mk = fmaxf(fmaxf(fabsf(P.in[I_K_NORM][l * 192 + ln]), fabsf(P.in[I_K_NORM][l * 192 + 64 + ln])), fabsf(P.in[I_K_NORM][l * 192 + 128 + ln]));
            float dq = fabsf(P.in[I_DQ_NORM][l * 64 + ln]), dk = fabsf(P.in[I_DK_NORM][l * 64 + ln]);
            a = wave_sum(a); b = wave_sum(b);
#pragma unroll
            for (int off = 1; off < 64; off <<= 1) { mq = fmaxf(mq, __shfl_xor(mq, off)); mk = fmaxf(mk, __shfl_xor(mk, off)); dq = fmaxf(dq, __shfl_xor(dq, off)); dk = fmaxf(dk, __shfl_xor(dk, off)); }
            if (ln == 0) {
                const float lam_init = 0.8f - 0.6f * expf(-0.3f * (float)l);
                ((gfloat*)(P.ws + WS_LAM))[l] = expf(a) - expf(b) + lam_init;
                ((gfloat*)(P.ws + WS_LAM))[8 + 2 * l] = mq * mk * 192.0f * CA; ((gfloat*)(P.ws + WS_LAM))[9 + 2 * l] = dq * dk * 64.0f * CD; }
        }
    }
}

__device__ __forceinline__ void meta_postproj(Frame& F, int l) {
    if (blockIdx.x < 254) return;
    const DParams& P = F.p; const int lane = F.lane, ri = (blockIdx.x - 254) * NWAVES + F.wave, row = NREAL + ri;
    gbf16_t* pr = (gbf16_t*)(P.ws + WS_PROJ) + (size_t)row * INWP;
    const float cs = ((const gfloat*)(P.ws + WS_COS))[ri * 32 + (lane & 31)], sn = ((const gfloat*)(P.ws + WS_SIN))[ri * 32 + (lane & 31)];
    const float gq = P.in[I_DQ_NORM][l * 64 + lane], gk = P.in[I_DK_NORM][l * 64 + lane];
    float x[16];
#pragma unroll
    for (int seg = 0; seg < 16; ++seg) x[seg] = bf2f(pr[PC_DQ + seg * 64 + lane]);
#pragma unroll
    for (int seg = 0; seg < 16; ++seg) {
        const float r = 1.0f / sqrtf(wave_sum(x[seg] * x[seg]) * (1.0f / 64.0f) + EPS);
        const float y = x[seg] * r * (seg < 8 ? gq : gk), pt = __shfl_xor(y, 32);
        const float o = lane < 32 ? y * cs - pt * sn : y * cs + pt * sn;
        pr[PC_DQ + seg * 64 + lane] = (bf16_t)f2bf(seg < 8 ? o * CD : o);
    }
    asm volatile("s_waitcnt vmcnt(0)" ::: "memory");
}

__device__ __forceinline__ void att_store(Frame& F, const f32x16 (&o)[4], int qrow0, int colbase, int nvalid, int lane_) {
    __syncthreads();
    const int r32 = lane_ & 31, hi = lane_ >> 5;
    LAS char* stg = (LAS char*)F.lds + F.wave * 8192;
#pragma unroll
    for (int r = 0; r < 16; ++r) { const int row = att::crow(r, hi);
#pragma unroll
        for (int d0 = 0; d0 < 4; ++d0) *(LAS unsigned short*)(stg + row * 256 + (d0 * 32 + r32) * 2) = (unsigned short)f2bf(o[d0][r]); }
    LDS_WAIT();
    gbf16_t* AO = (gbf16_t*)(F.p.ws + WS_AO);
    const int ch = lane_ & 15, rq = lane_ >> 4;
#pragma unroll
    for (int i = 0; i < 8; ++i) { const int row = rq + 4 * i, lr = F.wave * 32 + row; const u32x4 v = *(const LAS u32x4*)(stg + row * 256 + ch * 16);
        if (lr < nvalid) *(gu32x4*)(AO + (size_t)(qrow0 + lr) * DM + colbase + ch * 8) = v; }
}
template <bool NOMAX> __device__ __forceinline__ void attn_unit_mla(Frame& F, int l_idx, int b, int h, int qrow0, int qpos0, int NT, int nvalid) {
    const DParams& P = F.p;
    const gbf16_t* QRAW = (const gbf16_t*)(P.ws + WS_QRAW); const gbf16_t* KA = (const gbf16_t*)(P.ws + WS_KA); const gbf16_t* KVRAW = (const gbf16_t*)(P.ws + WS_KVRAW);
    f32x16 o[4]; float l;
    att::attn_map<192, true, NOMAX>(QRAW + (size_t)qrow0 * 768 + h * 192, 768, KA + h * 192, 768, KVRAW + h * 256 + 128, 1024, b, qpos0, NT, o, l, (LAS char*)F.lds, (void*)((unsigned char*)P.ws + WS_CTL + 32768),
                             P.in[I_Q_NORM] + l_idx * 192, (const gfloat*)(P.ws + WS_COS), (const gfloat*)(P.ws + WS_SIN));
    int lane_ = F.lane; asm volatile("" : "+v"(lane_));
    float rli[16]; att::row_recip(l, rli, (LAS char*)F.lds, F.wave, lane_ & 31, lane_ >> 5);
#pragma unroll
    for (int r = 0; r < 16; ++r)
#pragma unroll
        for (int d0 = 0; d0 < 4; ++d0) o[d0][r] *= rli[r];
    att_store(F, o, qrow0, h * 128, nvalid, lane_);
}
template <bool NOMAX> __device__ __forceinline__ void attn_unit_diff(Frame& F, int l_idx, int b, int h, int qrow0, int qpos0, int NT, int nvalid) {
    const DParams& P = F.p;
    const gbf16_t* PROJ = (const gbf16_t*)(P.ws + WS_PROJ);
    const float lam = ((const gfloat*)(P.ws + WS_LAM))[l_idx];
    const float lam_init = 0.8f - 0.6f * expf(-0.3f * (float)l_idx);
    f32x16 o[4]; unsigned oa[4][8]; float lsum; float rli[16];
#pragma unroll 1
    for (int c = 0; c < 2; ++c) {
        att::attn_map<64, false, NOMAX>(PROJ + (size_t)qrow0 * INWP + PC_DQ + h * 128 + c * 64, INWP, PROJ + PC_DK + h * 128 + c * 64, INWP, PROJ + PC_DV + h * 128, INWP, b, qpos0, NT, o, lsum, (LAS char*)F.lds, (void*)((unsigned char*)P.ws + WS_CTL + 32768 + 64));
        int tid_ = F.tid; asm volatile("" : "+v"(tid_));
        att::row_recip(lsum, rli, (LAS char*)F.lds, F.wave, tid_ & 31, (tid_ >> 5) & 1);
        if (c == 0) {
            if constexpr (NOMAX) {
#pragma unroll
                for (int d = 0; d < 4; ++d)
#pragma unroll
                    for (int r = 0; r < 8; ++r) oa[d][r] = cvt_pk_bf16(o[d][2 * r] * rli[2 * r], o[d][2 * r + 1] * rli[2 * r + 1]);
            } else {
                gf32x4* tmp = (gf32x4*)(P.ws + WS_TMP) + (size_t)blockIdx.x * (16 * 512) + tid_;
#pragma unroll
                for (int d = 0; d < 4; ++d)
#pragma unroll
                    for (int q = 0; q < 4; ++q) tmp[(d * 4 + q) * 512] = (f32x4){o[d][4 * q] * rli[4 * q], o[d][4 * q + 1] * rli[4 * q + 1], o[d][4 * q + 2] * rli[4 * q + 2], o[d][4 * q + 3] * rli[4 * q + 3]};
            }
        }
    }
    int tid_ = F.tid; asm volatile("" : "+v"(tid_));
    const int lane_ = tid_ & 63, r32 = lane_ & 31;
    const gf32x4* tmp = (const gf32x4*)(P.ws + WS_TMP) + (size_t)blockIdx.x * (16 * 512) + tid_;
    float ss[16];
#pragma unroll
    for (int r = 0; r < 16; ++r) ss[r] = 0.f;
    if constexpr (NOMAX) {
#pragma unroll
        for (int d = 0; d < 4; ++d)
#pragma unroll
            for (int r = 0; r < 16; ++r) { const float a0 = (r & 1) ? bf2f(oa[d][r >> 1] >> 16) : bf2f(oa[d][r >> 1] & 0xffffu); const float v = a0 - lam * rli[r] * o[d][r]; o[d][r] = v; ss[r] += v * v; }
    } else {
#pragma unroll
    for (int d = 0; d < 4; ++d) {
#pragma unroll
        for (int q = 0; q < 4; ++q) { const f32x4 t = tmp[(d * 4 + q) * 512];
#pragma unroll
            for (int e = 0; e < 4; ++e) { const int r = 4 * q + e; const float v = t[e] - lam * rli[r] * o[d][r]; o[d][r] = v; ss[r] += v * v; } }
        asm volatile("" ::: "memory"); }
    }
#pragma unroll
    for (int off = 1; off < 32; off <<= 1) { float t[16];
#pragma unroll
        for (int r = 0; r < 16; ++r) t[r] = __shfl_xor(ss[r], off);
#pragma unroll
        for (int r = 0; r < 16; ++r) ss[r] += t[r]; }
    const gfloat* gs = P.in[I_SUBLN] + l_idx * 128; const float post = 1.0f - lam_init;
    float gcol[4];
#pragma unroll
    for (int d = 0; d < 4; ++d) gcol[d] = gs[d * 32 + r32] * post;
#pragma unroll
    for (int r = 0; r < 16; ++r) { const float rn = 1.0f / sqrtf(ss[r] * (1.0f / 128.0f) + EPS);
#pragma unroll
        for (int d0 = 0; d0 < 4; ++d0) o[d0][r] *= rn * gcol[d0]; }
    att_store(F, o, qrow0, 512 + h * 128, nvalid, lane_);
}
template <bool NOMAX> __device__ __forceinline__ void stage_attention(Frame& F, int l) {
    const int v = F.vcu, bh = v >> 2, s = v & 3, b = bh >> 2, h = bh & 3;
    if (F.tid < 192) ((LAS float*)((LAS char*)F.lds + att::OFF_GQ))[F.tid] = F.p.in[I_Q_NORM][l * 192 + F.tid];
    __syncthreads();
#pragma unroll 1
    for (int u = 0; u < 5; ++u) {
        int type, b_, h_, qrow0, qpos0, NT, nvalid;
        if (u < 4) { const int qb = (u & 1) ? 7 - s : s; type = u >> 1; b_ = b; h_ = h; qrow0 = b * SEQ + qb * 256; qpos0 = NMETA + qb * 256; NT = 4 * qb + 5; nvalid = 256; }
        else { if (v >= 8 || l == DEPTH - 1) break; type = v >> 2; b_ = 0; h_ = v & 3; qrow0 = NREAL; qpos0 = 0; NT = 1; nvalid = NMETA; }
        if (type == 0) attn_unit_mla<NOMAX>(F, l, b_, h_, qrow0, qpos0, NT, nvalid);
        else attn_unit_diff<NOMAX>(F, l, b_, h_, qrow0, qpos0, NT, nvalid);
    }
    __syncthreads();
}

__device__ __forceinline__ f32x4 meta_dot(const gbf16_t* arow, const gbf16_t* wrow, int K) {
    f32x4 acc = {0.f, 0.f, 0.f, 0.f};
#pragma unroll 8
    for (int k = 0; k < K; k += 32) { const bf16x8 a = *(const gbf16x8*)(arow + k); const bf16x8 w = *(const gbf16x8*)(wrow + k);
        acc = __builtin_amdgcn_mfma_f32_16x16x32_bf16(w, a, acc, 0, 0, 0); }
    return acc;
}
__device__ __forceinline__ float meta_rh(const gfloat* mssq, int tr) {
    f32x4 v[16];
#pragma unroll
    for (int i = 0; i < 16; ++i) v[i] = *(const gf32x4*)(mssq + tr * 64 + 4 * i);
    __builtin_amdgcn_sched_barrier(0);
    float s = 0.f;
#pragma unroll
    for (int i = 0; i < 16; ++i) s += (v[i][0] + v[i][1]) + (v[i][2] + v[i][3]);
    return 1.0f / sqrtf(s * (1.0f / DM) + EPS);
}
__device__ __forceinline__ void meta_tasks(Frame& F, int kind, const pg8::Gemm& g, gbf16_t* eo, int eld, const gfloat* ers, const gbf16_t* src_meta, gbf16_t* xn) {
    const int tr = F.lane & 15, q = F.lane >> 4, row = NREAL + tr;
    const int kc = g.K >> 3, k0 = F.wave * kc;
    const gbf16_t* arow = g.A + (size_t)row * g.lda + 8 * q + k0;
    gfloat* mssq = (gfloat*)(F.p.ws + WS_MSSQ);
    LAS f32x4* red = (LAS f32x4*)(F.lds + pg8::STAGE_BYTES);
    const int ntasks = (kind == 1 ? DFF : g.N) / 16;
    if ((int)blockIdx.x >= ntasks) return;
    float sc = 1.0f;
    if (kind != 2) {
        if (ers) {
            const gbf16_t* cq = (const gbf16_t*)ers + (size_t)tr * INWP + 64 * q; u32x4 cv[8]; float s = 0.f;
#pragma unroll
            for (int i = 0; i < 8; ++i) cv[i] = *(const gu32x4*)(cq + 8 * i);
#pragma unroll
            for (int i = 0; i < 8; ++i) { float x[8]; unpack8(cv[i], x); s += ssq8(x); }
            s += __shfl_xor(s, 16); s += __shfl_xor(s, 32); sc = 1.0f / sqrtf(s * (1.0f / 256.0f) + EPS);
        } else sc = meta_rh(mssq, tr);
    }
    for (int t = blockIdx.x; t < ntasks; t += F.G) {
        int wr0 = 16 * t + tr, wr1 = 0;
        if (kind == 1) { const int c0 = 16 * t, pn = c0 >> 7, i0 = c0 & 127; wr0 = pn * 256 + i0 + tr; wr1 = wr0 + 128; }
        const f32x4 p0 = meta_dot(arow, g.Bt + (size_t)wr0 * g.K + 8 * q + k0, kc);
        red[F.wave * 64 + F.lane] = p0;
        if (kind == 1) { const f32x4 p1 = meta_dot(arow, g.Bt + (size_t)wr1 * g.K + 8 * q + k0, kc); red[512 + F.wave * 64 + F.lane] = p1; }
        __syncthreads();
        if (F.wave == 0) {
            f32x4 acc = red[F.lane];
#pragma unroll
            for (int w = 1; w < 8; ++w) acc += red[w * 64 + F.lane];
            if (kind == 0) {
                int col = 16 * t + 4 * q; bool keep = true;
                if (ers) { const int hh = col >> 8, wi = col & 255; keep = wi < 192; col = hh * 192 + wi; }
                else if (col >= PC_DQ && col < PC_DV) { const int p = col & 255; col = (col & ~255) + 64 * ((p >> 5) & 3) + 32 * (p >> 7) + (p & 31); }
                if (keep) *(gu32x2*)(eo + (size_t)row * eld + col) = (u32x2){cvt_pk_bf16(acc[0] * sc, acc[1] * sc), cvt_pk_bf16(acc[2] * sc, acc[3] * sc)};
            } else if (kind == 1) {
                f32x4 au = red[512 + F.lane];
#pragma unroll
                for (int w = 1; w < 8; ++w) au += red[512 + w * 64 + F.lane];
                *(gu32x2*)(eo + (size_t)row * eld + 16 * t + 4 * q) = (u32x2){cvt_pk_bf16(pg8::silu_mul(acc[0] * sc, au[0] * sc), pg8::silu_mul(acc[1] * sc, au[1] * sc)),
                                                                           cvt_pk_bf16(pg8::silu_mul(acc[2] * sc, au[2] * sc), pg8::silu_mul(acc[3] * sc, au[3] * sc))};
            } else {
                const int c = 16 * t + 4 * q;
                const u32x2 sv = *(const gu32x2*)(src_meta + (size_t)row * DM + c);
                const f32x4 h = (f32x4){bf2f(sv.x & 0xffffu), bf2f(sv.x >> 16), bf2f(sv.y & 0xffffu), bf2f(sv.y >> 16)} + acc;
                *(gu32x2*)(xn + (size_t)row * DM + c) = (u32x2){cvt_pk_bf16(h[0], h[1]), cvt_pk_bf16(h[2], h[3])};
                float s = (h[0] * h[0] + h[1] * h[1]) + (h[2] * h[2] + h[3] * h[3]);
                s += __shfl_xor(s, 16); s += __shfl_xor(s, 32);
                if (q == 0) mssq[tr * 64 + t] = s;
            }
        }
        __syncthreads();
    }
    asm volatile("s_waitcnt vmcnt(0)" ::: "memory");
}

__device__ __forceinline__ void meta_kv_heads(Frame& F, int l, const gbf16_t* Wkv) {
    if (blockIdx.x >= 4) return;
    const DParams& P = F.p; const int h = blockIdx.x, tr = F.lane & 15, q = F.lane >> 4;
    const gbf16_t* PROJ = (const gbf16_t*)(P.ws + WS_PROJ); gbf16_t* KA = (gbf16_t*)(P.ws + WS_KA); gbf16_t* KV = (gbf16_t*)(P.ws + WS_KVRAW);
    const gfloat* COS = (const gfloat*)(P.ws + WS_COS); const gfloat* SIN = (const gfloat*)(P.ws + WS_SIN); const gfloat* gk = P.in[I_K_NORM] + l * 192;
    LAS float* L = (LAS float*)(F.lds + pg8::STAGE_BYTES);
#pragma unroll 1
    for (int i = 0; i < 2; ++i) { const int t = 2 * F.wave + i;
        const f32x4 acc = meta_dot(PROJ + (size_t)(NREAL + tr) * INWP + PC_CKV + 8 * q, Wkv + (size_t)(h * 256 + 16 * t + tr) * 128 + 8 * q, 128);
#pragma unroll
        for (int e = 0; e < 4; ++e) L[tr * 256 + 16 * t + 4 * q + e] = acc[e]; }
    __syncthreads();
#pragma unroll 1
    for (int i = 0; i < 2; ++i) { const int ri = 2 * F.wave + i, row = NREAL + ri, lane = F.lane;
        const gbf16_t* pr = PROJ + (size_t)row * INWP;
        float rkv; { const unsigned v = *(const gunsigned*)(pr + PC_CKV + 2 * lane); const float a = bf2f(v & 0xffffu), c = bf2f(v >> 16); rkv = 1.0f / sqrtf(wave_sum(a * a + c * c) * (1.0f / 128.0f) + EPS); }
        const float x0 = L[ri * 256 + lane] * rkv, x1 = L[ri * 256 + 64 + lane] * rkv, x2 = bf2f(pr[PC_KR + lane]);
        const float r = 1.0f / sqrtf(wave_sum(x0 * x0 + x1 * x1 + x2 * x2) * (1.0f / 192.0f) + EPS);
        const float cs = COS[ri * 32 + (lane & 31)], sn = SIN[ri * 32 + (lane & 31)];
        const float y0 = x0 * r * gk[lane], y1 = x1 * r * gk[64 + lane], y2 = x2 * r * gk[128 + lane], pt = __shfl_xor(y2, 32);
        const float y2r = lane < 32 ? y2 * cs - pt * sn : y2 * cs + pt * sn;
        gbf16_t* ko = KA + (size_t)row * 768 + h * 192;
        ko[lane] = (bf16_t)f2bf(y0); ko[64 + lane] = (bf16_t)f2bf(y1); ko[128 + lane] = (bf16_t)f2bf(y2r);
        gbf16_t* vo = KV + (size_t)row * 1024 + h * 256 + 128;
        vo[lane] = (bf16_t)f2bf(L[ri * 256 + 128 + lane] * rkv); vo[64 + lane] = (bf16_t)f2bf(L[ri * 256 + 192 + lane] * rkv); }
    __syncthreads();
    asm volatile("s_waitcnt vmcnt(0)" ::: "memory");
}

constexpr int SPL = 7, NSTAGES = 1 + SPL * DEPTH;
__device__ __forceinline__ bool stage_needs_sync(int st) { return !(st >= 1 && (st - 1) % SPL == 2); }
__device__ __forceinline__ void run_stage(const Params& p, LAS unsigned char* ldsp, int st) {
    Frame F;
    F.lds = ldsp;
    { int t = threadIdx.x; asm volatile("" : "+v"(t)); F.tid = t; }
    { unsigned char* w = p.ws; asm volatile("" : "+s"(w)); F.p.ws = (guchar*)w; }
#pragma unroll
    for (int i = 0; i < 21; ++i) F.p.in[i] = (const gfloat*)p.in[i];
    F.p.out = (gfloat*)p.out; F.p.s_lo = p.s_lo; F.p.s_hi = p.s_hi;
    F.lane = F.tid & 63; F.wave = __builtin_amdgcn_readfirstlane(F.tid >> 6);
    F.G = gridDim.x; { const int bx = blockIdx.x; F.vcu = (F.G % 8 == 0) ? (bx % 8) * (F.G / 8) + bx / 8 : bx; }
    F.gw = blockIdx.x * NWAVES + F.wave; F.ngw = F.G * NWAVES;
    const DParams& P = F.p;
    guchar* ws = P.ws;
    if (st == 0) { stage_prep(F); return; }
    const int l = (st - 1) / SPL, s = (st - 1) % SPL;
    const gchar* wb = (const gchar*)(ws + WS_W + (size_t)l * W_LAYER);
    gbf16_t* HBA = (gbf16_t*)(ws + WS_HBA); gbf16_t* HBB = (gbf16_t*)(ws + WS_HBB);
    const bool last_layer = l == DEPTH - 1;
    int kind = -1; pg8::Gemm g{nullptr, nullptr, NREAL, 0, 0, 0};
    gbf16_t* eo = nullptr; int eld = 0;
    const gbf16_t* hsrc = nullptr; gbf16_t* hdst = nullptr;
    switch (s) {
    case 0: kind = 0; g.A = HBA; g.Bt = (const gbf16_t*)(wb + W_IN); g.N = INWP; g.K = DM; g.lda = DM; eo = (gbf16_t*)(ws + WS_PROJ); eld = INWP; break;
    case 1: kind = 5; g.A = (const gbf16_t*)(ws + WS_PROJ) + PC_CQ; g.Bt = (const gbf16_t*)(wb + W_Q); g.N = 1024; g.K = 256; g.lda = INWP; eo = (gbf16_t*)(ws + WS_QRAW); eld = 768; break;
    case 2: kind = 4; g.A = (const gbf16_t*)(ws + WS_PROJ) + PC_CKV; g.Bt = (const gbf16_t*)(wb + W_KV); g.N = 1024; g.K = 128; g.lda = INWP; break;
    case 3: { const gfloat* bnd = (const gfloat*)(ws + WS_LAM) + 8 + 2 * l;
        if (bnd[0] < att::SCORE_BOUND_OK && bnd[1] < att::SCORE_BOUND_OK) stage_attention<true>(F, l); else stage_attention<false>(F, l); } break;
    case 4: kind = 2; g.A = (const gbf16_t*)(ws + WS_AO); g.Bt = (const gbf16_t*)(wb + W_O); g.N = DM; g.K = DM; g.lda = DM; hsrc = HBA; hdst = HBB; break;
    case 5: kind = 1; g.A = HBB; g.Bt = (const gbf16_t*)(wb + W_GU); g.N = 2 * DFF; g.K = DM; g.lda = DM; eo = (gbf16_t*)(ws + WS_ACT); eld = DFF; break;
    case 6: kind = last_layer ? 3 : 2; g.A = (const gbf16_t*)(ws + WS_ACT); g.Bt = (const gbf16_t*)(wb + W_D); g.N = DM; g.K = DFF; g.lda = DFF; hsrc = HBB; hdst = HBA; break;
    }
    if (kind >= 0) {
        gfloat* rqp = (gfloat*)(ws + WS_RQP); gfloat* rkvp = (gfloat*)(ws + WS_RKVP); gfloat* krss = (gfloat*)(ws + WS_KRSS); const gfloat* ssqh = (const gfloat*)(ws + WS_SSQH);
        const gfloat* COS = (const gfloat*)(ws + WS_COS); const gfloat* SIN = (const gfloat*)(ws + WS_SIN);
        pg8::StaticOrder S; S.init(NREAL, g.N, F.G, (int)blockIdx.x);
        pg8::gemm_prefetch(F.lds, g, S, true);
        if (kind == 4) meta_kv_heads(F, l, g.Bt);
        else if (kind == 5) { meta_postproj(F, l); meta_tasks(F, 0, g, eo, eld, (const gfloat*)((const gbf16_t*)(ws + WS_PROJ) + (size_t)NREAL * INWP + PC_CQ), nullptr, nullptr); }
        else if (!(last_layer && s >= 4)) meta_tasks(F, kind, g, eo, eld, nullptr, hsrc, hdst);
        if (kind == 0) { pg8::EpiInProj E{eo, ssqh, rqp, rkvp, krss, COS, SIN, P.in[I_DQ_NORM] + l * 64, P.in[I_DK_NORM] + l * 64}; pg8::gemm_phase<true>(F.lds, g, S, E); }
        else if (kind == 5) { pg8::EpiScaleBf16 E{eo, eld, rqp, 4, 1.0f / 256.0f, 192, 192}; pg8::gemm_phase<true>(F.lds, g, S, E); }
        else if (kind == 4) { pg8::EpiKV E{(gbf16_t*)(ws + WS_KA), (gbf16_t*)(ws + WS_KVRAW), (const gbf16_t*)(ws + WS_PROJ), rkvp, krss, COS, SIN, P.in[I_K_NORM] + l * 192};
                              pg8::gemm_phase<true>(F.lds, g, S, E); }
        else if (kind == 1) { pg8::EpiSwiglu E{eo, eld, nullptr, ssqh}; pg8::gemm_phase<true>(F.lds, g, S, E); }
        else if (kind == 2) { pg8::EpiResidual<false> E{hsrc, hdst, (gfloat*)(ws + WS_SSQH), nullptr}; pg8::gemm_phase<true>(F.lds, g, S, E); }
        else { pg8::EpiResidual<true> E{hsrc, nullptr, nullptr, P.out}; pg8::gemm_phase<true>(F.lds, g, S, E); }
    }
}

constexpr int LDS_MISC_OFF = LDS_BYTES - 256;
constexpr size_t CTL_BAR_OFF = 16384;
__global__ void __launch_bounds__(NTHREADS, 2) mega_kernel(Params p) {
    extern __shared__ __attribute__((aligned(16))) unsigned char lds[];
    cg::grid_group grid = cg::this_grid();
    volatile LAS unsigned* misc = (volatile LAS unsigned*)((LAS unsigned char*)lds + LDS_MISC_OFF);
    if (threadIdx.x < 4) misc[threadIdx.x] = 0u;
    __syncthreads();
    const XcdBarrier bar = xcd_barrier_post((unsigned*)(p.ws + WS_CTL + CTL_BAR_OFF), misc);
#pragma unroll 1
    for (int st = p.s_lo; st < p.s_hi; ++st) {
        if (st > p.s_lo && stage_needs_sync(st)) { if (st == 1) grid.sync(); else xcd_barrier(bar); }
#if defined(PROBE_SUM)
        const unsigned long long q0_ = __builtin_amdgcn_s_memrealtime();
#endif
#if defined(PROBE_CLK)
        unsigned long long c0_ = 0, r0_ = 0;
        if (st == PROBE_CLK) { c0_ = __builtin_amdgcn_s_memtime(); r0_ = __builtin_amdgcn_s_memrealtime(); }
#endif
        run_stage(p, (LAS unsigned char*)lds, st);
#if defined(PROBE_SUM)
        if (blockIdx.x == 9 && threadIdx.x == 0) ((unsigned long long*)(p.ws + WS_CTL + 49152))[st] = __builtin_amdgcn_s_memrealtime() - q0_;
        if (st == p.s_hi - 1) { xcd_barrier(bar);
            if (blockIdx.x == 0 && threadIdx.x == 0) { const unsigned long long* bt = (const unsigned long long*)(p.ws + WS_CTL + 49152); unsigned long long sum = 0;
                for (int i = 0; i < NSTAGES; ++i) if ((PROBE_SUM >> i) & 1) sum += bt[i];
                p.out[0] += 0.1f + 1e-5f * (float)sum; } }
#endif
#if defined(PROBE_CLK)
        if (st == PROBE_CLK && threadIdx.x == 0) { const unsigned long long c1_ = __builtin_amdgcn_s_memtime(), r1_ = __builtin_amdgcn_s_memrealtime();
            unsigned long long* pt = (unsigned long long*)(p.ws + WS_CTL + 32768 + 128); if (blockIdx.x == 9) { pt[0] = c1_ - c0_; pt[1] = r1_ - r0_; }
            ((unsigned long long*)(p.ws + WS_CTL + 40960))[blockIdx.x] = r1_ - r0_; }
        if (st == p.s_hi - 1) { xcd_barrier(bar);
            if (blockIdx.x == 0 && threadIdx.x == 0) { const unsigned long long* pt = (const unsigned long long*)(p.ws + WS_CTL + 32768 + 128);
#if PROBE_CLK_WHAT == 0
                p.out[0] += 0.1f + 0.01f * (float)((double)pt[0] / (double)pt[1]);
#elif PROBE_CLK_WHAT >= 2
                { const unsigned long long* bt = (const unsigned long long*)(p.ws + WS_CTL + 40960); unsigned long long mx = 0, mn = ~0ull, sum = 0; int cnt_slow = 0;
                  for (int i = 0; i < 256; ++i) { mx = bt[i] > mx ? bt[i] : mx; mn = bt[i] < mn ? bt[i] : mn; sum += bt[i]; }
                  for (int i = 0; i < 256; ++i) if (bt[i] * 10 > mx * 9) ++cnt_slow;
                  p.out[0] += 0.1f + (PROBE_CLK_WHAT == 2 ? 1e-5f * (float)mx : PROBE_CLK_WHAT == 3 ? 1e-5f * (float)mn : PROBE_CLK_WHAT == 4 ? 1e-5f * (float)(sum / 256) : 0.002f * (float)cnt_slow); }
#else
                p.out[0] += 0.1f + 1e-5f * (float)pt[1];
#endif
            } }
#endif
#if defined(PROBE_T)
        if (st == p.s_hi - 1) { xcd_barrier(bar);
            if (blockIdx.x == 0 && threadIdx.x == 0) { const unsigned long long* pt = (const unsigned long long*)(p.ws + WS_CTL + 32768 + (PROBE_DIFF ? 64 : 0));
                const float frac = (float)((double)pt[PROBE_Q] / (double)pt[0]); p.out[0] += 0.1f + (PROBE_Q == 0 ? (float)((double)pt[0] * 1e-6) : frac); } }
#endif
#if defined(PROBE_DUP)
        if ((st == 0 && (PROBE_DUP & 0x8000)) || (st >= 1 && ((PROBE_DUP >> ((st - 1) % SPL)) & 1))) { xcd_barrier(bar); run_stage(p, (LAS unsigned char*)lds, st); }
#endif
    }
}

extern "C" void kernel_launch(void* const* d_in, const int* in_sizes, int n_in, void* d_out, int out_size, void* d_ws, size_t ws_size, hipStream_t stream) {
    static int state = 0;
    if (state == 0) {
        if (n_in != 21 || in_sizes[0] != NREAL * DM || out_size != NREAL * DM || ws_size < WS_END) {
            fprintf(stderr, "kernel_launch: unexpected shapes: n_in %d in0 %d out %d ws %zu (need %zu)\n", n_in, n_in > 0 ? in_sizes[0] : -1, out_size, ws_size, (size_t)WS_END); state = -1; return; }
        int dev = 0, cus = 0;
        hipGetDevice(&dev); hipDeviceGetAttribute(&cus, hipDeviceAttributeMultiprocessorCount, dev);
        if (hipFuncSetAttribute((const void*)mega_kernel, hipFuncAttributeMaxDynamicSharedMemorySize, LDS_BYTES) != hipSuccess) { fprintf(stderr, "kernel_launch: hipFuncSetAttribute failed\n"); state = -1; return; }
        int per_cu = 0;
        hipOccupancyMaxActiveBlocksPerMultiprocessor(&per_cu, (const void*)mega_kernel, NTHREADS, LDS_BYTES);
        (void)hipGetLastError();
        if (cus != 256 || per_cu < 1) { fprintf(stderr, "kernel_launch: needs a 256-CU device with one resident workgroup per CU (cus %d, per_cu %d)\n", cus, per_cu); state = -1; return; }
        state = 1;
    }
    if (state < 0) return;
    Params p{};
    for (int i = 0; i < 21; ++i) p.in[i] = (const float*)d_in[i];
    p.out = (float*)d_out; p.ws = (unsigned char*)d_ws;
    p.s_lo = 0; p.s_hi = NSTAGES;
    if (hipMemsetAsync((char*)d_ws + WS_CTL, 0, 65536, stream) != hipSuccess) { fprintf(stderr, "kernel_launch: hipMemsetAsync failed\n"); return; }
    void* args[] = {&p};
    hipError_t e = hipLaunchCooperativeKernel((const void*)mega_kernel, dim3(256), dim3(NTHREADS), args, LDS_BYTES, stream);
    if (e != hipSuccess) fprintf(stderr, "kernel_launch: cooperative launch failed: %s\n", hipGetErrorString(e));
}
```

```cpp
#include <hip/hip_runtime.h>
#include <hip/hip_cooperative_groups.h>
#include <cstdio>
#include <cstdint>
namespace cg = cooperative_groups;


constexpr int DM = 1024, BATCH = 16, SEQ = 2048, NMETA = 16, DEPTH = 2;
constexpr int NREAL = BATCH * SEQ;
constexpr int NROWS = NREAL + NMETA;
constexpr int MP = 33024;
constexpr int LSEQ = SEQ + NMETA;
constexpr int INW = 1984, INWP = 2048, DFF = 2816;
constexpr float EPS = 1e-6f;
constexpr float LOG2E = 1.4426950408889634f;
constexpr float CA = 0.07216878364870322f * LOG2E;
constexpr float CD = 0.125f * LOG2E;
constexpr int PC_CQ = 0, PC_CKV = 256, PC_KR = 384, PC_DQ = 512, PC_DK = 1024, PC_DV = 1536;
constexpr int SRC_DQ = 448, SRC_DK = 960, SRC_DV = 1472;

constexpr size_t MiB = 1u << 20;
constexpr size_t WS_CTL = 0;
constexpr size_t WS_RH = 1 * MiB;
constexpr size_t WS_RQ = WS_RH + 256 * 1024;
constexpr size_t WS_RKV = WS_RQ + 256 * 1024;
constexpr size_t WS_HM = WS_RKV + 256 * 1024;
constexpr size_t WS_LAM = WS_HM + 64 * 1024;
constexpr size_t WS_MSSQ = WS_LAM + 1024;
constexpr size_t WS_RQP = 3 * MiB;
constexpr size_t WS_RKVP = WS_RQP + 512 * 1024;
constexpr size_t WS_KRSS = WS_RH;
constexpr size_t WS_COS = 2 * MiB;
constexpr size_t WS_SIN = WS_COS + 512 * 1024;
constexpr size_t WS_W = 4 * MiB;
constexpr size_t W_IN = 0, W_Q = W_IN + (size_t)INWP * DM * 2, W_KV = W_Q + (size_t)1024 * 256 * 2, W_O = W_KV + (size_t)1024 * 256 * 2,
                 W_GU = W_O + (size_t)DM * DM * 2, W_D = W_GU + (size_t)2 * DFF * DM * 2, W_LAYER = W_D + (size_t)DM * DFF * 2;
static_assert(WS_W + 2 * W_LAYER <= 52 * MiB, "weights");
constexpr size_t WS_PROJ = 52 * MiB;
constexpr size_t WS_KVRAW = WS_PROJ + (size_t)MP * INWP * 2;
constexpr size_t WS_QA = WS_KVRAW + (size_t)MP * 1024 * 2;
constexpr size_t WS_KA = WS_QA + (size_t)MP * 768 * 2;
constexpr size_t WS_HBA = WS_KA + (size_t)MP * 768 * 2;
constexpr size_t WS_AO = WS_HBA + (size_t)MP * 1024 * 2;
constexpr size_t WS_TMP = WS_AO + (size_t)MP * 1024 * 2;
constexpr size_t WS_SSQH = WS_TMP + (size_t)256 * 64 * 512 * 4;
constexpr size_t WS_END = WS_SSQH + (size_t)NREAL * 16 * 4;
constexpr size_t WS_QRAW = WS_QA;
constexpr size_t WS_QRAW_OLD_UNUSED = WS_AO;
constexpr size_t WS_HBB = WS_QA;
constexpr size_t WS_ACT = WS_PROJ;
static_assert(WS_ACT + (size_t)MP * DFF * 2 <= WS_QA, "ACT overlay");

#define LAS __attribute__((address_space(3)))
typedef unsigned short bf16_t;
typedef short bf16x8 __attribute__((ext_vector_type(8)));
typedef short s16x4 __attribute__((ext_vector_type(4)));
typedef float f32x4 __attribute__((ext_vector_type(4)));
typedef float f32x16 __attribute__((ext_vector_type(16)));
typedef unsigned u32x4 __attribute__((ext_vector_type(4)));
typedef unsigned u32x2 __attribute__((ext_vector_type(2)));
#define GAS __attribute__((address_space(1)))
typedef GAS bf16_t gbf16_t; typedef GAS float gfloat; typedef GAS unsigned char guchar; typedef GAS char gchar; typedef GAS unsigned gunsigned;
typedef GAS u32x4 gu32x4; typedef GAS u32x2 gu32x2; typedef GAS f32x4 gf32x4; typedef GAS bf16x8 gbf16x8;

__device__ __forceinline__ unsigned f2bf(float f) { unsigned u = __builtin_bit_cast(unsigned, f); return (u + 0x7fffu + ((u >> 16) & 1u)) >> 16; }
__device__ __forceinline__ unsigned pk2(float lo, float hi) { return f2bf(lo) | (f2bf(hi) << 16); }
__device__ __forceinline__ float bf2f(unsigned b) { return __builtin_bit_cast(float, b << 16); }
__device__ __forceinline__ float rsq(float x) { return __builtin_amdgcn_rsqf(x); }
__device__ __forceinline__ unsigned cvt_pk_bf16(float lo, float hi) { unsigned r; asm volatile("v_cvt_pk_bf16_f32 %0, %1, %2" : "=v"(r) : "v"(lo), "v"(hi)); return r; }
__device__ __forceinline__ float wave_sum(float v) {
#pragma unroll
    for (int o = 1; o < 64; o <<= 1) v += __shfl_xor(v, o);
    return v;
}
#define LDS_WAIT() asm volatile("s_waitcnt lgkmcnt(0)" ::: "memory")

__device__ __forceinline__ void unpack8(const u32x4 v, float (&x)[8]) {
    x[0] = bf2f(v.x & 0xffffu); x[1] = bf2f(v.x >> 16); x[2] = bf2f(v.y & 0xffffu); x[3] = bf2f(v.y >> 16);
    x[4] = bf2f(v.z & 0xffffu); x[5] = bf2f(v.z >> 16); x[6] = bf2f(v.w & 0xffffu); x[7] = bf2f(v.w >> 16);
}
__device__ __forceinline__ u32x4 pack8(const float (&x)[8]) { return (u32x4){pk2(x[0], x[1]), pk2(x[2], x[3]), pk2(x[4], x[5]), pk2(x[6], x[7])}; }
__device__ __forceinline__ float ssq8(const float (&x)[8]) { return ((x[0] * x[0] + x[1] * x[1]) + (x[2] * x[2] + x[3] * x[3])) + ((x[4] * x[4] + x[5] * x[5]) + (x[6] * x[6] + x[7] * x[7])); }
__device__ __forceinline__ void norm_rope8(float (&x)[8], float r, const float (&g)[8], const float (&cs)[8], const float (&sn)[8], bool upper, float post) {
#pragma unroll
    for (int e = 0; e < 8; ++e) { const float y = x[e] * r * g[e], pt = __shfl_xor(y, 4); x[e] = (upper ? y * cs[e] + pt * sn[e] : y * cs[e] - pt * sn[e]) * post; }
}
__device__ __forceinline__ void load8f(float (&d)[8], const gfloat* p) { const f32x4 a = *(const gf32x4*)p, b = *(const gf32x4*)(p + 4); d[0] = a[0]; d[1] = a[1]; d[2] = a[2]; d[3] = a[3]; d[4] = b[0]; d[5] = b[1]; d[6] = b[2]; d[7] = b[3]; }


namespace pg8 {
constexpr int BM = 256, BK = 64, HALF = 128, HTB = HALF * BK * 2, STAGE_BYTES = 8 * HTB, NXCD = 8, WGM = 8;
__host__ __device__ __forceinline__ int lds_byte(int r, int c) { const int st = (r >> 4) * 2 + (c >> 5), rr = r & 15, cc = c & 31, ob = rr * 64 + cc * 2; return st * 1024 + (ob ^ (((ob >> 9) & 1) << 5)); }
__host__ __device__ __forceinline__ void stage_rc(int b, int& R, int& C) { const int st = b / 1024, sb = b % 1024, swz = sb ^ (((sb >> 9) & 1) << 5); R = (st >> 1) * 16 + swz / 64; C = (st & 1) * 32 + (swz % 64) / 2; }
__host__ __device__ __forceinline__ int perm32(int rho) { const int n = rho >> 4, i = rho & 15; return 8 * (i >> 2) + 4 * n + (i & 3); }

struct Unit { int pm, pn; };
struct Gemm { const gbf16_t* A; const gbf16_t* Bt; int M, N, K, lda; };

struct StaticOrder {
    int nM, nN, nwg, G, c;
    __device__ void init(int M, int N, int G_, int c_) { nM = M / BM; nN = N / BM; nwg = nM * nN; G = G_; c = c_; }
    __device__ bool next(int i, Unit& u) const {
        const long L = (long)i * G + c; if (L >= nwg) return false;
        int wgid = (int)L; { const int q = nwg / NXCD, r = nwg % NXCD, xcd = wgid % NXCD, off = wgid / NXCD; wgid = (xcd < r ? xcd * (q + 1) : r * (q + 1) + (xcd - r) * q) + off; }
        const int nig = WGM * nN, gid = wgid / nig, fm = gid * WGM, gsz = (nM - fm) < WGM ? (nM - fm) : WGM;
        u.pm = fm + ((wgid % nig) % gsz); u.pn = (wgid % nig) / gsz; return true;
    }
};

__device__ __forceinline__ void row_scales(float (&sc)[2][4], const gfloat* rs, const gfloat* part, int npart, float inv_div, int row0, int fq) {
    if (!part) {
#pragma unroll
        for (int ai = 0; ai < 2; ++ai)
#pragma unroll
            for (int m = 0; m < 4; ++m) sc[ai][m] = rs[row0 + ai * HALF + m * 16];
        return;
    }
    f32x4 v[8];
#pragma unroll
    for (int i = 0; i < 8; ++i) { const int row = row0 + (i >> 2) * HALF + (i & 3) * 16; v[i] = npart == 16 ? *(const gf32x4*)(part + (size_t)row * 16 + 4 * fq) : *(const gf32x4*)(part + (size_t)row * 4); }
    __builtin_amdgcn_sched_barrier(0);
    float s[8];
#pragma unroll
    for (int i = 0; i < 8; ++i) s[i] = (v[i][0] + v[i][1]) + (v[i][2] + v[i][3]);
    if (npart == 16) { float t[8];
#pragma unroll
        for (int i = 0; i < 8; ++i) t[i] = __shfl_xor(s[i], 16);
#pragma unroll
        for (int i = 0; i < 8; ++i) s[i] += t[i];
#pragma unroll
        for (int i = 0; i < 8; ++i) t[i] = __shfl_xor(s[i], 32);
#pragma unroll
        for (int i = 0; i < 8; ++i) s[i] += t[i]; }
#pragma unroll
    for (int i = 0; i < 8; ++i) sc[i >> 2][i & 3] = rsq(s[i] * inv_div + EPS);
}
struct EpiScaleBf16 {
    static constexpr bool PERM = true;
    gbf16_t* O; int ldc; const gfloat* part; int npart; float inv_div; int tstride, tvalid;
    __device__ __forceinline__ void operator()(const f32x4 (&acc)[2][2][4][2], const Unit& u, int wr, int wc, int fr, int fq, LAS unsigned char*) const {
        const int row0 = u.pm * BM + wr * 64 + fr, cin = wc * 32 + 8 * fq, col0 = u.pn * tstride + cin;
        float sc[2][4]; row_scales(sc, nullptr, part, npart, inv_div, row0, fq);
#pragma unroll
        for (int ai = 0; ai < 2; ++ai)
#pragma unroll
            for (int m = 0; m < 4; ++m) { const int row = row0 + ai * HALF + m * 16; const float s = sc[ai][m]; gbf16_t* rowp = O + (size_t)row * ldc + col0;
#pragma unroll
                for (int bj = 0; bj < 2; ++bj) { const f32x4 v0 = acc[ai][bj][m][0] * s, v1 = acc[ai][bj][m][1] * s;
                    u32x4 w; w.x = cvt_pk_bf16(v0[0], v0[1]); w.y = cvt_pk_bf16(v0[2], v0[3]); w.z = cvt_pk_bf16(v1[0], v1[1]); w.w = cvt_pk_bf16(v1[2], v1[3]);
                    if (cin + bj * HALF < tvalid) *(gu32x4*)(rowp + bj * HALF) = w; } }
    }
};
struct EpiInProj {
    static constexpr bool PERM = true;
    gbf16_t* O; const gfloat* part; gfloat* rqp; gfloat* rkvp; gfloat* krss; const gfloat* COS; const gfloat* SIN; const gfloat* gdq; const gfloat* gdk;
    __device__ __forceinline__ void operator()(const f32x4 (&acc)[2][2][4][2], const Unit& u, int wr, int wc, int fr, int fq, LAS unsigned char*) const {
        const int row0 = u.pm * BM + wr * 64 + fr, cin = wc * 32 + 8 * fq;
        float sc[2][4]; row_scales(sc, nullptr, part, 16, 1.0f / DM, row0, fq);
        if (u.pn >= 2 && u.pn < 6) {
            const gfloat* gp = (u.pn < 4 ? gdq : gdk) + 8 * fq; const float post = u.pn < 4 ? CD : 1.0f;
            const f32x4 gl0 = *(const gf32x4*)gp, gl1 = *(const gf32x4*)(gp + 4), gh0 = *(const gf32x4*)(gp + 32), gh1 = *(const gf32x4*)(gp + 36);
#pragma unroll
            for (int ai = 0; ai < 2; ++ai)
#pragma unroll
                for (int m = 0; m < 4; ++m) { const int row = row0 + ai * HALF + m * 16, pos = NMETA + (row & (SEQ - 1)); const float s = sc[ai][m];
                    f32x4 l0 = acc[ai][0][m][0] * s, l1 = acc[ai][0][m][1] * s, h0 = acc[ai][1][m][0] * s, h1 = acc[ai][1][m][1] * s;
                    float q = (((l0[0] * l0[0] + l0[1] * l0[1]) + (l0[2] * l0[2] + l0[3] * l0[3])) + ((l1[0] * l1[0] + l1[1] * l1[1]) + (l1[2] * l1[2] + l1[3] * l1[3])))
                            + (((h0[0] * h0[0] + h0[1] * h0[1]) + (h0[2] * h0[2] + h0[3] * h0[3])) + ((h1[0] * h1[0] + h1[1] * h1[1]) + (h1[2] * h1[2] + h1[3] * h1[3])));
                    q += __shfl_xor(q, 16); q += __shfl_xor(q, 32);
                    const float r = rsq(q * (1.0f / 64.0f) + EPS);
                    const f32x4 c0 = *(const gf32x4*)(COS + pos * 32 + 8 * fq), c1 = *(const gf32x4*)(COS + pos * 32 + 8 * fq + 4), s0 = *(const gf32x4*)(SIN + pos * 32 + 8 * fq), s1 = *(const gf32x4*)(SIN + pos * 32 + 8 * fq + 4);
                    l0 = l0 * r * gl0; l1 = l1 * r * gl1; h0 = h0 * r * gh0; h1 = h1 * r * gh1;
                    const f32x4 ol0 = (l0 * c0 - h0 * s0) * post, ol1 = (l1 * c1 - h1 * s1) * post, oh0 = (h0 * c0 + l0 * s0) * post, oh1 = (h1 * c1 + l1 * s1) * post;
                    gbf16_t* rowp = O + (size_t)row * INWP + u.pn * BM + 64 * wc + 8 * fq;
                    u32x4 w; w.x = cvt_pk_bf16(ol0[0], ol0[1]); w.y = cvt_pk_bf16(ol0[2], ol0[3]); w.z = cvt_pk_bf16(ol1[0], ol1[1]); w.w = cvt_pk_bf16(ol1[2], ol1[3]);
                    *(gu32x4*)rowp = w;
                    w.x = cvt_pk_bf16(oh0[0], oh0[1]); w.y = cvt_pk_bf16(oh0[2], oh0[3]); w.z = cvt_pk_bf16(oh1[0], oh1[1]); w.w = cvt_pk_bf16(oh1[2], oh1[3]);
                    *(gu32x4*)(rowp + 32) = w;
                    asm volatile("" ::: "memory"); }
            return;
        }
#pragma unroll
        for (int ai = 0; ai < 2; ++ai)
#pragma unroll
            for (int m = 0; m < 4; ++m) { const int row = row0 + ai * HALF + m * 16; const float s = sc[ai][m]; gbf16_t* rowp = O + (size_t)row * INWP + u.pn * BM + cin; float q[2];
#pragma unroll
                for (int bj = 0; bj < 2; ++bj) { const f32x4 v0 = acc[ai][bj][m][0] * s, v1 = acc[ai][bj][m][1] * s;
                    u32x4 w; w.x = cvt_pk_bf16(v0[0], v0[1]); w.y = cvt_pk_bf16(v0[2], v0[3]); w.z = cvt_pk_bf16(v1[0], v1[1]); w.w = cvt_pk_bf16(v1[2], v1[3]);
                    *(gu32x4*)(rowp + bj * HALF) = w;
                    q[bj] = ((v0[0] * v0[0] + v0[1] * v0[1]) + (v0[2] * v0[2] + v0[3] * v0[3])) + ((v1[0] * v1[0] + v1[1] * v1[1]) + (v1[2] * v1[2] + v1[3] * v1[3])); }
                if (u.pn < 2) {
                    q[0] += __shfl_xor(q[0], 16); q[0] += __shfl_xor(q[0], 32); q[1] += __shfl_xor(q[1], 16); q[1] += __shfl_xor(q[1], 32);
                    if (fq == 0) { if (u.pn == 0) rqp[(size_t)row * 4 + wc] = q[0] + q[1];
                                   else { rkvp[(size_t)row * 4 + wc] = q[0]; if (wc < 2) krss[(size_t)row * 2 + wc] = q[1]; } } } }
    }
};
__device__ __forceinline__ float silu_mul(float g, float u) { const float e = __builtin_amdgcn_exp2f(-g * LOG2E); return g * __builtin_amdgcn_rcpf(1.0f + e) * u; }
typedef float f32x2 __attribute__((ext_vector_type(2)));
__device__ __forceinline__ f32x2 swiglu_pk(f32x2 g, f32x2 u, float ks, float s2) {
    const f32x2 a = g * ks; f32x2 e; e.x = __builtin_amdgcn_exp2f(a.x); e.y = __builtin_amdgcn_exp2f(a.y);
    const f32x2 d = e + 1.0f; f32x2 r; r.x = __builtin_amdgcn_rcpf(d.x); r.y = __builtin_amdgcn_rcpf(d.y);
    return (g * u) * (r * s2);
}
struct EpiSwiglu {
    static constexpr bool PERM = true;
    gbf16_t* O; int ldc; const gfloat* rs; const gfloat* part;
    __device__ __forceinline__ void operator()(const f32x4 (&acc)[2][2][4][2], const Unit& u, int wr, int wc, int fr, int fq, LAS unsigned char*) const {
        const int row0 = u.pm * BM + wr * 64 + fr, col0 = u.pn * HALF + wc * 32 + 8 * fq;
        float sc[2][4]; row_scales(sc, rs, part, 16, 1.0f / DM, row0, fq);
#pragma unroll
        for (int ai = 0; ai < 2; ++ai)
#pragma unroll
            for (int m = 0; m < 4; ++m) { const int row = row0 + ai * HALF + m * 16; const float s = sc[ai][m], ks = -s * LOG2E, s2 = s * s;
                u32x4 w;
#pragma unroll
                for (int n = 0; n < 2; ++n) { const f32x4 g = acc[ai][0][m][n], uu = acc[ai][1][m][n];
                    const f32x2 o0 = swiglu_pk((f32x2){g[0], g[1]}, (f32x2){uu[0], uu[1]}, ks, s2), o1 = swiglu_pk((f32x2){g[2], g[3]}, (f32x2){uu[2], uu[3]}, ks, s2);
                    w[2 * n] = cvt_pk_bf16(o0.x, o0.y); w[2 * n + 1] = cvt_pk_bf16(o1.x, o1.y); }
                *(gu32x4*)(O + (size_t)row * ldc + col0) = w; }
    }
};
template <bool LAST> struct EpiResidual {
    static constexpr bool PERM = true;
    const gbf16_t* hsrc; gbf16_t* hdst; gfloat* part; gfloat* out;
    __device__ __forceinline__ void operator()(const f32x4 (&acc)[2][2][4][2], const Unit& u, int wr, int wc, int fr, int fq, LAS unsigned char*) const {
        const int row0 = u.pm * BM + wr * 64 + fr, col0 = u.pn * BM + wc * 32 + 8 * fq;
#pragma unroll
        for (int ai = 0; ai < 2; ++ai) {
            u32x4 hv[4][2];
#pragma unroll
            for (int m = 0; m < 4; ++m)
#pragma unroll
                for (int bj = 0; bj < 2; ++bj) hv[m][bj] = *(const gu32x4*)(hsrc + (size_t)(row0 + ai * HALF + m * 16) * DM + col0 + bj * HALF);
            __builtin_amdgcn_sched_barrier(0);
#pragma unroll
            for (int m = 0; m < 4; ++m) { const int row = row0 + ai * HALF + m * 16;
                float q = 0.f;
#pragma unroll
                for (int bj = 0; bj < 2; ++bj) { float x[8]; unpack8(hv[m][bj], x);
                    const f32x4 h0 = (f32x4){x[0], x[1], x[2], x[3]} + acc[ai][bj][m][0], h1 = (f32x4){x[4], x[5], x[6], x[7]} + acc[ai][bj][m][1];
                    if (LAST) { gfloat* o = out + (size_t)row * DM + col0 + bj * HALF; *(gf32x4*)o = h0; *(gf32x4*)(o + 4) = h1; }
                    else { u32x4 w; w.x = cvt_pk_bf16(h0[0], h0[1]); w.y = cvt_pk_bf16(h0[2], h0[3]); w.z = cvt_pk_bf16(h1[0], h1[1]); w.w = cvt_pk_bf16(h1[2], h1[3]);
                           *(gu32x4*)(hdst + (size_t)row * DM + col0 + bj * HALF) = w;
                           q += ((h0[0] * h0[0] + h0[1] * h0[1]) + (h0[2] * h0[2] + h0[3] * h0[3])) + ((h1[0] * h1[0] + h1[1] * h1[1]) + (h1[2] * h1[2] + h1[3] * h1[3])); } }
                if (!LAST) { q += __shfl_xor(q, 16); q += __shfl_xor(q, 32);
                    if (fq == 0) part[(size_t)row * 16 + u.pn * 4 + wc] = q; } }
            __builtin_amdgcn_sched_barrier(0); }
    }
};

struct EpiKV {
    static constexpr bool PERM = true;
    gbf16_t* KA; gbf16_t* KV; const gbf16_t* PROJ; const gfloat* rkvp; const gfloat* krss; const gfloat* COS; const gfloat* SIN; const gfloat* gk;
    __device__ __forceinline__ void operator()(const f32x4 (&acc)[2][2][4][2], const Unit& u, int wr, int wc, int fr, int fq, LAS unsigned char* lds) const {
        const int row0 = u.pm * BM + wr * 64 + fr, h = u.pn, c8 = wc * 32 + 8 * fq;
        LAS float* xch = (LAS float*)(lds + STAGE_BYTES);
        float sc[2][4]; row_scales(sc, nullptr, rkvp, 4, 1.0f / 128.0f, row0, fq);
#pragma unroll
        for (int ai = 0; ai < 2; ++ai)
#pragma unroll
            for (int m = 0; m < 4; ++m) { const float s = sc[ai][m]; const f32x4 v0 = acc[ai][0][m][0] * s, v1 = acc[ai][0][m][1] * s;
                float q = ((v0[0] * v0[0] + v0[1] * v0[1]) + (v0[2] * v0[2] + v0[3] * v0[3])) + ((v1[0] * v1[0] + v1[1] * v1[1]) + (v1[2] * v1[2] + v1[3] * v1[3]));
                q += __shfl_xor(q, 16); q += __shfl_xor(q, 32);
                if (fq == 0) xch[(ai * HALF + wr * 64 + m * 16 + fr) * 4 + wc] = q; }
        asm volatile("s_waitcnt lgkmcnt(0)" ::: "memory"); __builtin_amdgcn_s_barrier(); asm volatile("" ::: "memory");
        f32x4 g0 = *(const gf32x4*)(gk + c8), g1 = *(const gf32x4*)(gk + c8 + 4);
        const int t = wc * 4 + fq, tp = (t + 8) & 15;
        const f32x4 gr = *(const gf32x4*)(gk + 128 + 4 * t), gp = *(const gf32x4*)(gk + 128 + 4 * tp);
#pragma unroll
        for (int am = 0; am < 4; ++am) { const int ai = am >> 1, m0 = (am & 1) * 2;
            float kq[4]; u32x2 ka[4], kb[4]; f32x4 cs[4], sn[4];
#pragma unroll
            for (int m = m0; m < m0 + 2; ++m) { const int row = u.pm * BM + ai * HALF + wr * 64 + m * 16 + fr, pos = NMETA + (row & (SEQ - 1));
                kq[m] = krss[(size_t)row * 2] + krss[(size_t)row * 2 + 1];
                ka[m] = *(const gu32x2*)(PROJ + (size_t)row * INWP + PC_KR + 4 * t); kb[m] = *(const gu32x2*)(PROJ + (size_t)row * INWP + PC_KR + 4 * tp);
                cs[m] = *(const gf32x4*)(COS + pos * 32 + ((4 * t) & 31)); sn[m] = *(const gf32x4*)(SIN + pos * 32 + ((4 * t) & 31)); }
            __builtin_amdgcn_sched_barrier(0);
#pragma unroll
            for (int m = m0; m < m0 + 2; ++m) { const int rl = ai * HALF + wr * 64 + m * 16 + fr, row = u.pm * BM + rl; const float s = sc[ai][m];
                const f32x4 px = *(const LAS f32x4*)(xch + rl * 4);
                const float r = rsq((((px[0] + px[1]) + (px[2] + px[3])) + kq[m]) * (1.0f / 192.0f) + EPS);
                { const f32x4 v0 = acc[ai][0][m][0] * (s * r) * g0, v1 = acc[ai][0][m][1] * (s * r) * g1;
                  u32x4 w; w.x = cvt_pk_bf16(v0[0], v0[1]); w.y = cvt_pk_bf16(v0[2], v0[3]); w.z = cvt_pk_bf16(v1[0], v1[1]); w.w = cvt_pk_bf16(v1[2], v1[3]);
                  *(gu32x4*)(KA + (size_t)row * 768 + h * 192 + c8) = w; }
                { const f32x4 v0 = acc[ai][1][m][0] * s, v1 = acc[ai][1][m][1] * s;
                  u32x4 w; w.x = cvt_pk_bf16(v0[0], v0[1]); w.y = cvt_pk_bf16(v0[2], v0[3]); w.z = cvt_pk_bf16(v1[0], v1[1]); w.w = cvt_pk_bf16(v1[2], v1[3]);
                  *(gu32x4*)(KV + (size_t)row * 1024 + h * 256 + 128 + c8) = w; }
                { const u32x2 a = ka[m], b = kb[m];
                  const f32x4 x = (f32x4){bf2f(a.x & 0xffffu), bf2f(a.x >> 16), bf2f(a.y & 0xffffu), bf2f(a.y >> 16)} * gr;
                  const f32x4 xp = (f32x4){bf2f(b.x & 0xffffu), bf2f(b.x >> 16), bf2f(b.y & 0xffffu), bf2f(b.y >> 16)} * gp;
                  const f32x4 o = (t < 8 ? x * cs[m] - xp * sn[m] : x * cs[m] + xp * sn[m]) * r;
                  *(gu32x2*)(KA + (size_t)row * 768 + h * 192 + 128 + 4 * t) = (u32x2){cvt_pk_bf16(o[0], o[1]), cvt_pk_bf16(o[2], o[3])}; } }
            __builtin_amdgcn_sched_barrier(0); }
    }
};

template <class Sched>
__device__ __forceinline__ void gemm_prefetch(LAS unsigned char* lds, const Gemm g, const Sched& S, bool perm) {
    int tid_ = threadIdx.x; asm volatile("" : "+v"(tid_));
    const int tid = tid_, wid = __builtin_amdgcn_readfirstlane(tid >> 6);
    Unit cur; if (!S.next(0, cur)) return;
    const int K = g.K, lda = g.lda;
    const size_t hstepA = (size_t)HALF * lda * 2, hstepB = (size_t)HALF * K * 2;
    const char* cA = (const char*)(const void*)g.A + (size_t)cur.pm * 2 * hstepA; const char* cB = (const char*)(const void*)g.Bt + (size_t)cur.pn * 2 * hstepB;
    const unsigned ldsw = (unsigned)wid * 1024u;
    unsigned va[2], vb[2];
#pragma unroll
    for (int i = 0; i < 2; ++i) { int R, C; stage_rc(tid * 16 + i * 8192, R, C); const int Rb = perm ? ((R & ~31) + perm32(R & 31)) : R;
        va[i] = (unsigned)(R * lda + C) * 2u; vb[i] = (unsigned)(Rb * K + C) * 2u; }
#pragma unroll
    for (int i = 0; i < 2; ++i) __builtin_amdgcn_global_load_lds((const gunsigned*)(const void*)(cB + vb[i]), (LAS unsigned*)(lds + 4 * HTB + ldsw + i * 8192), 16, 0, 0);
#pragma unroll
    for (int i = 0; i < 2; ++i) __builtin_amdgcn_global_load_lds((const gunsigned*)(const void*)(cB + hstepB + vb[i]), (LAS unsigned*)(lds + 5 * HTB + ldsw + i * 8192), 16, 0, 0);
#pragma unroll
    for (int i = 0; i < 2; ++i) __builtin_amdgcn_global_load_lds((const gunsigned*)(const void*)(cA + va[i]), (LAS unsigned*)(lds + 0 * HTB + ldsw + i * 8192), 16, 0, 0);
#pragma unroll
    for (int i = 0; i < 2; ++i) __builtin_amdgcn_global_load_lds((const gunsigned*)(const void*)(cA + hstepA + va[i]), (LAS unsigned*)(lds + 1 * HTB + ldsw + i * 8192), 16, 0, 0);
}
template <bool PRE, class Epi, class Sched>
__device__ __forceinline__ void gemm_phase(LAS unsigned char* lds, const Gemm g, const Sched& S, const Epi& E) {
    int tid_ = threadIdx.x; asm volatile("" : "+v"(tid_));
    const int tid = tid_, wid = __builtin_amdgcn_readfirstlane(tid >> 6), lane = tid & 63, wr = wid >> 2, wc = wid & 3, fr = lane & 15, fq = lane >> 4;
    const int K = g.K, nt = K / BK, lda = g.lda;
    unsigned voffA[2], voffB[2];
#pragma unroll
    for (int i = 0; i < 2; ++i) { int R, C; stage_rc(tid * 16 + i * 8192, R, C); const int Rb = Epi::PERM ? ((R & ~31) + perm32(R & 31)) : R;
        voffA[i] = (unsigned)(R * lda + C) * 2u; voffB[i] = (unsigned)(Rb * K + C) * 2u; }
    const size_t kstep = (size_t)(BK * 2);
    const size_t hstepA = (size_t)HALF * lda * 2, hstepB = (size_t)HALF * K * 2;
    const size_t tstepA = 2 * hstepA, tstepB = 2 * hstepB;
    const unsigned ldsw = (unsigned)wid * 1024u;
    const int aoff = lds_byte(wr * 64 + fr, fq * 8), boff = lds_byte(wc * 32 + fr, fq * 8);
#define PG8_SA(b, h) (((b) * 2 + (h)) * HTB)
#define PG8_SB(b, h) ((4 + (b) * 2 + (h)) * HTB)
#define PG8_STAGE(bufoff, gbase, voff) do { _Pragma("unroll") for (int _i = 0; _i < 2; ++_i) \
        __builtin_amdgcn_global_load_lds((const gunsigned*)((const gchar*)(gbase) + (voff)[_i]), (LAS unsigned*)(lds + (bufoff) + ldsw + _i * 8192), 16, 0, 0); } while (0)
#define PG8_LDA(dst, b, h) do { _Pragma("unroll") for (int m = 0; m < 4; ++m) _Pragma("unroll") for (int k = 0; k < 2; ++k) dst[m][k] = *(const LAS bf16x8*)(lds + PG8_SA(b, h) + aoff + m * 2048 + k * 1024); } while (0)
#define PG8_LDB(dst, b, h) do { _Pragma("unroll") for (int n = 0; n < 2; ++n) _Pragma("unroll") for (int k = 0; k < 2; ++k) dst[n][k] = *(const LAS bf16x8*)(lds + PG8_SB(b, h) + boff + n * 2048 + k * 1024); } while (0)
#define PG8_MMA(ai, bj, At, Bt) do { __builtin_amdgcn_s_setprio(1); _Pragma("unroll") for (int m = 0; m < 4; ++m) _Pragma("unroll") for (int n = 0; n < 2; ++n) _Pragma("unroll") for (int k = 0; k < 2; ++k) \
        acc[ai][bj][m][n] = __builtin_amdgcn_mfma_f32_16x16x32_bf16(Bt[n][k], At[m][k], acc[ai][bj][m][n], 0, 0, 0); __builtin_amdgcn_s_setprio(0); } while (0)
#define PG8_WAIT_V(n) asm volatile("s_waitcnt vmcnt(" #n ")" ::: "memory")
#define PG8_WAIT_L(n) asm volatile("s_waitcnt lgkmcnt(" #n ")" ::: "memory")
#define PG8_BAR __builtin_amdgcn_s_barrier()
#define PG8_SCHED __builtin_amdgcn_sched_barrier(0)
    Unit cur, nxt; int ui = 0;
    if (!S.next(0, cur)) return;
    f32x4 acc[2][2][4][2];
#pragma unroll
    for (int a = 0; a < 2; ++a)
#pragma unroll
        for (int b = 0; b < 2; ++b)
#pragma unroll
            for (int m = 0; m < 4; ++m)
#pragma unroll
                for (int n = 0; n < 2; ++n) acc[a][b][m][n] = (f32x4){0.f, 0.f, 0.f, 0.f};
    bf16x8 At[4][2], B0[2][2], B1[2][2];
    const gchar* cA = (const gchar*)g.A + (size_t)cur.pm * tstepA; const gchar* cB = (const gchar*)g.Bt + (size_t)cur.pn * tstepB;
    if constexpr (!PRE) { PG8_STAGE(PG8_SB(0, 0), cB, voffB); PG8_STAGE(PG8_SB(0, 1), cB + hstepB, voffB); PG8_STAGE(PG8_SA(0, 0), cA, voffA); PG8_STAGE(PG8_SA(0, 1), cA + hstepA, voffA); }
    if (wr == 1) PG8_BAR;
    PG8_WAIT_V(2); PG8_BAR;
    PG8_STAGE(PG8_SB(1, 0), cB + kstep, voffB); PG8_STAGE(PG8_SA(1, 0), cA + kstep, voffA); PG8_STAGE(PG8_SB(1, 1), cB + hstepB + kstep, voffB);
    PG8_WAIT_V(6); PG8_BAR;
    for (;;) {
        const bool has_next = S.next(ui + 1, nxt);
        const gchar* nA = has_next ? (const gchar*)g.A + (size_t)nxt.pm * tstepA : cA; const gchar* nB = has_next ? (const gchar*)g.Bt + (size_t)nxt.pn * tstepB : cB;
        for (int t = 0; t < nt; t += 2) {
            const bool last = (t == nt - 2);
            const gchar* a1 = cA + (size_t)(t + 1) * kstep;
            const gchar* a2 = last ? nA : cA + (size_t)(t + 2) * kstep; const gchar* b2 = last ? nB : cB + (size_t)(t + 2) * kstep;
            const gchar* a3 = a2 + kstep; const gchar* b3 = b2 + kstep;
            PG8_LDB(B0, 0, 0); PG8_LDB(B1, 0, 1); PG8_SCHED; PG8_LDA(At, 0, 0); PG8_STAGE(PG8_SA(1, 1), a1 + hstepA, voffA);
            PG8_WAIT_V(8); PG8_WAIT_L(0); PG8_BAR; PG8_MMA(0, 0, At, B0); PG8_MMA(0, 1, At, B1); PG8_BAR; PG8_SCHED;
            PG8_LDA(At, 0, 1); PG8_STAGE(PG8_SB(0, 0), b2, voffB); PG8_STAGE(PG8_SB(0, 1), b2 + hstepB, voffB); PG8_STAGE(PG8_SA(0, 0), a2, voffA);
            PG8_WAIT_V(8); PG8_WAIT_L(0); PG8_BAR; PG8_MMA(1, 0, At, B0); PG8_MMA(1, 1, At, B1); PG8_BAR; PG8_SCHED;
            PG8_LDB(B0, 1, 0); PG8_LDB(B1, 1, 1); PG8_SCHED; PG8_LDA(At, 1, 0); PG8_STAGE(PG8_SA(0, 1), a2 + hstepA, voffA);
            PG8_WAIT_V(8); PG8_WAIT_L(0); PG8_BAR; PG8_MMA(0, 0, At, B0); PG8_MMA(0, 1, At, B1); PG8_BAR; PG8_SCHED;
            PG8_LDA(At, 1, 1); PG8_STAGE(PG8_SB(1, 0), b3, voffB); PG8_STAGE(PG8_SB(1, 1), b3 + hstepB, voffB); PG8_STAGE(PG8_SA(1, 0), a3, voffA);
            PG8_WAIT_V(8); PG8_WAIT_L(0); PG8_BAR; PG8_MMA(1, 0, At, B0); PG8_MMA(1, 1, At, B1); PG8_BAR; PG8_SCHED;
        }
        if (wr == 0) PG8_BAR;
        { Unit ue = cur; int fr_ = fr, fq_ = fq; asm volatile("" : "+s"(ue.pm), "+s"(ue.pn), "+v"(fr_), "+v"(fq_));
          E(acc, ue, wr, wc, fr_, fq_, lds); }
        if (!has_next) break;
#pragma unroll
        for (int a = 0; a < 2; ++a)
#pragma unroll
            for (int b = 0; b < 2; ++b)
#pragma unroll
                for (int m = 0; m < 4; ++m)
#pragma unroll
                    for (int n = 0; n < 2; ++n) acc[a][b][m][n] = (f32x4){0.f, 0.f, 0.f, 0.f};
        cur = nxt; cA = nA; cB = nB; ++ui;
        if (wr == 1) PG8_BAR;
    }
    PG8_WAIT_V(0);
    PG8_BAR;
#undef PG8_SA
#undef PG8_SB
#undef PG8_STAGE
#undef PG8_LDA
#undef PG8_LDB
#undef PG8_MMA
#undef PG8_WAIT_V
#undef PG8_WAIT_L
#undef PG8_BAR
#undef PG8_SCHED
}
}

namespace att {
#define SBAR() __builtin_amdgcn_sched_barrier(0)
constexpr int RING_BYTES = 139264, OFF_WS = RING_BYTES, OFF_GQ = OFF_WS + 8 * 64 * 4  , ATT_LDS = OFF_GQ + 192 * 4;
template <int N> __device__ __forceinline__ void wait_vm_lgkm0() { asm volatile("s_waitcnt vmcnt(%0) lgkmcnt(0)" :: "n"(N) : "memory"); }
__device__ __forceinline__ int crow(int r, int hi) { return (r & 3) + 8 * (r >> 2) + 4 * hi; }
__device__ __forceinline__ int v_st(int k, int c) { const int kk = (k & ~0xC) | ((k & 4) << 1) | ((k & 8) >> 1); return ((kk >> 3) * 4 + (c >> 5)) * 512 + ((kk & 7) * 32 + (c & 31)) * 2; }
__device__ __forceinline__ int v_rd_base(int lane) { return ((lane & 3) << 3) | (((lane >> 2) & 3) << 6) | (((lane >> 4) & 1) << 5) | (((lane >> 5) & 1) << 8); }
constexpr int v_rd_off(int d0, int ks, int half) { return d0 * 512 + ks * 4096 + half * 2048; }
template <int OFF> __device__ __forceinline__ s16x4 tr_read(int vb) {
    s16x4 r; asm volatile("ds_read_b64_tr_b16 %0, %1 offset:%2" : "=&v"(r) : "v"(vb), "i"(OFF) : "memory"); return r;
}
template <int OFF> __device__ __forceinline__ bf16x8 lds_read128(int base) {
    bf16x8 r; asm volatile("ds_read_b128 %0, %1 offset:%2" : "=&v"(r) : "v"(base), "i"(OFF) : "memory"); return r;
}
template <int N> __device__ __forceinline__ void wait_lgkm() { asm volatile("s_waitcnt lgkmcnt(%0)" :: "n"(N) : "memory"); }
template <int D0> __device__ __forceinline__ void pv_reads(s16x4 (&lo)[4], s16x4 (&hi)[4], int vb) {
    lo[0] = tr_read<v_rd_off(D0, 0, 0)>(vb); hi[0] = tr_read<v_rd_off(D0, 0, 1)>(vb); lo[1] = tr_read<v_rd_off(D0, 1, 0)>(vb); hi[1] = tr_read<v_rd_off(D0, 1, 1)>(vb);
    lo[2] = tr_read<v_rd_off(D0, 2, 0)>(vb); hi[2] = tr_read<v_rd_off(D0, 2, 1)>(vb); lo[3] = tr_read<v_rd_off(D0, 3, 0)>(vb); hi[3] = tr_read<v_rd_off(D0, 3, 1)>(vb);
}
__device__ __forceinline__ void pv_mma(f32x16& od, const s16x4 (&lo)[4], const s16x4 (&hi)[4], bf16x8 pa0, bf16x8 pa1, bf16x8 pa2, bf16x8 pa3) {
#define PK(L, H) (bf16x8){L[0], L[1], L[2], L[3], H[0], H[1], H[2], H[3]}
    od = __builtin_amdgcn_mfma_f32_32x32x16_bf16(pa0, PK(lo[0], hi[0]), od, 0, 0, 0);
    od = __builtin_amdgcn_mfma_f32_32x32x16_bf16(pa1, PK(lo[1], hi[1]), od, 0, 0, 0);
    od = __builtin_amdgcn_mfma_f32_32x32x16_bf16(pa2, PK(lo[2], hi[2]), od, 0, 0, 0);
    od = __builtin_amdgcn_mfma_f32_32x32x16_bf16(pa3, PK(lo[3], hi[3]), od, 0, 0, 0);
#undef PK
}
__device__ __forceinline__ void pv_all(f32x16 (&o)[4], int vb, bf16x8 pa0, bf16x8 pa1, bf16x8 pa2, bf16x8 pa3) {
    s16x4 la[4], ha[4], lb[4], hb[4];
    pv_reads<0>(la, ha, vb);
    pv_reads<1>(lb, hb, vb); wait_lgkm<8>(); SBAR(); pv_mma(o[0], la, ha, pa0, pa1, pa2, pa3); SBAR();
    pv_reads<2>(la, ha, vb); wait_lgkm<8>(); SBAR(); pv_mma(o[1], lb, hb, pa0, pa1, pa2, pa3); SBAR();
    pv_reads<3>(lb, hb, vb); wait_lgkm<8>(); SBAR(); pv_mma(o[2], la, ha, pa0, pa1, pa2, pa3); SBAR();
    wait_lgkm<0>(); SBAR(); pv_mma(o[3], lb, hb, pa0, pa1, pa2, pa3);
}
template <int C> __device__ __forceinline__ void sm_chunk4(const f32x16& P, float& ps, unsigned (&pw)[16]) {
    constexpr int B = (C & 3) * 4;
    const float e0 = __builtin_amdgcn_exp2f(P[B]), e1 = __builtin_amdgcn_exp2f(P[B + 1]), e2 = __builtin_amdgcn_exp2f(P[B + 2]), e3 = __builtin_amdgcn_exp2f(P[B + 3]);
    ps += (e0 + e1) + (e2 + e3);
    pw[2 * C] = cvt_pk_bf16(e0, e1); pw[2 * C + 1] = cvt_pk_bf16(e2, e3);
}
template <int D0, int KH> __device__ __forceinline__ void pv_reads_h(s16x4 (&lo)[2], s16x4 (&hi)[2], int vb) {
    lo[0] = tr_read<v_rd_off(D0, 2 * KH, 0)>(vb); hi[0] = tr_read<v_rd_off(D0, 2 * KH, 1)>(vb); lo[1] = tr_read<v_rd_off(D0, 2 * KH + 1, 0)>(vb); hi[1] = tr_read<v_rd_off(D0, 2 * KH + 1, 1)>(vb);
}
__device__ __forceinline__ void pv_mma_h(f32x16& od, const s16x4 (&lo)[2], const s16x4 (&hi)[2], bf16x8 a, bf16x8 b) {
#define PK(L, H) (bf16x8){L[0], L[1], L[2], L[3], H[0], H[1], H[2], H[3]}
    od = __builtin_amdgcn_mfma_f32_32x32x16_bf16(a, PK(lo[0], hi[0]), od, 0, 0, 0);
    od = __builtin_amdgcn_mfma_f32_32x32x16_bf16(b, PK(lo[1], hi[1]), od, 0, 0, 0);
#undef PK
}
#define ATT_SGB() do { _Pragma("unroll") for (int i_ = 0; i_ < 2; ++i_) { __builtin_amdgcn_sched_group_barrier(0x008, 1, 0); __builtin_amdgcn_sched_group_barrier(0x402, 5, 0); } } while (0)
__device__ __forceinline__ void pv_sm_all(f32x16 (&o)[4], int vb, bf16x8 pa0, bf16x8 pa1, bf16x8 pa2, bf16x8 pa3, const f32x16& p0, const f32x16& p1, float& ps, unsigned (&pw)[16]) {
    s16x4 la[2], ha[2], lb[2], hb[2];
    pv_reads_h<0, 0>(la, ha, vb);
    pv_reads_h<0, 1>(lb, hb, vb); wait_lgkm<4>(); SBAR(); pv_mma_h(o[0], la, ha, pa0, pa1); sm_chunk4<0>(p0, ps, pw); ATT_SGB(); SBAR();
    pv_reads_h<1, 0>(la, ha, vb); wait_lgkm<4>(); SBAR(); pv_mma_h(o[0], lb, hb, pa2, pa3); sm_chunk4<1>(p0, ps, pw); ATT_SGB(); SBAR();
    pv_reads_h<1, 1>(lb, hb, vb); wait_lgkm<4>(); SBAR(); pv_mma_h(o[1], la, ha, pa0, pa1); sm_chunk4<2>(p0, ps, pw); ATT_SGB(); SBAR();
    pv_reads_h<2, 0>(la, ha, vb); wait_lgkm<4>(); SBAR(); pv_mma_h(o[1], lb, hb, pa2, pa3); sm_chunk4<3>(p0, ps, pw); ATT_SGB(); SBAR();
    pv_reads_h<2, 1>(lb, hb, vb); wait_lgkm<4>(); SBAR(); pv_mma_h(o[2], la, ha, pa0, pa1); sm_chunk4<4>(p1, ps, pw); ATT_SGB(); SBAR();
    pv_reads_h<3, 0>(la, ha, vb); wait_lgkm<4>(); SBAR(); pv_mma_h(o[2], lb, hb, pa2, pa3); sm_chunk4<5>(p1, ps, pw); ATT_SGB(); SBAR();
    pv_reads_h<3, 1>(lb, hb, vb); wait_lgkm<4>(); SBAR(); pv_mma_h(o[3], la, ha, pa0, pa1); sm_chunk4<6>(p1, ps, pw); ATT_SGB(); SBAR();
    wait_lgkm<0>(); SBAR(); pv_mma_h(o[3], lb, hb, pa2, pa3); sm_chunk4<7>(p1, ps, pw); ATT_SGB(); SBAR();
}
template <int NKP> struct DmaCtx { LAS char* kdst; LAS char* vdst; size_t kstride, vstride; bool on; };
template <int DQK> __device__ __forceinline__ constexpr int dma_piece_after(int g) { return DQK == 192 ? (((g & 1) && g < 10) ? (g >> 1) : -1) : (g < 3 ? g : -1); }
template <int NKP, int I> __device__ __forceinline__ void dma_piece(const DmaCtx<NKP>& dc, const gbf16_t* (&kp1)[NKP], const gbf16_t* (&vp1)[2], int wid) {
    if (dc.on) {
        if constexpr (I < NKP) { __builtin_amdgcn_global_load_lds((const gunsigned*)kp1[I], (LAS unsigned*)(dc.kdst + (wid + 8 * I) * 1024), 16, 0, 0); kp1[I] += dc.kstride; }
        else { __builtin_amdgcn_global_load_lds((const gunsigned*)vp1[I - NKP], (LAS unsigned*)(dc.vdst + (wid + 8 * (I - NKP)) * 1024), 16, 0, 0); vp1[I - NKP] += dc.vstride; }
    }
}
template <int DQK, int G, int NKP> __device__ __forceinline__ void qk_step(f32x16& p0, f32x16& p1, bf16x8 (&kf)[2][2], const int (&kb)[4], const bf16x8 (&qr)[DQK / 16],
                                                                           const DmaCtx<NKP>& dc, const gbf16_t* (&kp1)[NKP], const gbf16_t* (&vp1)[2], int wid) {
    constexpr int ND = DQK / 16, RB = DQK * 2;
    if constexpr (G + 1 < ND) { kf[(G + 1) & 1][0] = lds_read128<((G + 1) >> 2) * 128>(kb[(G + 1) & 3]); kf[(G + 1) & 1][1] = lds_read128<((G + 1) >> 2) * 128 + 32 * RB>(kb[(G + 1) & 3]); wait_lgkm<2>(); }
    else { wait_lgkm<0>(); }
    SBAR();
    p0 = __builtin_amdgcn_mfma_f32_32x32x16_bf16(kf[G & 1][0], qr[G], p0, 0, 0, 0); p1 = __builtin_amdgcn_mfma_f32_32x32x16_bf16(kf[G & 1][1], qr[G], p1, 0, 0, 0);
    SBAR();
    if constexpr (dma_piece_after<DQK>(G) >= 0) { dma_piece<NKP, dma_piece_after<DQK>(G)>(dc, kp1, vp1, wid); SBAR(); }
    if constexpr (G + 1 < ND) qk_step<DQK, G + 1, NKP>(p0, p1, kf, kb, qr, dc, kp1, vp1, wid);
}
template <int DQK, int NKP> __device__ __forceinline__ void qkt_tile_n(f32x16& p0, f32x16& p1, const int (&kb)[4], const bf16x8 (&qr)[DQK / 16],
                                                                      const DmaCtx<NKP>& dc, const gbf16_t* (&kp1)[NKP], const gbf16_t* (&vp1)[2], int wid) {
    p0 = f32x16{}; p1 = f32x16{};
    bf16x8 kf[2][2];
    SBAR(); kf[0][0] = lds_read128<0>(kb[0]); kf[0][1] = lds_read128<32 * DQK * 2>(kb[0]);
    qk_step<DQK, 0, NKP>(p0, p1, kf, kb, qr, dc, kp1, vp1, wid);
}
template <int RB, int G> __device__ __forceinline__ void k_reads(bf16x8 (&dst)[4], const int (&kb)[4]) {
    dst[0] = lds_read128<((2 * G) >> 2) * 128>(kb[(2 * G) & 3]);         dst[1] = lds_read128<((2 * G) >> 2) * 128 + 32 * RB>(kb[(2 * G) & 3]);
    dst[2] = lds_read128<((2 * G + 1) >> 2) * 128>(kb[(2 * G + 1) & 3]); dst[3] = lds_read128<((2 * G + 1) >> 2) * 128 + 32 * RB>(kb[(2 * G + 1) & 3]);
}
template <int DQK, int G> __device__ __forceinline__ void qk_group(f32x16& p0, f32x16& p1, bf16x8 (&kf)[2][4], const int (&kb)[4], const bf16x8 (&qr)[DQK / 16]) {
    constexpr int NG = DQK / 32, RB = DQK * 2;
    if constexpr (G + 1 < NG) { k_reads<RB, G + 1>(kf[(G + 1) & 1], kb); wait_lgkm<4>(); } else { wait_lgkm<0>(); }
    SBAR();
    p0 = __builtin_amdgcn_mfma_f32_32x32x16_bf16(kf[G & 1][0], qr[2 * G], p0, 0, 0, 0);     p1 = __builtin_amdgcn_mfma_f32_32x32x16_bf16(kf[G & 1][1], qr[2 * G], p1, 0, 0, 0);
    p0 = __builtin_amdgcn_mfma_f32_32x32x16_bf16(kf[G & 1][2], qr[2 * G + 1], p0, 0, 0, 0); p1 = __builtin_amdgcn_mfma_f32_32x32x16_bf16(kf[G & 1][3], qr[2 * G + 1], p1, 0, 0, 0);
    SBAR();
    if constexpr (G + 1 < NG) qk_group<DQK, G + 1>(p0, p1, kf, kb, qr);
}
template <int DQK> __device__ __forceinline__ void qkt_tile(f32x16& p0, f32x16& p1, const int (&kb)[4], const bf16x8 (&qr)[DQK / 16]) {
    p0 = f32x16{}; p1 = f32x16{};
    if constexpr (false && DQK == 64) {
        bf16x8 kf[4];
        SBAR(); k_reads<128, 0>(kf, kb); wait_lgkm<0>(); SBAR();
        p0 = __builtin_amdgcn_mfma_f32_32x32x16_bf16(kf[0], qr[0], p0, 0, 0, 0); p1 = __builtin_amdgcn_mfma_f32_32x32x16_bf16(kf[1], qr[0], p1, 0, 0, 0);
        p0 = __builtin_amdgcn_mfma_f32_32x32x16_bf16(kf[2], qr[1], p0, 0, 0, 0); p1 = __builtin_amdgcn_mfma_f32_32x32x16_bf16(kf[3], qr[1], p1, 0, 0, 0);
        SBAR(); k_reads<128, 1>(kf, kb); wait_lgkm<0>(); SBAR();
        p0 = __builtin_amdgcn_mfma_f32_32x32x16_bf16(kf[0], qr[2], p0, 0, 0, 0); p1 = __builtin_amdgcn_mfma_f32_32x32x16_bf16(kf[1], qr[2], p1, 0, 0, 0);
        p0 = __builtin_amdgcn_mfma_f32_32x32x16_bf16(kf[2], qr[3], p0, 0, 0, 0); p1 = __builtin_amdgcn_mfma_f32_32x32x16_bf16(kf[3], qr[3], p1, 0, 0, 0);
        SBAR();
    } else {
        bf16x8 kf[2][4];
        SBAR(); k_reads<DQK * 2, 0>(kf[0], kb);
        qk_group<DQK, 0>(p0, p1, kf, kb, qr);
    }
}
__device__ __forceinline__ int key_row(int b, int p) { p = p < LSEQ ? p : LSEQ - 1; return p < NMETA ? NREAL + p : b * SEQ + p - NMETA; }

constexpr float THR = 6.0f;
constexpr float SCORE_BOUND_OK = 64.0f;
template <int DQK, bool QXF = false, bool NOMAX = false>
__device__ __forceinline__ void attn_map(const gbf16_t* __restrict__ Qp, int ldq, const gbf16_t* __restrict__ Kp, int ldk, const gbf16_t* __restrict__ Vp, int ldv,
                                         int b, int qpos0, int NT, f32x16 (&o)[4], float& l_out, LAS char* lds, void* probe_ptr = nullptr,
                                         const gfloat* gq = nullptr, const gfloat* COS = nullptr, const gfloat* SIN = nullptr) {
    constexpr int RB = DQK * 2, ND = DQK / 16, NKP = (64 * RB / 1024) / 8;
    constexpr int KSLOT = 64 * RB, DEPTH_ = DQK == 192 ? 2 : 4, NKS = DEPTH_ + 1, NVS = DEPTH_ + 2, NP = NKP + 2, OFF_K = 0, OFF_V = NKS * KSLOT;
    static_assert(OFF_V + NVS * 16384 <= RING_BYTES, "attention rings");
    int tid_ = threadIdx.x; asm volatile("" : "+v"(tid_));
    const int tid = tid_, wid = __builtin_amdgcn_readfirstlane(tid >> 6), lane = tid & 63, r32 = lane & 31, hi = lane >> 5;
    LAS char* K_lds = lds + OFF_K; LAS char* V_lds = lds + OFF_V; LAS float* al_l = (LAS float*)(lds + OFF_WS) + wid * 64;
    bf16x8 qr[ND];
    const int qpos = qpos0 + wid * 32 + r32, wq_min = qpos0 + wid * 32, wq_max = wq_min + 31;
    if constexpr (!QXF) {
        const gbf16_t* Qw = Qp + (size_t)(wid * 32 + r32) * ldq + hi * 8;
#pragma unroll
        for (int d0 = 0; d0 < ND; ++d0) qr[d0] = *(const gbf16x8*)(Qw + d0 * 16);
    } else {
        static_assert(DQK == 192, "QXF is the MLA q transform");
        f32x4 cv[2][2], sv[2][2];
        { const gbf16_t* Qw = Qp + (size_t)(wid * 32 + r32) * ldq + hi * 8;
#pragma unroll
          for (int d0 = 0; d0 < ND; ++d0) qr[d0] = *(const gbf16x8*)(Qw + d0 * 16);
#pragma unroll
          for (int p = 0; p < 2; ++p) { cv[p][0] = *(const gf32x4*)(COS + qpos * 32 + 16 * p + 8 * hi); cv[p][1] = *(const gf32x4*)(COS + qpos * 32 + 16 * p + 8 * hi + 4);
              sv[p][0] = *(const gf32x4*)(SIN + qpos * 32 + 16 * p + 8 * hi); sv[p][1] = *(const gf32x4*)(SIN + qpos * 32 + 16 * p + 8 * hi + 4); } }
        SBAR();
        const LAS float* gl = (const LAS float*)(lds + OFF_GQ) + 8 * hi;
        float ssq = 0.f;
#pragma unroll
        for (int d0 = 0; d0 < ND; ++d0)
#pragma unroll
            for (int e = 0; e < 8; ++e) { const float x = bf2f((unsigned)(unsigned short)qr[d0][e]); ssq += x * x; }
        { auto rr = __builtin_amdgcn_permlane32_swap(__float_as_uint(ssq), __float_as_uint(ssq), false, false); ssq = __uint_as_float(rr[0]) + __uint_as_float(rr[1]); }
        const float r = CA * rsq(ssq * (1.0f / 192.0f) + EPS);
#pragma unroll
        for (int d0 = 0; d0 < 8; ++d0) { const f32x4 ga = *(const LAS f32x4*)(gl + 16 * d0), gb = *(const LAS f32x4*)(gl + 16 * d0 + 4);
            const u32x4 w = {cvt_pk_bf16(bf2f((unsigned)(unsigned short)qr[d0][0]) * r * ga[0], bf2f((unsigned)(unsigned short)qr[d0][1]) * r * ga[1]), cvt_pk_bf16(bf2f((unsigned)(unsigned short)qr[d0][2]) * r * ga[2], bf2f((unsigned)(unsigned short)qr[d0][3]) * r * ga[3]),
                             cvt_pk_bf16(bf2f((unsigned)(unsigned short)qr[d0][4]) * r * gb[0], bf2f((unsigned)(unsigned short)qr[d0][5]) * r * gb[1]), cvt_pk_bf16(bf2f((unsigned)(unsigned short)qr[d0][6]) * r * gb[2], bf2f((unsigned)(unsigned short)qr[d0][7]) * r * gb[3])};
            qr[d0] = __builtin_bit_cast(bf16x8, w); }
#pragma unroll
        for (int p = 0; p < 2; ++p) {
            const int da = 8 + p, db = 10 + p; float ya[8], yb[8], cs[8], sn[8];
            { const f32x4 ga = *(const LAS f32x4*)(gl + 16 * da), gb = *(const LAS f32x4*)(gl + 16 * da + 4), gc = *(const LAS f32x4*)(gl + 16 * db), gd = *(const LAS f32x4*)(gl + 16 * db + 4);
#pragma unroll
              for (int e = 0; e < 4; ++e) { ya[e] = bf2f((unsigned)(unsigned short)qr[da][e]) * r * ga[e]; ya[4 + e] = bf2f((unsigned)(unsigned short)qr[da][4 + e]) * r * gb[e];
                  yb[e] = bf2f((unsigned)(unsigned short)qr[db][e]) * r * gc[e]; yb[4 + e] = bf2f((unsigned)(unsigned short)qr[db][4 + e]) * r * gd[e];
                  cs[e] = cv[p][0][e]; cs[4 + e] = cv[p][1][e]; sn[e] = sv[p][0][e]; sn[4 + e] = sv[p][1][e]; } }
            u32x4 wa, wb;
#pragma unroll
            for (int e = 0; e < 4; ++e) { wa[e] = cvt_pk_bf16(ya[2 * e] * cs[2 * e] - yb[2 * e] * sn[2 * e], ya[2 * e + 1] * cs[2 * e + 1] - yb[2 * e + 1] * sn[2 * e + 1]);
                wb[e] = cvt_pk_bf16(yb[2 * e] * cs[2 * e] + ya[2 * e] * sn[2 * e], yb[2 * e + 1] * cs[2 * e + 1] + ya[2 * e + 1] * sn[2 * e + 1]); }
            qr[da] = __builtin_bit_cast(bf16x8, wa); qr[db] = __builtin_bit_cast(bf16x8, wb); }
    }
    float m_reg = -1e30f, l_reg = 0.f;
#pragma unroll
    for (int d = 0; d < 4; ++d) o[d] = f32x16{};
    const int vb0 = (int)(unsigned)(uintptr_t)V_lds + v_rd_base(lane);
    int NTw = wq_max / 64 + 1; NTw = NTw < NT ? NTw : NT;
    const int jb = wq_min / 64;
    int kb4[4];
#pragma unroll
    for (int i = 0; i < 4; ++i) kb4[i] = r32 * RB + (((i * 2 + hi) ^ ((r32 >> 1) & 7)) << 4);
    const gbf16_t* kp1[NKP]; const gbf16_t* vp1[2]; const gbf16_t* kp0[NKP]; const gbf16_t* vp0[2];
#pragma unroll
    for (int i = 0; i < NKP; ++i) { const int L = (wid + 8 * i) * 1024 + 16 * lane, row = L / RB, within = L % RB, col = ((within ^ (((row >> 1) & 7) << 4)) >> 4) * 8;
        kp0[i] = Kp + (size_t)key_row(b, row) * ldk + col; kp1[i] = Kp + (size_t)(b * SEQ + 64 - NMETA + row) * ldk + col; }
#pragma unroll
    for (int i = 0; i < 2; ++i) { const int L = (wid + 8 * i) * 1024 + 16 * lane, sub = L >> 9, rem = L & 511, kk = (sub >> 2) * 8 + (rem >> 6);
        const int k = kk, col = (sub & 3) * 32 + ((rem & 63) >> 1);
        vp0[i] = Vp + (size_t)key_row(b, k) * ldv + col; vp1[i] = Vp + (size_t)(b * SEQ + 64 - NMETA + k) * ldv + col; }
    const size_t kstride = (size_t)64 * ldk, vstride = (size_t)64 * ldv;
#define ATT_DMA0() do { \
        _Pragma("unroll") for (int i_ = 0; i_ < NKP; ++i_) __builtin_amdgcn_global_load_lds((const gunsigned*)kp0[i_], (LAS unsigned*)(K_lds + (wid + 8 * i_) * 1024), 16, 0, 0); \
        _Pragma("unroll") for (int i_ = 0; i_ < 2; ++i_) __builtin_amdgcn_global_load_lds((const gunsigned*)vp0[i_], (LAS unsigned*)(V_lds + (wid + 8 * i_) * 1024), 16, 0, 0); } while (0)
#define ATT_DMA(j) do { const int ks_ = ((j) % NKS) * KSLOT, vs_ = ((j) % NVS) * 16384; \
        _Pragma("unroll") for (int i_ = 0; i_ < NKP; ++i_) { __builtin_amdgcn_global_load_lds((const gunsigned*)kp1[i_], (LAS unsigned*)(K_lds + ks_ + (wid + 8 * i_) * 1024), 16, 0, 0); kp1[i_] += kstride; } \
        _Pragma("unroll") for (int i_ = 0; i_ < 2; ++i_) { __builtin_amdgcn_global_load_lds((const gunsigned*)vp1[i_], (LAS unsigned*)(V_lds + vs_ + (wid + 8 * i_) * 1024), 16, 0, 0); vp1[i_] += vstride; } } while (0)
#define ATT_BAR(j) do { int c_ = ((j) + DEPTH_ - 1 < NT - 1 ? (j) + DEPTH_ - 1 : NT - 1) - (j); c_ = c_ < 0 ? 0 : c_; \
        if (c_ == 0) wait_vm_lgkm0<0>(); else if (c_ == 1) wait_vm_lgkm0<NP>(); else if (c_ == 2) wait_vm_lgkm0<2 * NP>(); else wait_vm_lgkm0<3 * NP>(); \
        __builtin_amdgcn_s_barrier(); asm volatile("" ::: "memory"); } while (0)
#define ATT_QKT(P0, P1, j) do { const int ko_ = (int)(unsigned)(uintptr_t)K_lds + ((j) % NKS) * KSLOT; int kbs_[4]; \
        _Pragma("unroll") for (int i_ = 0; i_ < 4; ++i_) kbs_[i_] = ko_ + kb4[i_]; \
        qkt_tile<DQK>(P0, P1, kbs_, qr); } while (0)
#define ATT_PARTIAL(P0, P1, AL, j, MASK) do { \
        if (MASK) { const int d_ = qpos - 64 * (j) - 4 * hi; _Pragma("unroll") for (int r = 0; r < 16; ++r) { if ((r & 3) + 8 * (r >> 2) > d_) P0[r] = -1e30f; if ((r & 3) + 8 * (r >> 2) + 32 > d_) P1[r] = -1e30f; } } \
        float pmax = P0[0]; _Pragma("unroll") for (int r = 1; r < 16; ++r) pmax = fmaxf(pmax, P0[r]); _Pragma("unroll") for (int r = 0; r < 16; ++r) pmax = fmaxf(pmax, P1[r]); \
        { auto rr = __builtin_amdgcn_permlane32_swap(__float_as_uint(pmax), __float_as_uint(pmax), false, false); pmax = fmaxf(__uint_as_float(rr[0]), __uint_as_float(rr[1])); } \
        if (__builtin_expect(__all(pmax - m_reg <= THR), 1)) { AL = 1.f; } else { const float mn = fmaxf(m_reg, pmax); AL = __builtin_amdgcn_exp2f(m_reg - mn); m_reg = mn; } \
        _Pragma("unroll") for (int r = 0; r < 16; ++r) { P0[r] = __builtin_amdgcn_exp2f(P0[r] - m_reg); P1[r] = P1[r] - m_reg; } } while (0)
#define ATT_RESC(AL) do { if (__any((AL) < 1.f)) { if (hi == 0) al_l[r32] = (AL); LDS_WAIT(); \
        _Pragma("unroll") for (int r = 0; r < 16; ++r) { const float a_ = al_l[crow(r, hi)]; _Pragma("unroll") for (int d = 0; d < 4; ++d) o[d][r] *= a_; } } } while (0)
#define ATT_PK4(P, BASE, OUT) do { u32x4 w = {cvt_pk_bf16(P[BASE + 0], P[BASE + 1]), cvt_pk_bf16(P[BASE + 2], P[BASE + 3]), cvt_pk_bf16(P[BASE + 4], P[BASE + 5]), cvt_pk_bf16(P[BASE + 6], P[BASE + 7])}; \
        OUT = __builtin_bit_cast(bf16x8, w); } while (0)
#define ATT_FINISH(P0, P1, AL) do { _Pragma("unroll") for (int r = 0; r < 16; ++r) P1[r] = __builtin_amdgcn_exp2f(P1[r]); \
        float ps = 0.f; _Pragma("unroll") for (int r = 0; r < 16; ++r) ps += P0[r] + P1[r]; \
        { auto rr = __builtin_amdgcn_permlane32_swap(__float_as_uint(ps), __float_as_uint(ps), false, false); ps = __uint_as_float(rr[0]) + __uint_as_float(rr[1]); } \
        l_reg = l_reg * (AL) + ps; ATT_PK4(P0, 0, pa0); ATT_PK4(P0, 8, pa1); ATT_PK4(P1, 0, pa2); ATT_PK4(P1, 8, pa3); } while (0)
#define ATT_PV(j) do { const int vb_ = vb0 + ((j) % NVS) * 16384; pv_all(o, vb_, pa0, pa1, pa2, pa3); } while (0)
    f32x16 p0 = f32x16{}, p1 = f32x16{}; float al = 1.f; bf16x8 pa0, pa1, pa2, pa3;
#define ATT_MASKONLY(P0, P1, j) do { const int d_ = qpos - 64 * (j) - 4 * hi; _Pragma("unroll") for (int r = 0; r < 16; ++r) { if ((r & 3) + 8 * (r >> 2) > d_) P0[r] = -1e30f; if ((r & 3) + 8 * (r >> 2) + 32 > d_) P1[r] = -1e30f; } } while (0)
#define ATT_SMPV(jj) do { if constexpr (NOMAX) { if ((jj) >= jb) ATT_MASKONLY(p0, p1, jj); \
            _Pragma("unroll") for (int r = 0; r < 16; ++r) p0[r] = __builtin_amdgcn_exp2f(p0[r]); ATT_FINISH(p0, p1, 1.0f); } \
        else { if ((jj) >= jb) { ATT_PARTIAL(p0, p1, al, jj, true); } else { ATT_PARTIAL(p0, p1, al, jj, false); } ATT_RESC(al); ATT_FINISH(p0, p1, al); } \
        SBAR(); ATT_PV(jj); } while (0)
    const bool groupA = wid < 4;
    __syncthreads();
    ATT_DMA0();
#pragma unroll
    for (int t = 1; t < DEPTH_; ++t) if (t < NT) ATT_DMA(t);
#if defined(PROBE_T)
    const bool prb = (blockIdx.x == PROBE_BLK) && (wid == PROBE_WAVE);
    unsigned long long tb = 0, tq = 0, ts = 0, t0_ = __builtin_amdgcn_s_memtime();
#define PT_BEG() unsigned long long t1_ = 0; if (prb) { __builtin_amdgcn_sched_barrier(0); t1_ = __builtin_amdgcn_s_memtime(); __builtin_amdgcn_sched_barrier(0); }
#define PT_END(acc) if (prb) { __builtin_amdgcn_sched_barrier(0); asm volatile("s_waitcnt lgkmcnt(0)" ::: "memory"); acc += __builtin_amdgcn_s_memtime() - t1_; __builtin_amdgcn_sched_barrier(0); }
#else
#define PT_BEG()
#define PT_END(acc)
#endif
    if constexpr (NOMAX) {
        unsigned pw[16];
        static_assert(NP == (DQK == 192 ? 5 : 3), "dma_piece_after() places exactly NP pieces");
#define ATT_QKT_N(j) do { const int ko_ = (int)(unsigned)(uintptr_t)K_lds + ((j) % NKS) * KSLOT; int kbs_[4]; \
        _Pragma("unroll") for (int i_ = 0; i_ < 4; ++i_) kbs_[i_] = ko_ + kb4[i_]; \
        DmaCtx<NKP> dc_; dc_.kdst = K_lds + (((j) + DEPTH_) % NKS) * KSLOT; dc_.vdst = V_lds + (((j) + DEPTH_) % NVS) * 16384; dc_.kstride = kstride; dc_.vstride = vstride; dc_.on = (j) + DEPTH_ < NT; \
        qkt_tile_n<DQK, NKP>(p0, p1, kbs_, qr, dc_, kp1, vp1, wid); } while (0)
#define ATT_PW2PA() do { pa0 = __builtin_bit_cast(bf16x8, (u32x4){pw[0], pw[1], pw[2], pw[3]}); pa1 = __builtin_bit_cast(bf16x8, (u32x4){pw[4], pw[5], pw[6], pw[7]}); \
        pa2 = __builtin_bit_cast(bf16x8, (u32x4){pw[8], pw[9], pw[10], pw[11]}); pa3 = __builtin_bit_cast(bf16x8, (u32x4){pw[12], pw[13], pw[14], pw[15]}); } while (0)
#define ATT_LSUM(ps_) do { auto rr = __builtin_amdgcn_permlane32_swap(__float_as_uint(ps_), __float_as_uint(ps_), false, false); ps_ = __uint_as_float(rr[0]) + __uint_as_float(rr[1]); } while (0)
        {
            ATT_BAR(0);
            ATT_QKT_N(0);
            if (0 >= jb) ATT_MASKONLY(p0, p1, 0);
            float ps = 0.f;
            sm_chunk4<0>(p0, ps, pw); sm_chunk4<1>(p0, ps, pw); sm_chunk4<2>(p0, ps, pw); sm_chunk4<3>(p0, ps, pw); sm_chunk4<4>(p1, ps, pw); sm_chunk4<5>(p1, ps, pw); sm_chunk4<6>(p1, ps, pw); sm_chunk4<7>(p1, ps, pw);
            ATT_LSUM(ps); l_reg = ps; ATT_PW2PA();
        }
        for (int j = 1; j < NT; ++j) {
            ATT_BAR(j);
            if (j >= NTw && j + DEPTH_ < NT) ATT_DMA(j + DEPTH_);
            if (j <= NTw) {
                if (j < NTw) { ATT_QKT_N(j); if (j >= jb) ATT_MASKONLY(p0, p1, j); }
                float ps = 0.f;
                { const int vb_ = vb0 + ((j - 1) % NVS) * 16384; pv_sm_all(o, vb_, pa0, pa1, pa2, pa3, p0, p1, ps, pw); }
                ATT_LSUM(ps); l_reg += (j < NTw) ? ps : 0.f; ATT_PW2PA();
            }
        }
        if (NTw == NT) { SBAR(); ATT_PV(NT - 1); }
#undef ATT_QKT_N
#undef ATT_PW2PA
#undef ATT_LSUM
    } else {
    for (int j = 0; j < NT; ++j) {
        if (groupA) { { PT_BEG(); ATT_BAR(j); PT_END(tb); } if (j + DEPTH_ < NT) ATT_DMA(j + DEPTH_); }
        if (j >= 1 && j - 1 < NTw) { PT_BEG(); ATT_SMPV(j - 1); PT_END(ts); }
        if (!groupA) { { PT_BEG(); ATT_BAR(j); PT_END(tb); } if (j + DEPTH_ < NT) ATT_DMA(j + DEPTH_); }
        if (j < NTw) { PT_BEG(); ATT_QKT(p0, p1, j); PT_END(tq); }
    }
#if defined(PROBE_T)
    if (prb && lane == 0) { unsigned long long* pt = (unsigned long long*)(probe_ptr); pt[0] += __builtin_amdgcn_s_memtime() - t0_; pt[1] += tb; pt[2] += tq; pt[3] += ts; }
#endif
    if (NTw == NT) ATT_SMPV(NT - 1);
    }
#undef ATT_SMPV
#undef ATT_MASKONLY
#undef ATT_DMA
#undef ATT_DMA0
#undef ATT_BAR
#undef ATT_QKT
#undef ATT_PARTIAL
#undef ATT_RESC
#undef ATT_PK4
#undef ATT_FINISH
#undef ATT_PV
    l_out = l_reg;
}
__device__ __forceinline__ void row_recip(float l, float (&rli)[16], LAS char* lds, int wid, int r32, int hi) {
    LAS float* li_l = (LAS float*)(lds + OFF_WS) + wid * 64 + 32;
    if (hi == 0) li_l[r32] = l;
    LDS_WAIT();
#pragma unroll
    for (int r = 0; r < 16; ++r) rli[r] = __builtin_amdgcn_rcpf(li_l[crow(r, hi)]);
    LDS_WAIT();
}
#undef SBAR
}


#define XB_TMO      128
#define XB_XCNT(j)  (256  + 64 * (j))
#define XB_XSUB(j)  (1280 + 64 * (j))
#define XB_XGEN(j)  (2304 + 64 * (j))
#define XB_TOP      3328
#define XB_TOPGEN   3392
#define XCD_BAR_WORDS 3456
#define XB_SPIN_CAP (1u << 18)
__device__ __forceinline__ unsigned xb_ld(unsigned* p)              { return __hip_atomic_load(p, __ATOMIC_RELAXED, __HIP_MEMORY_SCOPE_AGENT); }
__device__ __forceinline__ unsigned xb_add(unsigned* p, unsigned v) { return __hip_atomic_fetch_add(p, v, __ATOMIC_RELAXED, __HIP_MEMORY_SCOPE_AGENT); }
__device__ __forceinline__ unsigned xb_xcc_id() { return (unsigned)__builtin_amdgcn_s_getreg((3 << 11) | 20) & 0xFu; }
#define XB_SPIN(cond, bar) do { unsigned _sp = 0; while (cond) { __builtin_amdgcn_s_sleep(1); \
    if ((++_sp & 255u) == 0u) { if (xb_ld(&(bar)[XB_TMO])) break; if (_sp > XB_SPIN_CAP) { atomicAdd(&(bar)[XB_TMO], 1u); break; } } } } while (0)
struct XcdBarrier { unsigned* bar; unsigned x; volatile LAS unsigned* st; };
__device__ __forceinline__ XcdBarrier xcd_barrier_post(unsigned* bar, volatile LAS unsigned* st) {
    XcdBarrier b; b.bar = bar; b.x = xb_xcc_id(); b.st = st;
    if (threadIdx.x == 0) (void)xb_add(&bar[XB_XCNT(b.x)], 1u);
    return b;
}
__device__ __forceinline__ void xcd_barrier_complete(unsigned* bar, unsigned x, unsigned& nloc, unsigned& nx) {
    const unsigned G = gridDim.x * gridDim.y * gridDim.z;
    unsigned sum, cnt, mine, sp = 0u;
    for (;;) {
        sum = 0u; cnt = 0u; mine = 0u;
#pragma unroll
        for (unsigned j = 0; j < 16; ++j) { const unsigned c = xb_ld(&bar[XB_XCNT(j)]); sum += c; cnt += (c > 0u) ? 1u : 0u; mine = (j == x) ? c : mine; }
        if (sum == G) break;
        __builtin_amdgcn_s_sleep(1);
        if ((++sp & 255u) == 0u) { if (xb_ld(&bar[XB_TMO])) break; if (sp > XB_SPIN_CAP) { atomicAdd(&bar[XB_TMO], 1u); break; } }
    }
    nloc = mine > 0u ? mine : 1u; nx = cnt > 0u ? cnt : 1u;
}
__device__ __forceinline__ void xcd_barrier(const XcdBarrier& b) {
    asm volatile("s_waitcnt vmcnt(0)" ::: "memory");
    __syncthreads();
    if (threadIdx.x == 0) {
        unsigned* bar = b.bar;
        __builtin_amdgcn_s_waitcnt(0);
        unsigned nloc = b.st[0], nx = b.st[1];
        if (nloc == 0u) { xcd_barrier_complete(bar, b.x, nloc, nx); b.st[0] = nloc; b.st[1] = nx; }
        const unsigned old = xb_add(&bar[XB_XSUB(b.x)], 1u);
        const unsigned gen = old / nloc;
        if (old + 1u == (gen + 1u) * nloc) {
            __builtin_amdgcn_fence(__ATOMIC_RELEASE, "agent");
            asm volatile("s_waitcnt vmcnt(0)" ::: "memory");
            const unsigned og = xb_add(&bar[XB_TOP], 1u);
            const unsigned tg = og / nx;
            if (og + 1u == (tg + 1u) * nx) xb_add(&bar[XB_TOPGEN], 1u);
            else XB_SPIN(xb_ld(&bar[XB_TOPGEN]) == tg, bar);
            __builtin_amdgcn_fence(__ATOMIC_ACQUIRE, "agent");
            xb_add(&bar[XB_XGEN(b.x)], 1u);
            asm volatile("s_waitcnt vmcnt(0)" ::: "memory");
        } else {
            XB_SPIN(xb_ld(&bar[XB_XGEN(b.x)]) == gen, bar);
            __builtin_amdgcn_fence(__ATOMIC_ACQUIRE, "agent");
            asm volatile("s_waitcnt vmcnt(0)" ::: "memory");
        }
    }
    __syncthreads();
}

struct Params { const float* in[21]; float* out; unsigned char* ws; int s_lo, s_hi; };
struct DParams { const gfloat* in[21]; gfloat* out; guchar* ws; int s_lo, s_hi; };
enum { I_X = 0, I_META, I_ATTN_NORM, I_W_IN, I_QA_NORM, I_W_Q_UP, I_KVA_NORM, I_W_KV_UP, I_Q_NORM, I_K_NORM, I_DQ_NORM, I_DK_NORM, I_LQ1, I_LK1, I_LQ2, I_LK2, I_SUBLN, I_W_O, I_FFN_NORM,
       I_W_GU, I_W_D };
constexpr int LDS_BYTES = 149504;
constexpr int NTHREADS = 512, NWAVES = 8;

struct Frame {
    LAS unsigned char* lds; DParams p; int tid, lane, wave, vcu, G, gw, ngw;
};

__device__ __forceinline__ void transpose_item(const gfloat* W, int ldw, int Ksrc, const gfloat* gain, gbf16_t* WT, int Kd, int k0, int sc0, int dr0, LAS float* scr, int lane) {
    const bool zero = (sc0 < 0) || (k0 >= Ksrc);
    const int c = lane & 7;
    if (zero) {
#pragma unroll
        for (int j = 0; j < 4; ++j) { const int n = (lane >> 3) + 8 * j; *(gu32x4*)(WT + (size_t)(dr0 + n) * Kd + k0 + 8 * c) = (u32x4){0u, 0u, 0u, 0u}; }
        return;
    }
    f32x4 wv[8]; const int kr_ = lane >> 3, nq_ = (lane & 7) * 4;
#pragma unroll
    for (int i = 0; i < 8; ++i) wv[i] = __builtin_nontemporal_load((const gf32x4*)(W + (size_t)(k0 + 8 * i + kr_) * ldw + sc0 + nq_));
    if (gain) {
#pragma unroll
        for (int i = 0; i < 8; ++i) wv[i] = wv[i] * gain[k0 + 8 * i + kr_]; }
#pragma unroll
    for (int i = 0; i < 8; ++i) { LAS float* d = scr + (8 * i + kr_) * 33 + nq_; d[0] = wv[i][0]; d[1] = wv[i][1]; d[2] = wv[i][2]; d[3] = wv[i][3]; }
    LDS_WAIT(); asm volatile("" ::: "memory");
#pragma unroll
    for (int j = 0; j < 4; ++j) { const int n = (lane >> 3) + 8 * j; const LAS float* s = scr + (8 * c) * 33 + n;
        u32x4 o; o.x = pk2(s[0 * 33], s[1 * 33]); o.y = pk2(s[2 * 33], s[3 * 33]); o.z = pk2(s[4 * 33], s[5 * 33]); o.w = pk2(s[6 * 33], s[7 * 33]);
        *(gu32x4*)(WT + (size_t)(dr0 + n) * Kd + k0 + 8 * c) = o; }
    LDS_WAIT(); asm volatile("" ::: "memory");
}
constexpr int IT_IN = 16 * 64, IT_Q = 4 * 32, IT_KV = 2 * 32, IT_O = 16 * 32, IT_GU = 16 * 176, IT_D = 44 * 32, IT_L = IT_IN + IT_Q + IT_KV + IT_O + IT_GU + IT_D;
__device__ __forceinline__ void prep_transpose(Frame& F, int it, LAS float* scr) {
    const DParams& P = F.p;
        const int l = it / IT_L; int r = it % IT_L;
        gbf16_t* wb = (gbf16_t*)(P.ws + WS_W + (size_t)l * W_LAYER);
        if (r < IT_IN) { const int kb = r / 64, g = r % 64; int sc0;
            if (g < 14) sc0 = 32 * g;
            else if (g < 16) sc0 = -1;
            else if (g < 48) { const int tile = g >> 3, p32 = g & 7, bj = p32 >> 2, wcc = p32 & 3;
                sc0 = (tile < 4 ? SRC_DQ + (tile - 2) * 256 : SRC_DK + (tile - 4) * 256) + 64 * wcc + 32 * bj; }
            else sc0 = SRC_DV + 32 * (g - 48);
            transpose_item(P.in[I_W_IN] + (size_t)l * DM * INW, INW, DM, P.in[I_ATTN_NORM] + l * DM, (gbf16_t*)((gchar*)wb + W_IN), DM, kb * 64, sc0, 32 * g, scr, F.lane); return; }
        r -= IT_IN;
        if (r < IT_Q) { const int kb = r / 32, g = r % 32, h = g >> 3, d0 = (g & 7) * 32;
            transpose_item(P.in[I_W_Q_UP] + (size_t)l * 256 * 768, 768, 256, P.in[I_QA_NORM] + l * 256, (gbf16_t*)((gchar*)wb + W_Q), 256, kb * 64, d0 < 192 ? h * 192 + d0 : -1, 32 * g, scr, F.lane); return; }
        r -= IT_Q;
        if (r < IT_KV) { const int kb = r / 32, g = r % 32;
            transpose_item(P.in[I_W_KV_UP] + (size_t)l * 128 * 1024, 1024, 128, P.in[I_KVA_NORM] + l * 128, (gbf16_t*)((gchar*)wb + W_KV), 128, kb * 64, 32 * g, 32 * g, scr, F.lane); return; }
        r -= IT_KV;
        if (r < IT_O) { const int kb = r / 32, g = r % 32;
            transpose_item(P.in[I_W_O] + (size_t)l * DM * DM, DM, DM, nullptr, (gbf16_t*)((gchar*)wb + W_O), DM, kb * 64, 32 * g, 32 * g, scr, F.lane); return; }
        r -= IT_O;
        if (r < IT_GU) { const int kb = r / 176, g = r % 176, pn = g >> 3, half = (g & 7) >> 2, i0 = (g & 3) * 32;
            transpose_item(P.in[I_W_GU] + (size_t)l * DM * 2 * DFF, 2 * DFF, DM, P.in[I_FFN_NORM] + l * DM, (gbf16_t*)((gchar*)wb + W_GU), DM, kb * 64, half * DFF + pn * 128 + i0, 32 * g, scr, F.lane); return; }
        r -= IT_GU;
        { const int kb = r / 32, g = r % 32;
          transpose_item(P.in[I_W_D] + (size_t)l * DFF * DM, DM, DFF, nullptr, (gbf16_t*)((gchar*)wb + W_D), DFF, kb * 64, 32 * g, 32 * g, scr, F.lane); }
}
__device__ __forceinline__ void stage_prep(Frame& F) {
    LAS float* scr = (LAS float*)(F.lds + F.wave * 16384);
    const DParams& P = F.p;
    constexpr int N_C = NROWS / 4, N_ALL = N_C + 2 * IT_L;
    static_assert(NROWS % 4 == 0, "cast items are 4 rows");
    unsigned* ctr = (unsigned*)(P.ws + WS_CTL + 1024);
    gbf16_t* XN = (gbf16_t*)(P.ws + WS_HBA); gfloat* SSQ = (gfloat*)(P.ws + WS_SSQH); gfloat* MSSQ = (gfloat*)(P.ws + WS_MSSQ);
    volatile LAS int* slot = (volatile LAS int*)(F.lds + LDS_BYTES - 256 + 128);
    if (F.tid == 0) slot[0] = (int)__hip_atomic_fetch_add(ctr, 8u, __ATOMIC_RELAXED, __HIP_MEMORY_SCOPE_AGENT);
    __syncthreads();
    int base = slot[0], par = 0;
    while (base < N_ALL) {
        unsigned nb = 0; if (F.tid == 0) nb = __hip_atomic_fetch_add(ctr, 8u, __ATOMIC_RELAXED, __HIP_MEMORY_SCOPE_AGENT);
        const int item = base + F.wave;
        if (item < N_C) {
            f32x4 v[4][4];
#pragma unroll
            for (int q = 0; q < 4; ++q) { const int r_ = 4 * item + q; const gfloat* hr_ = r_ < NREAL ? P.in[I_X] + (size_t)r_ * DM : P.in[I_META] + (size_t)(r_ - NREAL) * DM;
#pragma unroll
                for (int j = 0; j < 4; ++j) v[q][j] = __builtin_nontemporal_load((const gf32x4*)hr_ + F.lane + 64 * j); }
#pragma unroll
            for (int q = 0; q < 4; ++q) { const int row = 4 * item + q;
                float sq = 0.f;
#pragma unroll
                for (int j = 0; j < 4; ++j) sq += (v[q][j].x * v[q][j].x + v[q][j].y * v[q][j].y) + (v[q][j].z * v[q][j].z + v[q][j].w * v[q][j].w);
                sq = wave_sum(sq);
                if (row < NREAL) { if (F.lane < 16) SSQ[(size_t)row * 16 + F.lane] = F.lane == 0 ? sq : 0.f; }
                else MSSQ[(row - NREAL) * 64 + F.lane] = F.lane == 0 ? sq : 0.f;
                gu32x2* o8 = (gu32x2*)(XN + (size_t)row * DM) + F.lane;
#pragma unroll
                for (int j = 0; j < 4; ++j) o8[64 * j] = (u32x2){pk2(v[q][j].x, v[q][j].y), pk2(v[q][j].z, v[q][j].w)}; }
        } else if (item < N_ALL) prep_transpose(F, item - N_C, scr);
        if (F.tid == 0) slot[par ^ 1] = (int)nb;
        __syncthreads();
        par ^= 1; base = slot[par];
    }
    __syncthreads();
    gfloat* COS = (gfloat*)(P.ws + WS_COS); gfloat* SIN = (gfloat*)(P.ws + WS_SIN);
    for (int i = blockIdx.x * NTHREADS + F.tid; i < LSEQ * 32; i += F.G * NTHREADS) {
        const int pos = i >> 5, m = i & 31;
        const float inv = 1.0f / powf(10000.0f, (float)(2 * m) / 64.0f), ang = (float)pos * inv;
        COS[i] = cosf(ang); SIN[i] = sinf(ang);
    }
    if (blockIdx.x == 0 && F.wave == 0) {
        const int ln = F.lane;
#pragma unroll 1
        for (int l = 0; l < DEPTH; ++l) {
            float a = P.in[I_LQ1][l * 64 + ln] * P.in[I_LK1][l * 64 + ln], b = P.in[I_LQ2][l * 64 + ln] * P.in[I_LK2][l * 64 + ln];
            float mq = fmaxf(fmaxf(fabsf(P.in[I_Q_NORM][l * 192 + ln]), fabsf(P.in[I_Q_NORM][l * 192 + 64 + ln])), fabsf(P.in[I_Q_NORM][l * 192 + 128 + ln]));
            float mk = fmaxf(fmaxf(fabsf(P.in[I_K_NORM][l * 192 + ln]), fabsf(P.in[I_K_NORM][l * 192 + 64 + ln])), fabsf(P.in[I_K_NORM][l * 192 + 128 + ln]));
            float dq = fabsf(P.in[I_DQ_NORM][l * 64 + ln]), dk = fabsf(P.in[I_DK_NORM][l * 64 + ln]);
            a = wave_sum(a); b = wave_sum(b);
#pragma unroll
            for (int off = 1; off < 64; off <<= 1) { mq = fmaxf(mq, __shfl_xor(mq, off)); mk = fmaxf(mk, __shfl_xor(mk, off)); dq = fmaxf(dq, __shfl_xor(dq, off)); dk = fmaxf(dk, __shfl_xor(dk, off)); }
            if (ln == 0) {
                const float lam_init = 0.8f - 0.6f * expf(-0.3f * (float)l);
                ((gfloat*)(P.ws + WS_LAM))[l] = expf(a) - expf(b) + lam_init;
                ((gfloat*)(P.ws + WS_LAM))[8 + 2 * l] = mq * mk * 192.0f * CA; ((gfloat*)(P.ws + WS_LAM))[9 + 2 * l] = dq * dk * 64.0f * CD; }
        }
    }
}

__device__ __forceinline__ void meta_postproj(Frame& F, int l) {
    if (blockIdx.x < 254) return;
    const DParams& P = F.p; const int lane = F.lane, ri = (blockIdx.x - 254) * NWAVES + F.wave, row = NREAL + ri;
    gbf16_t* pr = (gbf16_t*)(P.ws + WS_PROJ) + (size_t)row * INWP;
    const float cs = ((const gfloat*)(P.ws + WS_COS))[ri * 32 + (lane & 31)], sn = ((const gfloat*)(P.ws + WS_SIN))[ri * 32 + (lane & 31)];
    const float gq = P.in[I_DQ_NORM][l * 64 + lane], gk = P.in[I_DK_NORM][l * 64 + lane];
    float x[16];
#pragma unroll
    for (int seg = 0; seg < 16; ++seg) x[seg] = bf2f(pr[PC_DQ + seg * 64 + lane]);
#pragma unroll
    for (int seg = 0; seg < 16; ++seg) {
        const float r = rsq(wave_sum(x[seg] * x[seg]) * (1.0f / 64.0f) + EPS);
        const float y = x[seg] * r * (seg < 8 ? gq : gk), pt = __shfl_xor(y, 32);
        const float o = lane < 32 ? y * cs - pt * sn : y * cs + pt * sn;
        pr[PC_DQ + seg * 64 + lane] = (bf16_t)f2bf(seg < 8 ? o * CD : o);
    }
    asm volatile("s_waitcnt vmcnt(0)" ::: "memory");
}

__device__ __forceinline__ void att_store(Frame& F, const f32x16 (&o)[4], int qrow0, int colbase, int nvalid, int lane_) {
    __syncthreads();
    const int r32 = lane_ & 31, hi = lane_ >> 5;
    LAS char* stg = (LAS char*)F.lds + F.wave * 8192;
#pragma unroll
    for (int r = 0; r < 16; ++r) { const int row = att::crow(r, hi);
#pragma unroll
        for (int d0 = 0; d0 < 4; ++d0) *(LAS unsigned short*)(stg + row * 256 + (d0 * 32 + r32) * 2) = (unsigned short)f2bf(o[d0][r]); }
    LDS_WAIT();
    gbf16_t* AO = (gbf16_t*)(F.p.ws + WS_AO);
    const int ch = lane_ & 15, rq = lane_ >> 4;
#pragma unroll
    for (int i = 0; i < 8; ++i) { const int row = rq + 4 * i, lr = F.wave * 32 + row; const u32x4 v = *(const LAS u32x4*)(stg + row * 256 + ch * 16);
        if (lr < nvalid) *(gu32x4*)(AO + (size_t)(qrow0 + lr) * DM + colbase + ch * 8) = v; }
}
template <bool NOMAX> __device__ __forceinline__ void attn_unit_mla(Frame& F, int l_idx, int b, int h, int qrow0, int qpos0, int NT, int nvalid) {
    const DParams& P = F.p;
    const gbf16_t* QRAW = (const gbf16_t*)(P.ws + WS_QRAW); const gbf16_t* KA = (const gbf16_t*)(P.ws + WS_KA); const gbf16_t* KVRAW = (const gbf16_t*)(P.ws + WS_KVRAW);
    f32x16 o[4]; float l;
    att::attn_map<192, true, NOMAX>(QRAW + (size_t)qrow0 * 768 + h * 192, 768, KA + h * 192, 768, KVRAW + h * 256 + 128, 1024, b, qpos0, NT, o, l, (LAS char*)F.lds, (void*)((unsigned char*)P.ws + WS_CTL + 32768),
                             P.in[I_Q_NORM] + l_idx * 192, (const gfloat*)(P.ws + WS_COS), (const gfloat*)(P.ws + WS_SIN));
    int lane_ = F.lane; asm volatile("" : "+v"(lane_));
    float rli[16]; att::row_recip(l, rli, (LAS char*)F.lds, F.wave, lane_ & 31, lane_ >> 5);
#pragma unroll
    for (int r = 0; r < 16; ++r)
#pragma unroll
        for (int d0 = 0; d0 < 4; ++d0) o[d0][r] *= rli[r];
    att_store(F, o, qrow0, h * 128, nvalid, lane_);
}
template <bool NOMAX> __device__ __forceinline__ void attn_unit_diff(Frame& F, int l_idx, int b, int h, int qrow0, int qpos0, int NT, int nvalid) {
    const DParams& P = F.p;
    const gbf16_t* PROJ = (const gbf16_t*)(P.ws + WS_PROJ);
    const float lam = ((const gfloat*)(P.ws + WS_LAM))[l_idx];
    const float lam_init = 0.8f - 0.6f * expf(-0.3f * (float)l_idx);
    f32x16 o[4]; unsigned oa[4][8]; float lsum; float rli[16];
#pragma unroll 1
    for (int c = 0; c < 2; ++c) {
        att::attn_map<64, false, NOMAX>(PROJ + (size_t)qrow0 * INWP + PC_DQ + h * 128 + c * 64, INWP, PROJ + PC_DK + h * 128 + c * 64, INWP, PROJ + PC_DV + h * 128, INWP, b, qpos0, NT, o, lsum, (LAS char*)F.lds, (void*)((unsigned char*)P.ws + WS_CTL + 32768 + 64));
        int tid_ = F.tid; asm volatile("" : "+v"(tid_));
        att::row_recip(lsum, rli, (LAS char*)F.lds, F.wave, tid_ & 31, (tid_ >> 5) & 1);
        if (c == 0) {
            if constexpr (NOMAX) {
#pragma unroll
                for (int d = 0; d < 4; ++d)
#pragma unroll
                    for (int r = 0; r < 8; ++r) oa[d][r] = cvt_pk_bf16(o[d][2 * r] * rli[2 * r], o[d][2 * r + 1] * rli[2 * r + 1]);
            } else {
                gf32x4* tmp = (gf32x4*)(P.ws + WS_TMP) + (size_t)blockIdx.x * (16 * 512) + tid_;
#pragma unroll
                for (int d = 0; d < 4; ++d)
#pragma unroll
                    for (int q = 0; q < 4; ++q) tmp[(d * 4 + q) * 512] = (f32x4){o[d][4 * q] * rli[4 * q], o[d][4 * q + 1] * rli[4 * q + 1], o[d][4 * q + 2] * rli[4 * q + 2], o[d][4 * q + 3] * rli[4 * q + 3]};
            }
        }
    }
    int tid_ = F.tid; asm volatile("" : "+v"(tid_));
    const int lane_ = tid_ & 63, r32 = lane_ & 31;
    const gf32x4* tmp = (const gf32x4*)(P.ws + WS_TMP) + (size_t)blockIdx.x * (16 * 512) + tid_;
    float ss[16];
#pragma unroll
    for (int r = 0; r < 16; ++r) ss[r] = 0.f;
    if constexpr (NOMAX) {
#pragma unroll
        for (int d = 0; d < 4; ++d)
#pragma unroll
            for (int r = 0; r < 16; ++r) { const float a0 = (r & 1) ? bf2f(oa[d][r >> 1] >> 16) : bf2f(oa[d][r >> 1] & 0xffffu); const float v = a0 - lam * rli[r] * o[d][r]; o[d][r] = v; ss[r] += v * v; }
    } else {
#pragma unroll
    for (int d = 0; d < 4; ++d) {
#pragma unroll
        for (int q = 0; q < 4; ++q) { const f32x4 t = tmp[(d * 4 + q) * 512];
#pragma unroll
            for (int e = 0; e < 4; ++e) { const int r = 4 * q + e; const float v = t[e] - lam * rli[r] * o[d][r]; o[d][r] = v; ss[r] += v * v; } }
        asm volatile("" ::: "memory"); }
    }
#pragma unroll
    for (int off = 1; off < 32; off <<= 1) { float t[16];
#pragma unroll
        for (int r = 0; r < 16; ++r) t[r] = __shfl_xor(ss[r], off);
#pragma unroll
        for (int r = 0; r < 16; ++r) ss[r] += t[r]; }
    const gfloat* gs = P.in[I_SUBLN] + l_idx * 128; const float post = 1.0f - lam_init;
    float gcol[4];
#pragma unroll
    for (int d = 0; d < 4; ++d) gcol[d] = gs[d * 32 + r32] * post;
#pragma unroll
    for (int r = 0; r < 16; ++r) { const float rn = rsq(ss[r] * (1.0f / 128.0f) + EPS);
#pragma unroll
        for (int d0 = 0; d0 < 4; ++d0) o[d0][r] *= rn * gcol[d0]; }
    att_store(F, o, qrow0, 512 + h * 128, nvalid, lane_);
}
template <bool NOMAX> __device__ __forceinline__ void stage_attention(Frame& F, int l) {
    const int v = F.vcu, bh = v >> 2, s = v & 3, b = bh >> 2, h = bh & 3;
    if (F.tid < 192) ((LAS float*)((LAS char*)F.lds + att::OFF_GQ))[F.tid] = F.p.in[I_Q_NORM][l * 192 + F.tid];
    __syncthreads();
#pragma unroll 1
    for (int u = 0; u < 5; ++u) {
        int type, b_, h_, qrow0, qpos0, NT, nvalid;
        if (u < 4) { const int qb = (u & 1) ? 7 - s : s; type = u >> 1; b_ = b; h_ = h; qrow0 = b * SEQ + qb * 256; qpos0 = NMETA + qb * 256; NT = 4 * qb + 5; nvalid = 256; }
        else { if (v >= 8 || l == DEPTH - 1) break; type = v >> 2; b_ = 0; h_ = v & 3; qrow0 = NREAL; qpos0 = 0; NT = 1; nvalid = NMETA; }
        if (type == 0) attn_unit_mla<NOMAX>(F, l, b_, h_, qrow0, qpos0, NT, nvalid);
        else attn_unit_diff<NOMAX>(F, l, b_, h_, qrow0, qpos0, NT, nvalid);
    }
    __syncthreads();
}

__device__ __forceinline__ f32x4 meta_dot(const gbf16_t* arow, const gbf16_t* wrow, int K) {
    f32x4 acc = {0.f, 0.f, 0.f, 0.f};
#pragma unroll 8
    for (int k = 0; k < K; k += 32) { const bf16x8 a = *(const gbf16x8*)(arow + k); const bf16x8 w = *(const gbf16x8*)(wrow + k);
        acc = __builtin_amdgcn_mfma_f32_16x16x32_bf16(w, a, acc, 0, 0, 0); }
    return acc;
}
__device__ __forceinline__ float meta_rh(const gfloat* mssq, int tr) {
    f32x4 v[16];
#pragma unroll
    for (int i = 0; i < 16; ++i) v[i] = *(const gf32x4*)(mssq + tr * 64 + 4 * i);
    __builtin_amdgcn_sched_barrier(0);
    float s = 0.f;
#pragma unroll
    for (int i = 0; i < 16; ++i) s += (v[i][0] + v[i][1]) + (v[i][2] + v[i][3]);
    return rsq(s * (1.0f / DM) + EPS);
}
__device__ __forceinline__ void meta_tasks(Frame& F, int kind, const pg8::Gemm& g, gbf16_t* eo, int eld, const gfloat* ers, const gbf16_t* src_meta, gbf16_t* xn) {
    const int tr = F.lane & 15, q = F.lane >> 4, row = NREAL + tr;
    const int kc = g.K >> 3, k0 = F.wave * kc;
    const gbf16_t* arow = g.A + (size_t)row * g.lda + 8 * q + k0;
    gfloat* mssq = (gfloat*)(F.p.ws + WS_MSSQ);
    LAS f32x4* red = (LAS f32x4*)(F.lds + pg8::STAGE_BYTES);
    const int ntasks = (kind == 1 ? DFF : g.N) / 16;
    if ((int)blockIdx.x >= ntasks) return;
    float sc = 1.0f;
    if (kind != 2) {
        if (ers) {
            const gbf16_t* cq = (const gbf16_t*)ers + (size_t)tr * INWP + 64 * q; u32x4 cv[8]; float s = 0.f;
#pragma unroll
            for (int i = 0; i < 8; ++i) cv[i] = *(const gu32x4*)(cq + 8 * i);
#pragma unroll
            for (int i = 0; i < 8; ++i) { float x[8]; unpack8(cv[i], x); s += ssq8(x); }
            s += __shfl_xor(s, 16); s += __shfl_xor(s, 32); sc = rsq(s * (1.0f / 256.0f) + EPS);
        } else sc = meta_rh(mssq, tr);
    }
    for (int t = blockIdx.x; t < ntasks; t += F.G) {
        int wr0 = 16 * t + tr, wr1 = 0;
        if (kind == 1) { const int c0 = 16 * t, pn = c0 >> 7, i0 = c0 & 127; wr0 = pn * 256 + i0 + tr; wr1 = wr0 + 128; }
        const f32x4 p0 = meta_dot(arow, g.Bt + (size_t)wr0 * g.K + 8 * q + k0, kc);
        red[F.wave * 64 + F.lane] = p0;
        if (kind == 1) { const f32x4 p1 = meta_dot(arow, g.Bt + (size_t)wr1 * g.K + 8 * q + k0, kc); red[512 + F.wave * 64 + F.lane] = p1; }
        __syncthreads();
        if (F.wave == 0) {
            f32x4 acc = red[F.lane];
#pragma unroll
            for (int w = 1; w < 8; ++w) acc += red[w * 64 + F.lane];
            if (kind == 0) {
                int col = 16 * t + 4 * q; bool keep = true;
                if (ers) { const int hh = col >> 8, wi = col & 255; keep = wi < 192; col = hh * 192 + wi; }
                else if (col >= PC_DQ && col < PC_DV) { const int p = col & 255; col = (col & ~255) + 64 * ((p >> 5) & 3) + 32 * (p >> 7) + (p & 31); }
                if (keep) *(gu32x2*)(eo + (size_t)row * eld + col) = (u32x2){cvt_pk_bf16(acc[0] * sc, acc[1] * sc), cvt_pk_bf16(acc[2] * sc, acc[3] * sc)};
            } else if (kind == 1) {
                f32x4 au = red[512 + F.lane];
#pragma unroll
                for (int w = 1; w < 8; ++w) au += red[512 + w * 64 + F.lane];
                *(gu32x2*)(eo + (size_t)row * eld + 16 * t + 4 * q) = (u32x2){cvt_pk_bf16(pg8::silu_mul(acc[0] * sc, au[0] * sc), pg8::silu_mul(acc[1] * sc, au[1] * sc)),
                                                                           cvt_pk_bf16(pg8::silu_mul(acc[2] * sc, au[2] * sc), pg8::silu_mul(acc[3] * sc, au[3] * sc))};
            } else {
                const int c = 16 * t + 4 * q;
                const u32x2 sv = *(const gu32x2*)(src_meta + (size_t)row * DM + c);
                const f32x4 h = (f32x4){bf2f(sv.x & 0xffffu), bf2f(sv.x >> 16), bf2f(sv.y & 0xffffu), bf2f(sv.y >> 16)} + acc;
                *(gu32x2*)(xn + (size_t)row * DM + c) = (u32x2){cvt_pk_bf16(h[0], h[1]), cvt_pk_bf16(h[2], h[3])};
                float s = (h[0] * h[0] + h[1] * h[1]) + (h[2] * h[2] + h[3] * h[3]);
                s += __shfl_xor(s, 16); s += __shfl_xor(s, 32);
                if (q == 0) mssq[tr * 64 + t] = s;
            }
        }
        __syncthreads();
    }
    asm volatile("s_waitcnt vmcnt(0)" ::: "memory");
}

__device__ __forceinline__ void meta_kv_heads(Frame& F, int l, const gbf16_t* Wkv) {
    if (blockIdx.x >= 4) return;
    const DParams& P = F.p; const int h = blockIdx.x, tr = F.lane & 15, q = F.lane >> 4;
    const gbf16_t* PROJ = (const gbf16_t*)(P.ws + WS_PROJ); gbf16_t* KA = (gbf16_t*)(P.ws + WS_KA); gbf16_t* KV = (gbf16_t*)(P.ws + WS_KVRAW);
    const gfloat* COS = (const gfloat*)(P.ws + WS_COS); const gfloat* SIN = (const gfloat*)(P.ws + WS_SIN); const gfloat* gk = P.in[I_K_NORM] + l * 192;
    LAS float* L = (LAS float*)(F.lds + pg8::STAGE_BYTES);
#pragma unroll 1
    for (int i = 0; i < 2; ++i) { const int t = 2 * F.wave + i;
        const f32x4 acc = meta_dot(PROJ + (size_t)(NREAL + tr) * INWP + PC_CKV + 8 * q, Wkv + (size_t)(h * 256 + 16 * t + tr) * 128 + 8 * q, 128);
#pragma unroll
        for (int e = 0; e < 4; ++e) L[tr * 256 + 16 * t + 4 * q + e] = acc[e]; }
    __syncthreads();
#pragma unroll 1
    for (int i = 0; i < 2; ++i) { const int ri = 2 * F.wave + i, row = NREAL + ri, lane = F.lane;
        const gbf16_t* pr = PROJ + (size_t)row * INWP;
        float rkv; { const unsigned v = *(const gunsigned*)(pr + PC_CKV + 2 * lane); const float a = bf2f(v & 0xffffu), c = bf2f(v >> 16); rkv = rsq(wave_sum(a * a + c * c) * (1.0f / 128.0f) + EPS); }
        const float x0 = L[ri * 256 + lane] * rkv, x1 = L[ri * 256 + 64 + lane] * rkv, x2 = bf2f(pr[PC_KR + lane]);
        const float r = rsq(wave_sum(x0 * x0 + x1 * x1 + x2 * x2) * (1.0f / 192.0f) + EPS);
        const float cs = COS[ri * 32 + (lane & 31)], sn = SIN[ri * 32 + (lane & 31)];
        const float y0 = x0 * r * gk[lane], y1 = x1 * r * gk[64 + lane], y2 = x2 * r * gk[128 + lane], pt = __shfl_xor(y2, 32);
        const float y2r = lane < 32 ? y2 * cs - pt * sn : y2 * cs + pt * sn;
        gbf16_t* ko = KA + (size_t)row * 768 + h * 192;
        ko[lane] = (bf16_t)f2bf(y0); ko[64 + lane] = (bf16_t)f2bf(y1); ko[128 + lane] = (bf16_t)f2bf(y2r);
        gbf16_t* vo = KV + (size_t)row * 1024 + h * 256 + 128;
        vo[lane] = (bf16_t)f2bf(L[ri * 256 + 128 + lane] * rkv); vo[64 + lane] = (bf16_t)f2bf(L[ri * 256 + 192 + lane] * rkv); }
    __syncthreads();
    asm volatile("s_waitcnt vmcnt(0)" ::: "memory");
}

constexpr int SPL = 7, NSTAGES = 1 + SPL * DEPTH;
__device__ __forceinline__ bool stage_needs_sync(int st) { return !(st >= 1 && (st - 1) % SPL == 2); }
__device__ __forceinline__ void run_stage(const Params& p, LAS unsigned char* ldsp, int st) {
    Frame F;
    F.lds = ldsp;
    { int t = threadIdx.x; asm volatile("" : "+v"(t)); F.tid = t; }
    { unsigned char* w = p.ws; asm volatile("" : "+s"(w)); F.p.ws = (guchar*)w; }
#pragma unroll
    for (int i = 0; i < 21; ++i) F.p.in[i] = (const gfloat*)p.in[i];
    F.p.out = (gfloat*)p.out; F.p.s_lo = p.s_lo; F.p.s_hi = p.s_hi;
    F.lane = F.tid & 63; F.wave = __builtin_amdgcn_readfirstlane(F.tid >> 6);
    F.G = gridDim.x; { const int bx = blockIdx.x; F.vcu = (F.G % 8 == 0) ? (bx % 8) * (F.G / 8) + bx / 8 : bx; }
    F.gw = blockIdx.x * NWAVES + F.wave; F.ngw = F.G * NWAVES;
    const DParams& P = F.p;
    guchar* ws = P.ws;
    if (st == 0) { stage_prep(F); return; }
    const int l = (st - 1) / SPL, s = (st - 1) % SPL;
    const gchar* wb = (const gchar*)(ws + WS_W + (size_t)l * W_LAYER);
    gbf16_t* HBA = (gbf16_t*)(ws + WS_HBA); gbf16_t* HBB = (gbf16_t*)(ws + WS_HBB);
    const bool last_layer = l == DEPTH - 1;
    int kind = -1; pg8::Gemm g{nullptr, nullptr, NREAL, 0, 0, 0};
    gbf16_t* eo = nullptr; int eld = 0;
    const gbf16_t* hsrc = nullptr; gbf16_t* hdst = nullptr;
    switch (s) {
    case 0: kind = 0; g.A = HBA; g.Bt = (const gbf16_t*)(wb + W_IN); g.N = INWP; g.K = DM; g.lda = DM; eo = (gbf16_t*)(ws + WS_PROJ); eld = INWP; break;
    case 1: kind = 5; g.A = (const gbf16_t*)(ws + WS_PROJ) + PC_CQ; g.Bt = (const gbf16_t*)(wb + W_Q); g.N = 1024; g.K = 256; g.lda = INWP; eo = (gbf16_t*)(ws + WS_QRAW); eld = 768; break;
    case 2: kind = 4; g.A = (const gbf16_t*)(ws + WS_PROJ) + PC_CKV; g.Bt = (const gbf16_t*)(wb + W_KV); g.N = 1024; g.K = 128; g.lda = INWP; break;
    case 3: { const gfloat* bnd = (const gfloat*)(ws + WS_LAM) + 8 + 2 * l;
        if (bnd[0] < att::SCORE_BOUND_OK && bnd[1] < att::SCORE_BOUND_OK) stage_attention<true>(F, l); else stage_attention<false>(F, l); } break;
    case 4: kind = 2; g.A = (const gbf16_t*)(ws + WS_AO); g.Bt = (const gbf16_t*)(wb + W_O); g.N = DM; g.K = DM; g.lda = DM; hsrc = HBA; hdst = HBB; break;
    case 5: kind = 1; g.A = HBB; g.Bt = (const gbf16_t*)(wb + W_GU); g.N = 2 * DFF; g.K = DM; g.lda = DM; eo = (gbf16_t*)(ws + WS_ACT); eld = DFF; break;
    case 6: kind = last_layer ? 3 : 2; g.A = (const gbf16_t*)(ws + WS_ACT); g.Bt = (const gbf16_t*)(wb + W_D); g.N = DM; g.K = DFF; g.lda = DFF; hsrc = HBB; hdst = HBA; break;
    }
    if (kind >= 0) {
        gfloat* rqp = (gfloat*)(ws + WS_RQP); gfloat* rkvp = (gfloat*)(ws + WS_RKVP); gfloat* krss = (gfloat*)(ws + WS_KRSS); const gfloat* ssqh = (const gfloat*)(ws + WS_SSQH);
        const gfloat* COS = (const gfloat*)(ws + WS_COS); const gfloat* SIN = (const gfloat*)(ws + WS_SIN);
        pg8::StaticOrder S; S.init(NREAL, g.N, F.G, (int)blockIdx.x);
        pg8::gemm_prefetch(F.lds, g, S, true);
        if (kind == 4) meta_kv_heads(F, l, g.Bt);
        else if (kind == 5) { meta_postproj(F, l); meta_tasks(F, 0, g, eo, eld, (const gfloat*)((const gbf16_t*)(ws + WS_PROJ) + (size_t)NREAL * INWP + PC_CQ), nullptr, nullptr); }
        else if (!(last_layer && s >= 4)) meta_tasks(F, kind, g, eo, eld, nullptr, hsrc, hdst);
        if (kind == 0) { pg8::EpiInProj E{eo, ssqh, rqp, rkvp, krss, COS, SIN, P.in[I_DQ_NORM] + l * 64, P.in[I_DK_NORM] + l * 64}; pg8::gemm_phase<true>(F.lds, g, S, E); }
        else if (kind == 5) { pg8::EpiScaleBf16 E{eo, eld, rqp, 4, 1.0f / 256.0f, 192, 192}; pg8::gemm_phase<true>(F.lds, g, S, E); }
        else if (kind == 4) { pg8::EpiKV E{(gbf16_t*)(ws + WS_KA), (gbf16_t*)(ws + WS_KVRAW), (const gbf16_t*)(ws + WS_PROJ), rkvp, krss, COS, SIN, P.in[I_K_NORM] + l * 192};
                              pg8::gemm_phase<true>(F.lds, g, S, E); }
        else if (kind == 1) { pg8::EpiSwiglu E{eo, eld, nullptr, ssqh}; pg8::gemm_phase<true>(F.lds, g, S, E); }
        else if (kind == 2) { pg8::EpiResidual<false> E{hsrc, hdst, (gfloat*)(ws + WS_SSQH), nullptr}; pg8::gemm_phase<true>(F.lds, g, S, E); }
        else { pg8::EpiResidual<true> E{hsrc, nullptr, nullptr, P.out}; pg8::gemm_phase<true>(F.lds, g, S, E); }
    }
}

constexpr int LDS_MISC_OFF = LDS_BYTES - 256;
constexpr size_t CTL_BAR_OFF = 16384;
__global__ void __launch_bounds__(NTHREADS, 2) mega_kernel(Params p) {
    extern __shared__ __attribute__((aligned(16))) unsigned char lds[];
    cg::grid_group grid = cg::this_grid();
    volatile LAS unsigned* misc = (volatile LAS unsigned*)((LAS unsigned char*)lds + LDS_MISC_OFF);
    if (threadIdx.x < 4) misc[threadIdx.x] = 0u;
    __syncthreads();
    const XcdBarrier bar = xcd_barrier_post((unsigned*)(p.ws + WS_CTL + CTL_BAR_OFF), misc);
#pragma unroll 1
    for (int st = p.s_lo; st < p.s_hi; ++st) {
        if (st > p.s_lo && stage_needs_sync(st)) { if (st == 1) grid.sync(); else xcd_barrier(bar); }
#if defined(PROBE_SUM)
        const unsigned long long q0_ = __builtin_amdgcn_s_memrealtime();
#endif
#if defined(PROBE_CLK)
        unsigned long long c0_ = 0, r0_ = 0;
        if (st == PROBE_CLK) { c0_ = __builtin_amdgcn_s_memtime(); r0_ = __builtin_amdgcn_s_memrealtime(); }
#endif
        run_stage(p, (LAS unsigned char*)lds, st);
#if defined(PROBE_SUM)
        if (blockIdx.x == 9 && threadIdx.x == 0) ((unsigned long long*)(p.ws + WS_CTL + 49152))[st] = __builtin_amdgcn_s_memrealtime() - q0_;
        if (st == p.s_hi - 1) { xcd_barrier(bar);
            if (blockIdx.x == 0 && threadIdx.x == 0) { const unsigned long long* bt = (const unsigned long long*)(p.ws + WS_CTL + 49152); unsigned long long sum = 0;
                for (int i = 0; i < NSTAGES; ++i) if ((PROBE_SUM >> i) & 1) sum += bt[i];
                p.out[0] += 0.1f + 1e-5f * (float)sum; } }
#endif
#if defined(PROBE_CLK)
        if (st == PROBE_CLK && threadIdx.x == 0) { const unsigned long long c1_ = __builtin_amdgcn_s_memtime(), r1_ = __builtin_amdgcn_s_memrealtime();
            unsigned long long* pt = (unsigned long long*)(p.ws + WS_CTL + 32768 + 128); if (blockIdx.x == 9) { pt[0] = c1_ - c0_; pt[1] = r1_ - r0_; }
            ((unsigned long long*)(p.ws + WS_CTL + 40960))[blockIdx.x] = r1_ - r0_; }
        if (st == p.s_hi - 1) { xcd_barrier(bar);
            if (blockIdx.x == 0 && threadIdx.x == 0) { const unsigned long long* pt = (const unsigned long long*)(p.ws + WS_CTL + 32768 + 128);
#if PROBE_CLK_WHAT == 0
                p.out[0] += 0.1f + 0.01f * (float)((double)pt[0] / (double)pt[1]);
#elif PROBE_CLK_WHAT >= 2
                { const unsigned long long* bt = (const unsigned long long*)(p.ws + WS_CTL + 40960); unsigned long long mx = 0, mn = ~0ull, sum = 0; int cnt_slow = 0;
                  for (int i = 0; i < 256; ++i) { mx = bt[i] > mx ? bt[i] : mx; mn = bt[i] < mn ? bt[i] : mn; sum += bt[i]; }
                  for (int i = 0; i < 256; ++i) if (bt[i] * 10 > mx * 9) ++cnt_slow;
                  p.out[0] += 0.1f + (PROBE_CLK_WHAT == 2 ? 1e-5f * (float)mx : PROBE_CLK_WHAT == 3 ? 1e-5f * (float)mn : PROBE_CLK_WHAT == 4 ? 1e-5f * (float)(sum / 256) : 0.002f * (float)cnt_slow); }
#else
                p.out[0] += 0.1f + 1e-5f * (float)pt[1];
#endif
            } }
#endif
#if defined(PROBE_T)
        if (st == p.s_hi - 1) { xcd_barrier(bar);
            if (blockIdx.x == 0 && threadIdx.x == 0) { const unsigned long long* pt = (const unsigned long long*)(p.ws + WS_CTL + 32768 + (PROBE_DIFF ? 64 : 0));
                const float frac = (float)((double)pt[PROBE_Q] / (double)pt[0]); p.out[0] += 0.1f + (PROBE_Q == 0 ? (float)((double)pt[0] * 1e-6) : frac); } }
#endif
#if defined(PROBE_DUP)
        if ((st == 0 && (PROBE_DUP & 0x8000)) || (st >= 1 && ((PROBE_DUP >> ((st - 1) % SPL)) & 1))) { xcd_barrier(bar); run_stage(p, (LAS unsigned char*)lds, st); }
#endif
    }
}

extern "C" void kernel_launch(void* const* d_in, const int* in_sizes, int n_in, void* d_out, int out_size, void* d_ws, size_t ws_size, hipStream_t stream) {
    static int state = 0;
    if (state == 0) {
        if (n_in != 21 || in_sizes[0] != NREAL * DM || out_size != NREAL * DM || ws_size < WS_END) {
            fprintf(stderr, "kernel_launch: unexpected shapes: n_in %d in0 %d out %d ws %zu (need %zu)\n", n_in, n_in > 0 ? in_sizes[0] : -1, out_size, ws_size, (size_t)WS_END); state = -1; return; }
        int dev = 0, cus = 0;
        hipGetDevice(&dev); hipDeviceGetAttribute(&cus, hipDeviceAttributeMultiprocessorCount, dev);
        if (hipFuncSetAttribute((const void*)mega_kernel, hipFuncAttributeMaxDynamicSharedMemorySize, LDS_BYTES) != hipSuccess) { fprintf(stderr, "kernel_launch: hipFuncSetAttribute failed\n"); state = -1; return; }
        int per_cu = 0;
        hipOccupancyMaxActiveBlocksPerMultiprocessor(&per_cu, (const void*)mega_kernel, NTHREADS, LDS_BYTES);
        (void)hipGetLastError();
        if (cus != 256 || per_cu < 1) { fprintf(stderr, "kernel_launch: needs a 256-CU device with one resident workgroup per CU (cus %d, per_cu %d)\n", cus, per_cu); state = -1; return; }
        state = 1;
    }
    if (state < 0) return;
    Params p{};
    for (int i = 0; i < 21; ++i) p.in[i] = (const float*)d_in[i];
    p.out = (float*)d_out; p.ws = (unsigned char*)d_ws;
    p.s_lo = 0; p.s_hi = NSTAGES;
    if (hipMemsetAsync((char*)d_ws + WS_CTL, 0, 65536, stream) != hipSuccess) { fprintf(stderr, "kernel_launch: hipMemsetAsync failed\n"); return; }
    void* args[] = {&p};
    hipError_t e = hipLaunchCooperativeKernel((const void*)mega_kernel, dim3(256), dim3(NTHREADS), args, LDS_BYTES, stream);
    if (e != hipSuccess) fprintf(stderr, "kernel_launch: cooperative launch failed: %s\n", hipGetErrorString(e));
}
```
